# Optimizing an MI355X kernel written in HIP

```python
import math
import jax, jax.numpy as jnp
from jax import lax
import numpy as np

D_MODEL = 1024
BATCH = 2
SEQ = 8192
DEPTH = 4

N_MIXERS = 3
HEAD_DIM = 64
MIX_WIDTH = 768
N_MEM_HEADS = 4
MEM_WIDTH = N_MEM_HEADS * HEAD_DIM
N_MEM = 256
BRANCH = MIX_WIDTH + MEM_WIDTH
IN_WIDTH = 3 * MIX_WIDTH + MEM_WIDTH + BRANCH
RMS_EPS = 1e-6
SUBLN_EPS = 1e-5
NEG_INF = -1e30

DSW_GROUPS = ((128, 1), (512, 4), (2048, 16))
DSW_HEADS_PER_GROUP = 4
DSW_HEADS = DSW_HEADS_PER_GROUP * len(DSW_GROUPS)
DSW_GROUP_WIDTH = DSW_HEADS_PER_GROUP * HEAD_DIM
BAND_BLOCK = 128

MOBA_HEADS = MIX_WIDTH // HEAD_DIM
MOBA_BLOCK = 256
MOBA_TOPK = 3
MOBA_Q_CHUNK = 64

DIFF_HEADS = 6
DIFF_D = 64
DIFF_Q_BLOCK = 128
N_DIFF_LAYERS = len(range(2, DEPTH, N_MIXERS))

kernel_name = "hybrid_dilated_moba_diff_trunk"


def alibi_slopes(n):
    return jnp.asarray(2.0 ** (-8.0 * np.arange(1, n + 1) / n), dtype=jnp.float32)


def rmsnorm(x, g, eps=RMS_EPS):
    xf = x.astype(jnp.float32)
    y = xf * lax.rsqrt(jnp.mean(xf * xf, axis=-1, keepdims=True) + eps)
    return (y * g.astype(jnp.float32)).astype(x.dtype)


def split_heads(t, n):
    b, s, _ = t.shape
    return t.reshape(b, s, n, -1).transpose(0, 2, 1, 3)


def merge_heads(t):
    b, h, s, d = t.shape
    return t.transpose(0, 2, 1, 3).reshape(b, s, h * d)


def banded_causal_attention(q, k, v, span, slopes):
    b, h, L, hd = q.shape
    nb = -(-L // BAND_BLOCK)
    Lp = nb * BAND_BLOCK
    pad = ((0, 0), (0, 0), (0, Lp - L), (0, 0))
    qb = jnp.pad(q, pad).reshape(b, h, nb, BAND_BLOCK, hd)
    kb = jnp.pad(k, pad).reshape(b, h, nb, BAND_BLOCK, hd)
    vb = jnp.pad(v, pad).reshape(b, h, nb, BAND_BLOCK, hd)
    shift = ((0, 0), (0, 0), (1, 0), (0, 0), (0, 0))
    kk = jnp.concatenate([jnp.pad(kb, shift)[:, :, :-1], kb], axis=3)
    vv = jnp.concatenate([jnp.pad(vb, shift)[:, :, :-1], vb], axis=3)
    dist = (jnp.arange(BAND_BLOCK)[:, None] + BAND_BLOCK) - jnp.arange(2 * BAND_BLOCK)[None, :]
    kpos = jnp.arange(nb)[:, None] * BAND_BLOCK - BAND_BLOCK + jnp.arange(2 * BAND_BLOCK)[None, :]
    valid = ((dist >= 0) & (dist <= span))[None, :, :] & (kpos >= 0)[:, None, :]
    s = jnp.einsum('bhnqd,bhnkd->bhnqk', qb, kk).astype(jnp.float32) * (hd ** -0.5)
    s = s - slopes[None, :, None, None, None] * dist.astype(jnp.float32)
    s = jnp.where(valid, s, NEG_INF)
    lse = jax.nn.logsumexp(s, axis=-1)
    p = jnp.exp(s - lse[..., None])
    out = jnp.einsum('bhnqk,bhnkd->bhnqd', p, vv.astype(jnp.float32))
    return out.reshape(b, h, Lp, hd)[:, :, :L], lse.reshape(b, h, Lp)[:, :, :L]


def dilated_window_mixer(q, k, v):
    b, S, _ = q.shape
    hg = DSW_HEADS_PER_GROUP
    slopes_all = alibi_slopes(DSW_HEADS)
    outs, lses = [], []
    for g, (window, dil) in enumerate(DSW_GROUPS):
        cols = slice(g * DSW_GROUP_WIDTH, (g + 1) * DSW_GROUP_WIDTH)
        U = S // dil

        def to_residue(t):
            t = t.reshape(b, U, dil, hg, HEAD_DIM).transpose(0, 3, 2, 1, 4)
            return t.reshape(b, hg * dil, U, HEAD_DIM)

        slopes = jnp.repeat(slopes_all[g * hg:(g + 1) * hg] * dil, dil)
        o, lse = banded_causal_attention(to_residue(q[..., cols]), to_residue(k[..., cols]),
                                         to_residue(v[..., cols]), window // dil, slopes)
        o = o.reshape(b, hg, dil, U, HEAD_DIM).transpose(0, 3, 2, 1, 4).reshape(b, S, hg, HEAD_DIM)
        lse = lse.reshape(b, hg, dil, U).transpose(0, 3, 2, 1).reshape(b, S, hg)
        outs.append(o)
        lses.append(lse)
    alpha = jax.nn.softmax(jnp.stack(lses, axis=0), axis=0)
    mixed = [(outs[g] * alpha[g][..., None]).reshape(b, S, DSW_GROUP_WIDTH) for g in range(len(DSW_GROUPS))]
    return jnp.concatenate(mixed, axis=-1).astype(q.dtype)


def moba_mixer(q, k, v):
    b, S, _ = q.shape
    H = MOBA_HEADS
    slopes = alibi_slopes(H)
    nblk = -(-S // MOBA_BLOCK)
    Sp = nblk * MOBA_BLOCK
    n_gate = max(nblk, MOBA_TOPK)
    pad = ((0, 0), (0, 0), (0, Sp - S), (0, 0))
    qh = jnp.pad(split_heads(q, H), pad)
    kb = jnp.pad(split_heads(k, H), pad).reshape(b, H, nblk, MOBA_BLOCK, HEAD_DIM)
    vb = jnp.pad(split_heads(v, H), pad).reshape(b, H, nblk, MOBA_BLOCK, HEAD_DIM)
    kmean = jnp.mean(kb.astype(jnp.float32), axis=3)
    nchunk = Sp // MOBA_Q_CHUNK
    qc = qh.reshape(b, H, nchunk, MOBA_Q_CHUNK, HEAD_DIM).transpose(2, 0, 1, 3, 4)
    bi = jnp.arange(b)[:, None, None, None]
    hi = jnp.arange(H)[None, :, None, None]
    scale = HEAD_DIM ** -0.5

    def one_chunk(args):
        c, qx = args
        t = c * MOBA_Q_CHUNK + jnp.arange(MOBA_Q_CHUNK)
        n = (c * MOBA_Q_CHUNK) // MOBA_BLOCK
        gate = jnp.einsum('bhqd,bhnd->bhqn', qx.astype(jnp.float32), kmean)
        gate = jnp.pad(gate, ((0, 0), (0, 0), (0, 0), (0, n_gate - nblk)), constant_values=NEG_INF)
        gate = jnp.where(jnp.arange(n_gate) < n, gate, NEG_INF)
        _, idx = lax.top_k(gate, MOBA_TOPK)
        idx = jnp.minimum(idx, nblk - 1)
        sel_ok = jnp.arange(MOBA_TOPK) < n
        ks = kb[bi, hi, idx]
        vs = vb[bi, hi, idx]
        kpos_sel = idx[..., None] * MOBA_BLOCK + jnp.arange(MOBA_BLOCK)
        dist_sel = (t[None, None, :, None, None] - kpos_sel).astype(jnp.float32)
        s_sel = jnp.einsum('bhqd,bhqjkd->bhqjk', qx, ks).astype(jnp.float32) * scale
        s_sel = s_sel - slopes[None, :, None, None, None] * dist_sel
        s_sel = jnp.where(sel_ok[:, None], s_sel, NEG_INF)
        k_own = lax.dynamic_index_in_dim(kb, n, axis=2, keepdims=False)
        v_own = lax.dynamic_index_in_dim(vb, n, axis=2, keepdims=False)
        dist_own = t[:, None] - (n * MOBA_BLOCK + jnp.arange(MOBA_BLOCK))[None, :]
        s_own = jnp.einsum('bhqd,bhkd->bhqk', qx, k_own).astype(jnp.float32) * scale
        s_own = jnp.where(dist_own >= 0,
                          s_own - slopes[None, :, None, None] * dist_own.astype(jnp.float32), NEG_INF)
        s_all = jnp.concatenate([s_sel.reshape(b, H, MOBA_Q_CHUNK, MOBA_TOPK * MOBA_BLOCK), s_own], axis=-1)
        p = jax.nn.softmax(s_all, axis=-1)
        p_sel = p[..., :MOBA_TOPK * MOBA_BLOCK].reshape(b, H, MOBA_Q_CHUNK, MOBA_TOPK, MOBA_BLOCK)
        p_own = p[..., MOBA_TOPK * MOBA_BLOCK:]
        return (jnp.einsum('bhqjk,bhqjkd->bhqd', p_sel, vs.astype(jnp.float32))
                + jnp.einsum('bhqk,bhkd->bhqd', p_own, v_own.astype(jnp.float32)))

    o = lax.map(one_chunk, (jnp.arange(nchunk), qc))
    o = o.transpose(1, 2, 0, 3, 4).reshape(b, H, Sp, HEAD_DIM)[:, :, :S]
    return merge_heads(o).astype(q.dtype)


def diff_mixer(q, k, v, lq1, lk1, lq2, lk2, subln_g, lambda_init):
    b, S, _ = q.shape
    H = DIFF_HEADS
    slopes = alibi_slopes(H)
    qh = q.reshape(b, S, H, 2, DIFF_D).transpose(0, 2, 3, 1, 4)
    kh = k.reshape(b, S, H, 2, DIFF_D).transpose(0, 2, 3, 1, 4)
    vh = split_heads(v, H).astype(jnp.float32)
    lam = (jnp.exp(jnp.sum(lq1.astype(jnp.float32) * lk1.astype(jnp.float32)))
           - jnp.exp(jnp.sum(lq2.astype(jnp.float32) * lk2.astype(jnp.float32))) + lambda_init)
    nqb = S // DIFF_Q_BLOCK
    qblocks = qh.reshape(b, H, 2, nqb, DIFF_Q_BLOCK, DIFF_D).transpose(3, 0, 1, 2, 4, 5)
    kpos = jnp.arange(S)

    def one_block(args):
        j, qx = args
        t = j * DIFF_Q_BLOCK + jnp.arange(DIFF_Q_BLOCK)
        dist = t[:, None] - kpos[None, :]
        s = jnp.einsum('bhmqd,bhmkd->bhmqk', qx, kh).astype(jnp.float32) * (DIFF_D ** -0.5)
        s = jnp.where(dist >= 0, s - slopes[None, :, None, None, None] * dist.astype(jnp.float32), NEG_INF)
        p = jax.nn.softmax(s, axis=-1)
        w = p[:, :, 0] - lam * p[:, :, 1]
        return jnp.einsum('bhqk,bhkd->bhqd', w, vh)

    o = lax.map(one_block, (jnp.arange(nqb), qblocks))
    o = o.transpose(1, 2, 0, 3, 4).reshape(b, H, S, 2 * DIFF_D)
    o = rmsnorm(o, subln_g, SUBLN_EPS) * (1.0 - lambda_init)
    return merge_heads(o).astype(q.dtype)


def memory_attention(qm, mem_n, w_mem_kv):
    kv = mem_n @ w_mem_kv
    km = split_heads(kv[..., :MEM_WIDTH], N_MEM_HEADS)
    vm = split_heads(kv[..., MEM_WIDTH:], N_MEM_HEADS)
    qh = split_heads(qm, N_MEM_HEADS)
    s = jnp.einsum('bhqd,bhkd->bhqk', qh, km).astype(jnp.float32) * (HEAD_DIM ** -0.5)
    p = jax.nn.softmax(s, axis=-1)
    return merge_heads(jnp.einsum('bhqk,bhkd->bhqd', p, vm.astype(jnp.float32))).astype(qm.dtype)


def setup_inputs(seed: int = 0) -> dict:
    key = jax.random.key(seed)
    ks = jax.random.split(key, 14)
    f32 = jnp.float32
    nd = max(N_DIFF_LAYERS, 0)
    return {
        "x": jax.random.normal(ks[0], (BATCH, SEQ, D_MODEL), f32),
        "mem": jax.random.normal(ks[1], (BATCH, N_MEM, D_MODEL), f32),
        "norm_g": 1.0 + 0.02 * jax.random.normal(ks[2], (DEPTH, D_MODEL), f32),
        "w_in": jax.random.normal(ks[3], (DEPTH, D_MODEL, IN_WIDTH), f32) * D_MODEL ** -0.5,
        "w_out": jax.random.normal(ks[4], (DEPTH, BRANCH, D_MODEL), f32) * BRANCH ** -0.5,
        "mem_norm_g": 1.0 + 0.02 * jax.random.normal(ks[5], (DEPTH, D_MODEL), f32),
        "w_mem_kv": jax.random.normal(ks[6], (DEPTH, D_MODEL, 2 * MEM_WIDTH), f32) * D_MODEL ** -0.5,
        "diff_lambda_q1": 0.1 * jax.random.normal(ks[7], (nd, DIFF_D), f32),
        "diff_lambda_k1": 0.1 * jax.random.normal(ks[8], (nd, DIFF_D), f32),
        "diff_lambda_q2": 0.1 * jax.random.normal(ks[9], (nd, DIFF_D), f32),
        "diff_lambda_k2": 0.1 * jax.random.normal(ks[10], (nd, DIFF_D), f32),
        "diff_subln_g": 1.0 + 0.02 * jax.random.normal(ks[11], (nd, 2 * DIFF_D), f32),
        "final_norm_g": 1.0 + 0.02 * jax.random.normal(ks[12], (D_MODEL,), f32),
    }


def reference(x, mem, norm_g, w_in, w_out, mem_norm_g, w_mem_kv, diff_lambda_q1, diff_lambda_k1,
              diff_lambda_q2, diff_lambda_k2, diff_subln_g, final_norm_g):
    c1, c2, c3, c4 = MIX_WIDTH, 2 * MIX_WIDTH, 3 * MIX_WIDTH, 3 * MIX_WIDTH + MEM_WIDTH
    for i in range(DEPTH):
        h = rmsnorm(x, norm_g[i])
        proj = h @ w_in[i]
        q, k, v = proj[..., :c1], proj[..., c1:c2], proj[..., c2:c3]
        qm, gate = proj[..., c3:c4], proj[..., c4:]
        kind = i % N_MIXERS
        if kind == 0:
            mix = dilated_window_mixer(q, k, v)
        elif kind == 1:
            mix = moba_mixer(q, k, v)
        else:
            c = i // N_MIXERS
            lambda_init = 0.8 - 0.6 * math.exp(-0.3 * i)
            mix = diff_mixer(q, k, v, diff_lambda_q1[c], diff_lambda_k1[c], diff_lambda_q2[c],
                             diff_lambda_k2[c], diff_subln_g[c], lambda_init)
        mo = memory_attention(qm, rmsnorm(mem, mem_norm_g[i]), w_mem_kv[i])
        y = jnp.concatenate([mix, mo], axis=-1) * jax.nn.silu(gate)
        x = x + y @ w_out[i]
    return rmsnorm(x, final_norm_g)
```

```cpp
#include <hip/hip_runtime.h>
#include <hip/hip_bf16.h>
#include <cstdio>
#include <cstdint>
#include <cmath>

#ifndef MK_PER_PHASE
#define MK_PER_PHASE 0
#endif

constexpr int BATCH = 2, SEQ = 8192, DMODEL = 1024, DEPTH = 4, MROWS = BATCH * SEQ;
constexpr int MIXW = 768, MEMW = 256, NMEM = 256, INW = 3584;
constexpr float RMS_EPS = 1e-6f, SUBLN_EPS = 1e-5f;
constexpr float LOG2E = 1.4426950408889634f;
constexpr float QSCALE = 0.125f * LOG2E;
constexpr size_t MiB = 1u << 20;
constexpr size_t WS_CTL = 0, CTL_ZERO_BYTES = 1 * MiB;
constexpr size_t WS_WIN = 1 * MiB;
constexpr size_t WS_WOUT = 29 * MiB;
constexpr size_t WS_WMEM = 37 * MiB;
constexpr size_t WS_XB = 41 * MiB;
constexpr size_t WS_Q = 73 * MiB, WS_K = 97 * MiB, WS_V = 121 * MiB;
constexpr size_t WS_QM = 145 * MiB;
constexpr size_t WS_GATE = 153 * MiB;
constexpr size_t WS_MIX = 185 * MiB;
constexpr size_t WS_MO = 233 * MiB;
constexpr size_t WS_MEMN = 241 * MiB;
constexpr size_t WS_MEMKV = 242 * MiB;
constexpr size_t WS_LSE = 244 * MiB;
constexpr size_t WS_SSQ = 245 * MiB;
constexpr size_t WS_KPART = 246 * MiB;
constexpr size_t WS_MISC = 247 * MiB;
constexpr size_t WS_END = 248 * MiB;
constexpr int CW_BAR = 4096;
namespace pg8 {
#define PG8_LAS __attribute__((address_space(3)))
typedef unsigned short bf16_t;
typedef short bf16x8 __attribute__((ext_vector_type(8)));
typedef float f32x4 __attribute__((ext_vector_type(4)));
typedef unsigned u32x4 __attribute__((ext_vector_type(4)));
constexpr int BM = 256, BK = 64, HALF = 128, HTB = HALF * BK * 2  , STAGE_BYTES = 8 * HTB, NXCD = 8, WGM = 8;

__host__ __device__ __forceinline__ int lds_byte(int r, int c) { const int st = (r >> 4) * 2 + (c >> 5), rr = r & 15, cc = c & 31, ob = rr * 64 + cc * 2; return st * 1024 + (ob ^ (((ob >> 9) & 1) << 5)); }
__host__ __device__ __forceinline__ void stage_rc(int b, int& R, int& C) { const int st = b / 1024, sb = b % 1024, swz = sb ^ (((sb >> 9) & 1) << 5); R = (st >> 1) * 16 + swz / 64; C = (st & 1) * 32 + (swz % 64) / 2; }
__host__ __device__ __forceinline__ int perm32(int rho) { const int n = rho >> 4, i = rho & 15; return 8 * (i >> 2) + 4 * n + (i & 3); }

struct Unit { int pm, pn; };
struct Gemm { const bf16_t* A; const bf16_t* Bt; int M, N, K; };

struct StaticOrder {
    int nM, nN, nwg, G, c;
    __host__ __device__ void init(int M, int N, int G_, int c_) { nM = M / BM; nN = N / BM; nwg = nM * nN; G = G_; c = c_; }
    __host__ __device__ bool next(int i, Unit& u) const {
        const long L = (long)i * G + c; if (L >= nwg) return false;
        int wgid = (int)L; { const int q = nwg / NXCD, r = nwg % NXCD, xcd = wgid % NXCD, off = wgid / NXCD; wgid = (xcd < r ? xcd * (q + 1) : r * (q + 1) + (xcd - r) * q) + off; }
        const int nig = WGM * nN, gid = wgid / nig, fm = gid * WGM, gsz = (nM - fm) < WGM ? (nM - fm) : WGM;
        u.pm = fm + ((wgid % nig) % gsz); u.pn = (wgid % nig) / gsz; return true;
    }
    __device__ __forceinline__ void a_ready(const Unit&) const {}
    __device__ __forceinline__ void done(const Unit&) const {}
};

typedef float f32x2 __attribute__((ext_vector_type(2)));
typedef __bf16 bf16x2_t __attribute__((ext_vector_type(2)));
typedef unsigned u32x2 __attribute__((ext_vector_type(2)));
__device__ __forceinline__ unsigned cvt_pk_bf16(float lo, float hi) { f32x2 v = {lo, hi}; bf16x2_t b = __builtin_convertvector(v, bf16x2_t); return __builtin_bit_cast(unsigned, b); }

struct EpiIn {
    static constexpr bool PERM = true, AFTER_DRAIN = false;
    unsigned char* ws; int kind;
    __device__ __forceinline__ void operator()(const f32x4 (&acc)[2][2][4][2], const Unit& u, int wr, int wc, int fr, int fq) const {
        const int pn = u.pn;
        size_t boff; int ldc, colt, sh = 0;
        static_assert(WS_K - WS_Q == WS_V - WS_K, "q | k | v equally spaced");
        if (pn < 9) { const int sec = pn / 3, g = pn - 3 * sec; boff = WS_Q + (size_t)sec * (WS_K - WS_Q); ldc = MIXW; colt = g * 256; if (kind == 0) sh = 2 * g; }
        else if (pn == 9) { boff = WS_QM; ldc = MEMW; colt = 0; }
        else { boff = WS_GATE; ldc = DMODEL; colt = (pn - 10) * 256; }
        bf16_t* base = (bf16_t*)(ws + boff);
        const float* ssq = (const float*)(ws + WS_SSQ); float* kpart = (float*)(ws + WS_KPART);
        const int col0 = colt + wc * 32 + 8 * fq;
        const bool want_ksum = (kind == 1) && (pn >= 3) && (pn < 6);
#pragma unroll
        for (int ai = 0; ai < 2; ++ai)
#pragma unroll
            for (int m = 0; m < 4; ++m) {
                const int row = u.pm * BM + ai * HALF + wr * 64 + m * 16 + fr;
                const f32x4 sp = *(const f32x4*)(ssq + (size_t)row * 16 + 4 * fq);
                float s = (sp[0] + sp[1]) + (sp[2] + sp[3]);
                s += __shfl_xor(s, 16); s += __shfl_xor(s, 32);
                const float rstd = 1.0f / sqrtf(s * (1.0f / DMODEL) + RMS_EPS);
                int orow = row;
                if (sh) { const int b = row >> 13, t = row & (SEQ - 1); orow = (b << 13) + ((t & ((1 << sh) - 1)) << (13 - sh)) + (t >> sh); }
                bf16_t* rowp = base + (size_t)orow * ldc + col0;
#pragma unroll
                for (int bj = 0; bj < 2; ++bj) {
                    const f32x4 v0 = acc[ai][bj][m][0] * rstd, v1 = acc[ai][bj][m][1] * rstd;
                    u32x4 w; w.x = cvt_pk_bf16(v0[0], v0[1]); w.y = cvt_pk_bf16(v0[2], v0[3]); w.z = cvt_pk_bf16(v1[0], v1[1]); w.w = cvt_pk_bf16(v1[2], v1[3]);
                    *(u32x4*)(rowp + bj * HALF) = w;
                }
                if (m & 1) asm volatile("" ::: "memory");
            }
        if (want_ksum) {
            float rs[2][4];
#pragma unroll
            for (int ai = 0; ai < 2; ++ai)
#pragma unroll
                for (int m = 0; m < 4; ++m) {
                    const int row = u.pm * BM + ai * HALF + wr * 64 + m * 16 + fr;
                    const f32x4 sp = *(const f32x4*)(ssq + (size_t)row * 16 + 4 * fq);
                    float s = (sp[0] + sp[1]) + (sp[2] + sp[3]);
                    s += __shfl_xor(s, 16); s += __shfl_xor(s, 32);
                    rs[ai][m] = 1.0f / sqrtf(s * (1.0f / DMODEL) + RMS_EPS);
                }
#pragma unroll
            for (int bj = 0; bj < 2; ++bj)
#pragma unroll
                for (int n = 0; n < 2; ++n) {
                    f32x4 v = (f32x4){0.f, 0.f, 0.f, 0.f};
#pragma unroll
                    for (int ai = 0; ai < 2; ++ai)
#pragma unroll
                        for (int m = 0; m < 4; ++m) v += acc[ai][bj][m][n] * rs[ai][m];
#pragma unroll
                    for (int e = 0; e < 4; ++e) { float x = v[e]; x += __shfl_xor(x, 1); x += __shfl_xor(x, 2); x += __shfl_xor(x, 4); x += __shfl_xor(x, 8); v[e] = x; }
                    if (fr == 0) *(f32x4*)(kpart + (size_t)(u.pm * 2 + wr) * MIXW + (pn - 3) * 256 + bj * HALF + wc * 32 + 8 * fq + 4 * n) = v;
                }
        }
    }
};
struct EpiPlain {
    static constexpr bool PERM = true, AFTER_DRAIN = false;
    bf16_t* O; int ldc;
    __device__ __forceinline__ void operator()(const f32x4 (&acc)[2][2][4][2], const Unit& u, int wr, int wc, int fr, int fq) const {
        const int col0 = u.pn * BM + wc * 32 + 8 * fq;
#pragma unroll
        for (int ai = 0; ai < 2; ++ai)
#pragma unroll
            for (int m = 0; m < 4; ++m) {
                bf16_t* rowp = O + (size_t)(u.pm * BM + ai * HALF + wr * 64 + m * 16 + fr) * ldc + col0;
#pragma unroll
                for (int bj = 0; bj < 2; ++bj) {
                    const f32x4 v0 = acc[ai][bj][m][0], v1 = acc[ai][bj][m][1];
                    u32x4 w; w.x = cvt_pk_bf16(v0[0], v0[1]); w.y = cvt_pk_bf16(v0[2], v0[3]); w.z = cvt_pk_bf16(v1[0], v1[1]); w.w = cvt_pk_bf16(v1[2], v1[3]);
                    *(u32x4*)(rowp + bj * HALF) = w;
                }
            }
    }
};
struct EpiOut {
    static constexpr bool PERM = false, AFTER_DRAIN = false;
    const float* xin; float* xout; bf16_t* xb; float* ssq;
    __device__ __forceinline__ void operator()(const f32x4 (&acc)[2][2][4][2], const Unit& u, int wr, int wc, int fr, int fq) const {
        const int col0 = u.pn * BM + wc * 32 + 4 * fq;
#pragma unroll
        for (int ai = 0; ai < 2; ++ai)
#pragma unroll
            for (int m = 0; m < 4; ++m) {
                const int row = u.pm * BM + ai * HALF + wr * 64 + m * 16 + fr;
                const size_t off = (size_t)row * DMODEL + col0;
                float s = 0.f;
#pragma unroll
                for (int bj = 0; bj < 2; ++bj)
#pragma unroll
                    for (int n = 0; n < 2; ++n) {
                        const size_t o = off + bj * HALF + n * 16;
                        const f32x4 v = *(const f32x4*)(xin + o) + acc[ai][bj][m][n];
                        *(f32x4*)(xout + o) = v;
                        u32x2 w; w.x = cvt_pk_bf16(v[0], v[1]); w.y = cvt_pk_bf16(v[2], v[3]);
                        *(u32x2*)(xb + o) = w;
                        s += (v[0] * v[0] + v[1] * v[1]) + (v[2] * v[2] + v[3] * v[3]);
                    }
                s += __shfl_xor(s, 16); s += __shfl_xor(s, 32);
                if (fq == 0) ssq[(size_t)row * 16 + u.pn * 4 + wc] = s;
            }
    }
};
struct TailOrder {
    int nM, nN, G, c;
    __device__ bool next(int i, Unit& u) const { const int nwg = nM * nN; int idx = c - (G - nwg); if (G < nwg) idx = c; idx += i * G; if (idx < 0 || idx >= nwg || (i > 0 && G >= nwg)) return false; u.pm = idx % nM; u.pn = idx / nM; return true; }
    __device__ __forceinline__ void a_ready(const Unit&) const {}
    __device__ __forceinline__ void done(const Unit&) const {}
};
template <class Epi, class Sched, bool ALIGN_EPI = false, bool SP2 = false>
__device__ __forceinline__ void gemm_phase(PG8_LAS unsigned char* lds, const Gemm g, const Sched& S, const Epi& E) {
    int tid_ = threadIdx.x; asm volatile("" : "+v"(tid_));
    const int tid = tid_, wid = __builtin_amdgcn_readfirstlane(tid >> 6), lane = tid & 63, wr = wid >> 2, wc = wid & 3, fr = lane & 15, fq = lane >> 4;
    const int K = g.K, nt = K / BK;
    unsigned voffA[2], voffB[2];
#pragma unroll
    for (int i = 0; i < 2; ++i) { int R, C; stage_rc(tid * 16 + i * 8192, R, C); const int Rb = Epi::PERM ? ((R & ~31) + perm32(R & 31)) : R;
        voffA[i] = (unsigned)(R * K + C) * 2u; voffB[i] = (unsigned)(Rb * K + C) * 2u; }
    const size_t kstep = (size_t)(BK * 2);
    const size_t hstep = (size_t)HALF * K * 2;
    const size_t tstep = 2 * hstep;
    const unsigned ldsw = (unsigned)wid * 1024u;
    const int aoff = lds_byte(wr * 64 + fr, fq * 8), boff = lds_byte(wc * 32 + fr, fq * 8);
#define PG8_SA(b, h) (((b) * 2 + (h)) * HTB)
#define PG8_SB(b, h) ((4 + (b) * 2 + (h)) * HTB)
#define PG8_STAGE(bufoff, gbase, voff) do { _Pragma("unroll") for (int _i = 0; _i < 2; ++_i) \
        __builtin_amdgcn_global_load_lds((const unsigned*)((const char*)(gbase) + (voff)[_i]), (PG8_LAS unsigned*)(lds + (bufoff) + ldsw + _i * 8192), 16, 0, 0); } while (0)
#define PG8_LDA(dst, b, h) do { _Pragma("unroll") for (int m = 0; m < 4; ++m) _Pragma("unroll") for (int k = 0; k < 2; ++k) dst[m][k] = *(const PG8_LAS bf16x8*)(lds + PG8_SA(b, h) + aoff + m * 2048 + k * 1024); } while (0)
#define PG8_LDB(dst, b, h) do { _Pragma("unroll") for (int n = 0; n < 2; ++n) _Pragma("unroll") for (int k = 0; k < 2; ++k) dst[n][k] = *(const PG8_LAS bf16x8*)(lds + PG8_SB(b, h) + boff + n * 2048 + k * 1024); } while (0)
#define PG8_MMA(ai, bj, At, Bt) do { __builtin_amdgcn_s_setprio(1); _Pragma("unroll") for (int m = 0; m < 4; ++m) _Pragma("unroll") for (int n = 0; n < 2; ++n) _Pragma("unroll") for (int k = 0; k < 2; ++k) \
        acc[ai][bj][m][n] = __builtin_amdgcn_mfma_f32_16x16x32_bf16(Bt[n][k], At[m][k], acc[ai][bj][m][n], 0, 0, 0); __builtin_amdgcn_s_setprio(0); } while (0)
#define PG8_WAIT_V(n) asm volatile("s_waitcnt vmcnt(" #n ")" ::: "memory")
#define PG8_WAIT_L(n) asm volatile("s_waitcnt lgkmcnt(" #n ")" ::: "memory")
#define PG8_BAR __builtin_amdgcn_s_barrier()
#define PG8_SCHED __builtin_amdgcn_sched_barrier(0)
    Unit cur, nxt; int ui = 0;
    if (!S.next(0, cur)) return;
    f32x4 acc[2][2][4][2];
#pragma unroll
    for (int a = 0; a < 2; ++a)
#pragma unroll
        for (int b = 0; b < 2; ++b)
#pragma unroll
            for (int m = 0; m < 4; ++m)
#pragma unroll
                for (int n = 0; n < 2; ++n) acc[a][b][m][n] = (f32x4){0.f, 0.f, 0.f, 0.f};
    bf16x8 At[4][2], B0[2][2], B1[2][2];
    const char* cA = (const char*)g.A + (size_t)cur.pm * tstep; const char* cB = (const char*)g.Bt + (size_t)cur.pn * tstep;
    S.a_ready(cur);
    if constexpr (SP2) {
        PG8_STAGE(PG8_SB(0, 0), cB, voffB); PG8_STAGE(PG8_SB(0, 1), cB + hstep, voffB); PG8_STAGE(PG8_SA(0, 0), cA, voffA); PG8_STAGE(PG8_SA(0, 1), cA + hstep, voffA);
        if (wr == 1) PG8_BAR;
        PG8_WAIT_V(2); PG8_BAR;
        PG8_STAGE(PG8_SB(1, 0), cB + kstep, voffB); PG8_STAGE(PG8_SA(1, 0), cA + kstep, voffA); PG8_STAGE(PG8_SB(1, 1), cB + hstep + kstep, voffB);
        PG8_WAIT_V(6); PG8_BAR;
    } else {
        PG8_STAGE(PG8_SB(0, 0), cB, voffB); PG8_STAGE(PG8_SA(0, 0), cA, voffA); PG8_STAGE(PG8_SB(0, 1), cB + hstep, voffB); PG8_STAGE(PG8_SA(0, 1), cA + hstep, voffA);
        if (wr == 1) PG8_BAR;
        PG8_WAIT_V(4); PG8_BAR;
        PG8_STAGE(PG8_SB(1, 0), cB + kstep, voffB); PG8_STAGE(PG8_SA(1, 0), cA + kstep, voffA); PG8_STAGE(PG8_SB(1, 1), cB + hstep + kstep, voffB);
        PG8_WAIT_V(6); PG8_BAR;
    }
    for (;;) {
        const bool has_next = S.next(ui + 1, nxt);
        const char* nA = has_next ? (const char*)g.A + (size_t)nxt.pm * tstep : cA; const char* nB = has_next ? (const char*)g.Bt + (size_t)nxt.pn * tstep : cB;
        for (int t = 0; t < nt; t += 2) {
            const bool last = (t == nt - 2);
            const char* a1 = cA + (size_t)(t + 1) * kstep;
            const char* a2 = last ? nA : cA + (size_t)(t + 2) * kstep; const char* b2 = last ? nB : cB + (size_t)(t + 2) * kstep;
            const char* a3 = a2 + kstep; const char* b3 = b2 + kstep;
            if (last && has_next) S.a_ready(nxt);
            if constexpr (SP2) {
            PG8_LDB(B0, 0, 0); PG8_LDB(B1, 0, 1); PG8_SCHED; PG8_LDA(At, 0, 0); PG8_STAGE(PG8_SA(1, 1), a1 + hstep, voffA);
            PG8_WAIT_V(8); PG8_WAIT_L(0); PG8_BAR; PG8_MMA(0, 0, At, B0); PG8_MMA(0, 1, At, B1); PG8_BAR; PG8_SCHED;
            PG8_LDA(At, 0, 1); PG8_STAGE(PG8_SB(0, 0), b2, voffB); PG8_STAGE(PG8_SB(0, 1), b2 + hstep, voffB); PG8_STAGE(PG8_SA(0, 0), a2, voffA);
            PG8_WAIT_V(8); PG8_WAIT_L(0); PG8_BAR; PG8_MMA(1, 0, At, B0); PG8_MMA(1, 1, At, B1); PG8_BAR; PG8_SCHED;
            PG8_LDB(B0, 1, 0); PG8_LDB(B1, 1, 1); PG8_SCHED; PG8_LDA(At, 1, 0); PG8_STAGE(PG8_SA(0, 1), a2 + hstep, voffA);
            PG8_WAIT_V(8); PG8_WAIT_L(0); PG8_BAR; PG8_MMA(0, 0, At, B0); PG8_MMA(0, 1, At, B1); PG8_BAR; PG8_SCHED;
            PG8_LDA(At, 1, 1); PG8_STAGE(PG8_SB(1, 0), b3, voffB); PG8_STAGE(PG8_SB(1, 1), b3 + hstep, voffB); PG8_STAGE(PG8_SA(1, 0), a3, voffA);
            PG8_WAIT_V(8); PG8_WAIT_L(0); PG8_BAR; PG8_MMA(1, 0, At, B0); PG8_MMA(1, 1, At, B1); PG8_BAR; PG8_SCHED;
            } else {
            PG8_LDB(B0, 0, 0); PG8_SCHED; PG8_LDA(At, 0, 0); PG8_STAGE(PG8_SA(1, 1), a1 + hstep, voffA);
            PG8_WAIT_L(8); PG8_BAR; PG8_WAIT_L(0); PG8_MMA(0, 0, At, B0); PG8_BAR; PG8_SCHED;
            PG8_LDB(B1, 0, 1); PG8_STAGE(PG8_SB(0, 0), b2, voffB);
            PG8_BAR; PG8_WAIT_L(0); PG8_MMA(0, 1, At, B1); PG8_BAR;
            PG8_LDA(At, 0, 1); PG8_STAGE(PG8_SA(0, 0), a2, voffA);
            PG8_BAR; PG8_WAIT_L(0); PG8_MMA(1, 0, At, B0); PG8_BAR; PG8_SCHED;
            PG8_STAGE(PG8_SB(0, 1), b2 + hstep, voffB);
            PG8_WAIT_V(6); PG8_BAR; PG8_MMA(1, 1, At, B1); PG8_BAR;
            PG8_LDB(B0, 1, 0); PG8_SCHED; PG8_LDA(At, 1, 0); PG8_STAGE(PG8_SA(0, 1), a2 + hstep, voffA);
            PG8_WAIT_L(8); PG8_BAR; PG8_WAIT_L(0); PG8_MMA(0, 0, At, B0); PG8_BAR; PG8_SCHED;
            PG8_LDB(B1, 1, 1); PG8_STAGE(PG8_SB(1, 0), b3, voffB);
            PG8_BAR; PG8_WAIT_L(0); PG8_MMA(0, 1, At, B1); PG8_BAR;
            PG8_LDA(At, 1, 1); PG8_STAGE(PG8_SA(1, 0), a3, voffA);
            PG8_BAR; PG8_WAIT_L(0); PG8_MMA(1, 0, At, B0); PG8_BAR; PG8_SCHED;
            PG8_STAGE(PG8_SB(1, 1), b3 + hstep, voffB);
            PG8_WAIT_V(6); PG8_BAR; PG8_MMA(1, 1, At, B1); PG8_BAR;
            }
        }
        if constexpr (ALIGN_EPI) { if (wr == 0) PG8_BAR; }
        if constexpr (!Epi::AFTER_DRAIN) { E(acc, cur, wr, wc, fr, fq); S.done(cur); }
        if (!has_next) break;
#pragma unroll
        for (int a = 0; a < 2; ++a)
#pragma unroll
            for (int b = 0; b < 2; ++b)
#pragma unroll
                for (int m = 0; m < 4; ++m)
#pragma unroll
                    for (int n = 0; n < 2; ++n) acc[a][b][m][n] = (f32x4){0.f, 0.f, 0.f, 0.f};
        cur = nxt; cA = nA; cB = nB; ++ui;
        if constexpr (ALIGN_EPI) { if (wr == 1) PG8_BAR; }
    }
    PG8_WAIT_V(0);
    if constexpr (!ALIGN_EPI) { if (wr == 0) PG8_BAR; }
    PG8_BAR;
    if constexpr (Epi::AFTER_DRAIN) { E.fused(acc, cur, wr, wc, fr, fq, lds, wid, lane); S.done(cur); }
#undef PG8_SA
#undef PG8_SB
#undef PG8_STAGE
#undef PG8_LDA
#undef PG8_LDB
#undef PG8_MMA
#undef PG8_WAIT_V
#undef PG8_WAIT_L
#undef PG8_BAR
#undef PG8_SCHED
}
}
namespace att {
#define LAS __attribute__((address_space(3)))
typedef unsigned short bf16_t;
typedef short bf16x8 __attribute__((ext_vector_type(8)));
typedef short s16x4 __attribute__((ext_vector_type(4)));
typedef short v4i16_t __attribute__((ext_vector_type(4)));
typedef float f32x16 __attribute__((ext_vector_type(16)));
typedef float f32x4 __attribute__((ext_vector_type(4)));
typedef float f32x2_t __attribute__((ext_vector_type(2)));
typedef __bf16 bf16x2_t __attribute__((ext_vector_type(2)));
typedef unsigned u32x4 __attribute__((ext_vector_type(4)));
typedef LAS char* lptr;
typedef LAS const char* lcptr;
constexpr int NW = 8;
constexpr int KSLOT = 8192, VSLOT = 16384;
constexpr int L_K = 0, L_V = 2 * KSLOT, L_WS = L_V + 2 * VSLOT, L_OST = L_WS + NW * 256, L_KM = L_OST + NW * 8192, L_END = L_KM + 8192;
constexpr float NEG_INF = -INFINITY;

__device__ __forceinline__ int crow(int r, int hi) { return (r & 3) + 8 * (r >> 2) + 4 * hi; }
__device__ __forceinline__ unsigned cvtpk(float lo, float hi) { f32x2_t v = {lo, hi}; bf16x2_t b = __builtin_convertvector(v, bf16x2_t); return __builtin_bit_cast(unsigned, b); }
__device__ __forceinline__ void glds16(const void* gsrc, unsigned lds_dst) { unsigned keep;
    asm volatile("s_mov_b32 %0, m0\n\ts_mov_b32 m0, %2\n\ts_nop 0\n\tglobal_load_lds_dwordx4 %1, off\n\ts_mov_b32 m0, %0" : "=&s"(keep) : "v"(gsrc), "s"(lds_dst) : "memory"); }
#define ATT_WAIT_BAR() asm volatile("s_waitcnt vmcnt(0) lgkmcnt(0)\n\ts_barrier" ::: "memory")
#define ATT_MFMA(a, b, c) __builtin_amdgcn_mfma_f32_32x32x16_bf16(a, b, c, 0, 0, 0)
__device__ __forceinline__ s16x4 vtr(lcptr p) { return __builtin_bit_cast(s16x4, __builtin_amdgcn_ds_read_tr16_b64_v4i16((LAS v4i16_t*)p)); }
__device__ __forceinline__ float swap_half(float v) { auto rr = __builtin_amdgcn_permlane32_swap(__float_as_uint(v), __float_as_uint(v), false, false); const int hi = (threadIdx.x >> 5) & 1; return __uint_as_float(hi ? rr[0] : rr[1]); }
__device__ __forceinline__ float rowmax(const f32x16& p0, const f32x16& p1) {
    float a = fmaxf(fmaxf(p0[0], p0[1]), p1[0]), b = fmaxf(fmaxf(p0[2], p0[3]), p1[1]); a = fmaxf(fmaxf(a, p1[2]), p1[3]);
#pragma unroll
    for (int r = 4; r < 16; r += 4) { a = fmaxf(fmaxf(a, p0[r]), p0[r + 1]); b = fmaxf(fmaxf(b, p0[r + 2]), p0[r + 3]); a = fmaxf(fmaxf(a, p1[r]), p1[r + 1]); b = fmaxf(fmaxf(b, p1[r + 2]), p1[r + 3]); }
    const float m = fmaxf(a, b);
    return fmaxf(m, swap_half(m));
}

struct BMNone {
    __device__ __forceinline__ bool active(int) const { return true; }
    __device__ __forceinline__ void cinit(int, f32x16& c0, f32x16& c1) const { c0 = f32x16{}; c1 = f32x16{}; }
    __device__ __forceinline__ void mask(int, f32x16&, f32x16&) const {}
};
struct BMBand {
    int qpos, qlo, W, hi; float slope2;
    __device__ __forceinline__ void init(int qpos_, int qlo_, int W_, float slope2_, int hi_) { qpos = qpos_; qlo = qlo_; W = W_; slope2 = slope2_; hi = hi_; }
    __device__ __forceinline__ bool active(int t) const { return (64 * t <= qlo + 31) && (64 * t + 63 >= qlo - W); }
    __device__ __forceinline__ void cinit(int t, f32x16& c0, f32x16& c1) const { const float base = slope2 * (float)(64 * t + 4 * hi - qpos), base1 = base + 32.f * slope2;
#pragma unroll
        for (int r = 0; r < 16; ++r) { const float cf = (float)((r & 3) + 8 * (r >> 2)); c0[r] = __builtin_fmaf(slope2, cf, base); c1[r] = __builtin_fmaf(slope2, cf, base1); } }
    __device__ __forceinline__ void mask(int t, f32x16& p0, f32x16& p1) const {
        if ((64 * t + 63 > qlo) || (64 * t < qlo + 31 - W)) {
            const int d0 = qpos - 64 * t - 4 * hi;
#pragma unroll
            for (int r = 0; r < 16; ++r) { const int d = d0 - ((r & 3) + 8 * (r >> 2)); if (d < 0 || d > W) p0[r] = NEG_INF; const int e = d - 32; if (e < 0 || e > W) p1[r] = NEG_INF; }
        }
    }
};
struct BMMoba {
    BMBand band; unsigned sel; int qb;
    __device__ __forceinline__ bool active(int t) const { const int j = t >> 2; if (j == qb) return band.active(t); return __builtin_amdgcn_ballot_w64(((sel >> j) & 1u) != 0u) != 0ull; }
    __device__ __forceinline__ void cinit(int t, f32x16& c0, f32x16& c1) const { band.cinit(t, c0, c1); }
    __device__ __forceinline__ void mask(int t, f32x16& p0, f32x16& p1) const { const int j = t >> 2;
        if (j == qb) band.mask(t, p0, p1);
        else if (((sel >> j) & 1u) == 0u) {
#pragma unroll
            for (int r = 0; r < 16; ++r) { p0[r] = NEG_INF; p1[r] = NEG_INF; } } }
};

template <int DV, class BM>
__device__ __forceinline__ void flash_loop(lptr L, const bf16x8 (&qr)[4], const bf16_t* Kb, const bf16_t* Vb, int kp, int vp, int t_hi, int t_lo, const BM& bm,
                                           f32x16 (&o)[DV / 32], float& m_run, float& l_run) {
    int tid_ = threadIdx.x; asm volatile("" : "+v"(tid_));
    const int tid = tid_, lane = tid & 63, r32 = lane & 31, hi = lane >> 5;
    const int wid = __builtin_amdgcn_readfirstlane(tid >> 6);
    const unsigned lds0 = (unsigned)(uintptr_t)L;
    LAS float* wsf = (LAS float*)(L + L_WS) + wid * 64;
    const bf16_t* ksrc = Kb + (size_t)lane * kp + wid * 8;
    const bf16_t* vsrc = Vb + (size_t)(16 * (wid & 3) + (lane >> 2)) * vp + (wid >> 2) * 32 + (lane & 3) * 8;
    const unsigned kdst = lds0 + L_K + wid * 1024, vdst = lds0 + L_V + wid * 1024;
#define ATT_DMA(t, slot) do { glds16(ksrc + (size_t)(t) * 64 * kp, (unsigned)__builtin_amdgcn_readfirstlane(kdst + (slot) * KSLOT)); \
        glds16(vsrc + (size_t)(t) * 64 * vp, (unsigned)__builtin_amdgcn_readfirstlane(vdst + (slot) * VSLOT)); \
        if (DV == 128) glds16(vsrc + (size_t)(t) * 64 * vp + 64, (unsigned)__builtin_amdgcn_readfirstlane(vdst + (slot) * VSLOT + 8192)); } while (0)
    const lcptr kp0 = (lcptr)L + L_K + hi * 1024 + r32 * 16;
    const lcptr vp0 = (lcptr)L + L_V + ((lane >> 4) & 1) * 32 + (lane & 3) * 8 + (4 * hi + ((lane & 15) >> 2)) * 64;
    ATT_DMA(t_hi, 0); ATT_WAIT_BAR();
    int slot = 0;
    for (int t = t_hi; t >= t_lo; --t) {
        if (t > t_lo) ATT_DMA(t - 1, slot ^ 1);
        if (bm.active(t)) {
            f32x16 p0, p1; bm.cinit(t, p0, p1);
            const lcptr kq = kp0 + slot * KSLOT;
#pragma unroll
            for (int d0 = 0; d0 < 4; ++d0) {
                const bf16x8 k0 = *(const LAS bf16x8*)(kq + d0 * 2048), k1 = *(const LAS bf16x8*)(kq + d0 * 2048 + 512);
                p0 = ATT_MFMA(k0, qr[d0], p0); p1 = ATT_MFMA(k1, qr[d0], p1);
            }
            bm.mask(t, p0, p1);
            const float mt = rowmax(p0, p1), mn = fmaxf(m_run, mt);
            if (__builtin_amdgcn_ballot_w64(mn > m_run) != 0ull) {
                const float mu = (mn == NEG_INF) ? 0.f : mn;
                const float f = __builtin_amdgcn_exp2f(m_run - mu);
                l_run *= f; m_run = mn;
                if (hi == 0) wsf[r32] = f;
#pragma unroll
                for (int r = 0; r < 16; ++r) { const float fr_ = wsf[crow(r, hi)];
#pragma unroll
                    for (int d = 0; d < DV / 32; ++d) o[d][r] *= fr_; }
            }
            const float mu = (m_run == NEG_INF) ? 0.f : m_run;
            float s0 = 0.f, s1 = 0.f;
#pragma unroll
            for (int r = 0; r < 16; ++r) { p0[r] = __builtin_amdgcn_exp2f(p0[r] - mu); p1[r] = __builtin_amdgcn_exp2f(p1[r] - mu); s0 += p0[r]; s1 += p1[r]; }
            l_run += s0 + s1;
            u32x4 pw0, pw1, pw2, pw3;
            pw0 = (u32x4){cvtpk(p0[0], p0[1]), cvtpk(p0[2], p0[3]), cvtpk(p0[4], p0[5]), cvtpk(p0[6], p0[7])};
            pw1 = (u32x4){cvtpk(p0[8], p0[9]), cvtpk(p0[10], p0[11]), cvtpk(p0[12], p0[13]), cvtpk(p0[14], p0[15])};
            pw2 = (u32x4){cvtpk(p1[0], p1[1]), cvtpk(p1[2], p1[3]), cvtpk(p1[4], p1[5]), cvtpk(p1[6], p1[7])};
            pw3 = (u32x4){cvtpk(p1[8], p1[9]), cvtpk(p1[10], p1[11]), cvtpk(p1[12], p1[13]), cvtpk(p1[14], p1[15])};
            const bf16x8 pa0 = __builtin_bit_cast(bf16x8, pw0), pa1 = __builtin_bit_cast(bf16x8, pw1), pa2 = __builtin_bit_cast(bf16x8, pw2), pa3 = __builtin_bit_cast(bf16x8, pw3);
            const lcptr vq = vp0 + slot * VSLOT;
#pragma unroll
            for (int d = 0; d < DV / 32; ++d) {
                s16x4 lo[4], hh[4];
#pragma unroll
                for (int ks = 0; ks < 4; ++ks) { lo[ks] = vtr(vq + d * 4096 + ks * 1024); hh[ks] = vtr(vq + d * 4096 + ks * 1024 + 512); }
#define ATT_PK(k) (bf16x8){lo[k][0], lo[k][1], lo[k][2], lo[k][3], hh[k][0], hh[k][1], hh[k][2], hh[k][3]}
                o[d] = ATT_MFMA(pa0, ATT_PK(0), o[d]); o[d] = ATT_MFMA(pa1, ATT_PK(1), o[d]); o[d] = ATT_MFMA(pa2, ATT_PK(2), o[d]); o[d] = ATT_MFMA(pa3, ATT_PK(3), o[d]);
#undef ATT_PK
            }
        }
        ATT_WAIT_BAR(); slot ^= 1;
    }
#undef ATT_DMA
}

template <int DV, class RowPtr>
__device__ __forceinline__ float finish_unit(lptr L, f32x16 (&o)[DV / 32], float m_run, float l_run, const RowPtr& rp) {
    int tid_ = threadIdx.x; asm volatile("" : "+v"(tid_));
    const int tid = tid_, lane = tid & 63, r32 = lane & 31, hi = lane >> 5;
    const int wid = __builtin_amdgcn_readfirstlane(tid >> 6);
    LAS float* wsf = (LAS float*)(L + L_WS) + wid * 64;
    const float l_tot = l_run + swap_half(l_run);
    if (hi == 0) wsf[32 + r32] = l_tot;
    LAS bf16_t* stg = (LAS bf16_t*)(L + L_OST + wid * 8192);
#pragma unroll
    for (int r = 0; r < 16; ++r) { const int orow = crow(r, hi); const float rl = __builtin_amdgcn_rcpf(wsf[32 + orow]);
#pragma unroll
        for (int d = 0; d < DV / 32; ++d) { const __hip_bfloat16 hv = __float2bfloat16(o[d][r] * rl); stg[orow * DV + d * 32 + r32] = __builtin_bit_cast(unsigned short, hv); } }
    constexpr int CPR = DV / 8;
#pragma unroll
    for (int it = 0; it < DV / 16; ++it) { const int idx = it * 64 + lane, row = idx / CPR, ch = idx % CPR;
        const u32x4 v = *(const LAS u32x4*)((lcptr)stg + row * (DV * 2) + ch * 16);
        *(u32x4*)(rp(row) + ch * 8) = v; }
    return m_run + __builtin_amdgcn_logf(l_tot);
}
__device__ __forceinline__ void load_q(bf16x8 (&qr)[4], const bf16_t* qrow, int hi) {
#pragma unroll
    for (int d0 = 0; d0 < 4; ++d0) qr[d0] = *(const bf16x8*)(qrow + d0 * 16 + hi * 8);
}
__device__ __forceinline__ float alibi2(int i, int n) { return exp2f(-8.0f * (float)(i + 1) / (float)n) * LOG2E; }
}
constexpr int RING_OFF = 0, RING_BYTES = 131072;
constexpr int LDSCTL_OFF = RING_BYTES, MISC_OFF = LDSCTL_OFF + 320;
constexpr int LDS_BYTES = 147456;
static_assert(att::L_END <= RING_BYTES, "attention LDS map");
constexpr int NWAVES = 8;
constexpr int NPHASES = 2 + 4 * DEPTH;

#define GAS __attribute__((address_space(1)))
#define LAS __attribute__((address_space(3)))
typedef unsigned short bf16;
typedef unsigned v4u __attribute__((ext_vector_type(4)));
typedef float f32x4 __attribute__((ext_vector_type(4)));
typedef short bf16x8 __attribute__((ext_vector_type(8)));
typedef GAS unsigned gu32;
typedef GAS unsigned long long gu64;
#define RLX_AGENT __ATOMIC_RELAXED, __HIP_MEMORY_SCOPE_AGENT
#define LDS_WAIT() asm volatile("s_waitcnt lgkmcnt(0)" ::: "memory")
#define VM_WAIT() asm volatile("s_waitcnt vmcnt(0)" ::: "memory")
__device__ __forceinline__ unsigned long long rt() { return __builtin_amdgcn_s_memrealtime(); }
__device__ __forceinline__ unsigned f2bf(float f) { unsigned u = __builtin_bit_cast(unsigned, f); return (u + 0x7fffu + ((u >> 16) & 1u)) >> 16; }
__device__ __forceinline__ unsigned pk2(float lo, float hi) { return f2bf(lo) | (f2bf(hi) << 16); }
#define XB_TMO      128
#define XB_XCNT(j)  (256  + 64 * (j))
#define XB_XSUB(j)  (1280 + 64 * (j))
#define XB_XGEN(j)  (2304 + 64 * (j))
#define XB_TOP      3328
#define XB_TOPGEN   3392
#define XCD_BAR_WORDS 3456
#define XB_SPIN_CAP (1u << 18)

__device__ __forceinline__ unsigned xb_ld(unsigned* p)              { return __hip_atomic_load(p, __ATOMIC_RELAXED, __HIP_MEMORY_SCOPE_AGENT); }
__device__ __forceinline__ unsigned xb_add(unsigned* p, unsigned v) { return __hip_atomic_fetch_add(p, v, __ATOMIC_RELAXED, __HIP_MEMORY_SCOPE_AGENT); }
__device__ __forceinline__ unsigned xb_xcc_id() { return (unsigned)__builtin_amdgcn_s_getreg((3 << 11) | 20) & 0xFu; }
#define XB_SPIN(cond, bar) do { unsigned _sp = 0; while (cond) { __builtin_amdgcn_s_sleep(1); \
    if ((++_sp & 255u) == 0u) { if (xb_ld(&(bar)[XB_TMO])) break; if (_sp > XB_SPIN_CAP) { atomicAdd(&(bar)[XB_TMO], 1u); break; } } } } while (0)

struct XcdBarrier {
    unsigned* bar; unsigned x;
    volatile LAS unsigned* st;
};

__device__ __forceinline__ XcdBarrier xcd_barrier_post(unsigned* bar, volatile LAS unsigned* st) {
    XcdBarrier b; b.bar = bar; b.x = xb_xcc_id(); b.st = st;
    if (threadIdx.x == 0) (void)xb_add(&bar[XB_XCNT(b.x)], 1u);
    return b;
}
__device__ __forceinline__ void xcd_barrier_complete(unsigned* bar, unsigned x, unsigned& nloc, unsigned& nx) {
    const unsigned G = gridDim.x * gridDim.y * gridDim.z;
    unsigned sum, cnt, mine, sp = 0u;
    for (;;) {
        sum = 0u; cnt = 0u; mine = 0u;
#pragma unroll
        for (unsigned j = 0; j < 16; ++j) { const unsigned c = xb_ld(&bar[XB_XCNT(j)]); sum += c; cnt += (c > 0u) ? 1u : 0u; mine = (j == x) ? c : mine; }
        if (sum == G) break;
        __builtin_amdgcn_s_sleep(1);
        if ((++sp & 255u) == 0u) { if (xb_ld(&bar[XB_TMO])) break; if (sp > XB_SPIN_CAP) { atomicAdd(&bar[XB_TMO], 1u); break; } }
    }
    nloc = mine > 0u ? mine : 1u; nx = cnt > 0u ? cnt : 1u;
}

__device__ __forceinline__ void xcd_barrier(const XcdBarrier& b) {
    asm volatile("s_waitcnt vmcnt(0)" ::: "memory");
    __syncthreads();
    if (threadIdx.x == 0) {
        unsigned* bar = b.bar;
        __builtin_amdgcn_s_waitcnt(0);
        unsigned nloc = b.st[0], nx = b.st[1];
        if (nloc == 0u) { xcd_barrier_complete(bar, b.x, nloc, nx); b.st[0] = nloc; b.st[1] = nx; }
        const unsigned old = xb_add(&bar[XB_XSUB(b.x)], 1u);
        const unsigned gen = old / nloc;
        if (old + 1u == (gen + 1u) * nloc) {
            __builtin_amdgcn_fence(__ATOMIC_RELEASE, "agent");
            asm volatile("s_waitcnt vmcnt(0)" ::: "memory");
            const unsigned og = xb_add(&bar[XB_TOP], 1u);
            const unsigned tg = og / nx;
            if (og + 1u == (tg + 1u) * nx) xb_add(&bar[XB_TOPGEN], 1u);
            else XB_SPIN(xb_ld(&bar[XB_TOPGEN]) == tg, bar);
            __builtin_amdgcn_fence(__ATOMIC_ACQUIRE, "agent");
            xb_add(&bar[XB_XGEN(b.x)], 1u);
            asm volatile("s_waitcnt vmcnt(0)" ::: "memory");
        } else {
            XB_SPIN(xb_ld(&bar[XB_XGEN(b.x)]) == gen, bar);
            __builtin_amdgcn_fence(__ATOMIC_ACQUIRE, "agent");
            asm volatile("s_waitcnt vmcnt(0)" ::: "memory");
        }
    }
    __syncthreads();
}
struct Args { const float* in[13]; float* out; unsigned char* ws; int ph_lo, ph_hi, li, pad; };
struct Frame {
    LAS unsigned char* lds;
    int tid, lane, wave, vcu, G;
    unsigned char* ws;
};
#define IN_X(a) ((a).in[0])
#define IN_MEM(a) ((a).in[1])
#define IN_NORM_G(a) ((a).in[2])
#define IN_W_IN(a) ((a).in[3])
#define IN_W_OUT(a) ((a).in[4])
#define IN_MEM_NORM_G(a) ((a).in[5])
#define IN_W_MEM_KV(a) ((a).in[6])
#define IN_LQ1(a) ((a).in[7])
#define IN_LK1(a) ((a).in[8])
#define IN_LQ2(a) ((a).in[9])
#define IN_LK2(a) ((a).in[10])
#define IN_SUBLN_G(a) ((a).in[11])
#define IN_FINAL_G(a) ((a).in[12])
__device__ __forceinline__ float wave_sum(float v) {
#pragma unroll
    for (int o = 1; o < 64; o <<= 1) v += __shfl_xor(v, o);
    return v;
}
__device__ __forceinline__ void p0_transpose_item(const float* W, int K, int N, bf16* WT, int row_off, const float* gk, float cs, LAS float* scr, int item, int lane) {
    const int nblk = N / 32, kb = item / nblk, nb = item % nblk, k0 = 64 * kb, n0 = 32 * nb;
#pragma unroll 8
    for (int i = 0; i < 32; ++i) { const int kk = 2 * i + (lane >> 5); const float g = gk ? gk[k0 + kk] * cs : cs; scr[kk * 33 + (lane & 31)] = W[(size_t)(k0 + kk) * N + n0 + (lane & 31)] * g; }
    LDS_WAIT(); asm volatile("" ::: "memory");
    const int c = lane & 7;
#pragma unroll
    for (int j = 0; j < 4; ++j) { const int n = (lane >> 3) + 8 * j; const LAS float* s = scr + (8 * c) * 33 + n;
        v4u o; o.x = pk2(s[0 * 33], s[1 * 33]); o.y = pk2(s[2 * 33], s[3 * 33]); o.z = pk2(s[4 * 33], s[5 * 33]); o.w = pk2(s[6 * 33], s[7 * 33]);
        *(GAS v4u*)(WT + (size_t)(row_off + n0 + n) * K + k0 + 8 * c) = o; }
    LDS_WAIT(); asm volatile("" ::: "memory");
}
__device__ __forceinline__ void p0_prologue(Frame& F, const Args& A) {
    LAS float* scr = (LAS float*)(F.lds + RING_OFF + F.wave * 16384);
    const int gw = F.vcu * NWAVES + F.wave, NGW = F.G * NWAVES;
    constexpr int I_IN = (DMODEL / 64) * (INW / 32), I_OUT = (DMODEL / 64) * (DMODEL / 32), I_MEM = (DMODEL / 64) * (512 / 32);
    constexpr int NITEMS = DEPTH * (I_IN + I_OUT + I_MEM);
    bf16* win = (bf16*)(F.ws + WS_WIN); bf16* wout = (bf16*)(F.ws + WS_WOUT); bf16* wmem = (bf16*)(F.ws + WS_WMEM);
    for (int it = gw; it < NITEMS; it += NGW) {
        int r = it;
        if (r < DEPTH * I_IN) { const int l = r / I_IN, q = r % I_IN, nb = q % (INW / 32), n0 = nb * 32;
            const float cs = (n0 < MIXW || (n0 >= 3 * MIXW && n0 < 3 * MIXW + MEMW)) ? QSCALE : 1.0f;
            p0_transpose_item(IN_W_IN(A) + (size_t)l * DMODEL * INW, DMODEL, INW, win + (size_t)l * INW * DMODEL, 0, IN_NORM_G(A) + l * DMODEL, cs, scr, q, F.lane); continue; }
        r -= DEPTH * I_IN;
        if (r < DEPTH * I_OUT) { const int l = r / I_OUT, q = r % I_OUT;
            p0_transpose_item(IN_W_OUT(A) + (size_t)l * DMODEL * DMODEL, DMODEL, DMODEL, wout + (size_t)l * DMODEL * DMODEL, 0, nullptr, 1.0f, scr, q, F.lane); continue; }
        r -= DEPTH * I_OUT;
        { const int l = r / I_MEM, q = r % I_MEM;
            p0_transpose_item(IN_W_MEM_KV(A) + (size_t)l * DMODEL * 512, DMODEL, 512, wmem, l * 512, IN_MEM_NORM_G(A) + l * DMODEL, 1.0f, scr, q, F.lane); }
    }
    bf16* xb = (bf16*)(F.ws + WS_XB); float* ssq = (float*)(F.ws + WS_SSQ);
    for (int m = gw; m < MROWS; m += NGW) {
        const GAS f32x4* xr = (const GAS f32x4*)(IN_X(A) + (size_t)m * DMODEL) + F.lane;
        GAS unsigned long long* o8 = (GAS unsigned long long*)(xb + (size_t)m * DMODEL) + F.lane;
        float s = 0.f;
#pragma unroll
        for (int j = 0; j < 4; ++j) { const f32x4 v = xr[64 * j]; s += (v.x * v.x + v.y * v.y) + (v.z * v.z + v.w * v.w);
            o8[64 * j] = (unsigned long long)pk2(v.x, v.y) | ((unsigned long long)pk2(v.z, v.w) << 32); }
        s = wave_sum(s);
        if (F.lane < 16) ssq[(size_t)m * 16 + F.lane] = (F.lane == 0) ? s : 0.f;
    }
    bf16* memn = (bf16*)(F.ws + WS_MEMN);
    for (int m = gw; m < BATCH * NMEM; m += NGW) {
        const GAS f32x4* xr = (const GAS f32x4*)(IN_MEM(A) + (size_t)m * DMODEL) + F.lane;
        GAS unsigned long long* o8 = (GAS unsigned long long*)(memn + (size_t)m * DMODEL) + F.lane;
        f32x4 v[4]; float s = 0.f;
#pragma unroll
        for (int j = 0; j < 4; ++j) { v[j] = xr[64 * j]; s += (v[j].x * v[j].x + v[j].y * v[j].y) + (v[j].z * v[j].z + v[j].w * v[j].w); }
        const float rstd = 1.0f / sqrtf(wave_sum(s) * (1.0f / DMODEL) + RMS_EPS);
#pragma unroll
        for (int j = 0; j < 4; ++j) o8[64 * j] = (unsigned long long)pk2(v[j].x * rstd, v[j].y * rstd) | ((unsigned long long)pk2(v[j].z * rstd, v[j].w * rstd) << 32);
    }
    if (gw == 0) {
        const float a = wave_sum(IN_LQ1(A)[F.lane] * IN_LK1(A)[F.lane]), b = wave_sum(IN_LQ2(A)[F.lane] * IN_LK2(A)[F.lane]);
        const float lam_init = 0.8f - 0.6f * expf(-0.3f * 2.0f);
        if (F.lane == 0) ((float*)(F.ws + WS_MISC))[0] = expf(a) - expf(b) + lam_init;
    }
}
__device__ __forceinline__ float diff_lambda_init() { return 0.8f - 0.6f * expf(-0.3f * 2.0f); }

__device__ __forceinline__ void unit_mem(Frame& F, int layer, int un) {
    using namespace att;
    const int hm = un & 3, rb = un >> 2;
    const int r32 = F.lane & 31, hi = F.lane >> 5;
    const int row0 = rb * 256 + F.wave * 32, b = rb >> 5;
    const bf16_t* qm = (const bf16_t*)(F.ws + WS_QM);
    const bf16_t* kv = (const bf16_t*)(F.ws + WS_MEMKV) + (size_t)(b * NMEM) * 2048 + layer * 512 + hm * 64;
    bf16x8 qr[4]; load_q(qr, qm + (size_t)(row0 + r32) * MEMW + hm * 64, hi);
    f32x16 o[2]; o[0] = f32x16{}; o[1] = f32x16{}; float m_run = NEG_INF, l_run = 0.f;
    BMNone bm;
    flash_loop<64>((lptr)(F.lds + RING_OFF), qr, kv, kv + 256, 2048, 2048, 3, 0, bm, o, m_run, l_run);
    bf16_t* mo = (bf16_t*)(F.ws + WS_MO) + (size_t)row0 * MEMW + hm * 64;
    finish_unit<64>((lptr)(F.lds + RING_OFF), o, m_run, l_run, [=](int i) { return mo + (size_t)i * MEMW; });
}
__device__ __forceinline__ void unit_dsw(Frame& F, int un) {
    using namespace att;
    const int x = un & 31, hh = (un >> 5) % 12, b = un / 384;
    const int g = hh >> 2, sh = 2 * g, dil = 1 << sh, U = SEQ >> sh, nb = U >> 8;
    const int res = x / nb, ub = x % nb;
    const int r32 = F.lane & 31, hi = F.lane >> 5;
    const size_t seq0 = (size_t)b * SEQ + (size_t)res * U;
    const int qlo = ub * 256 + F.wave * 32, qpos = qlo + r32;
    const bf16_t* Q = (const bf16_t*)(F.ws + WS_Q) + seq0 * MIXW + hh * 64;
    const bf16_t* K = (const bf16_t*)(F.ws + WS_K) + seq0 * MIXW + hh * 64;
    const bf16_t* V = (const bf16_t*)(F.ws + WS_V) + seq0 * MIXW + hh * 64;
    bf16x8 qr[4]; load_q(qr, Q + (size_t)qpos * MIXW, hi);
    f32x16 o[2]; o[0] = f32x16{}; o[1] = f32x16{}; float m_run = NEG_INF, l_run = 0.f;
    BMBand bm; bm.init(qpos, qlo, 128, alibi2(hh, 12) * (float)dil, hi);
    const int t_hi = ub * 4 + 3, t_lo = (ub * 4 - 2) > 0 ? (ub * 4 - 2) : 0;
    flash_loop<64>((lptr)(F.lds + RING_OFF), qr, K, V, MIXW, MIXW, t_hi, t_lo, bm, o, m_run, l_run);
    bf16_t* mix = (bf16_t*)(F.ws + WS_MIX) + ((size_t)b * SEQ) * MIXW + hh * 64;
    const float l2 = finish_unit<64>((lptr)(F.lds + RING_OFF), o, m_run, l_run, [=](int i) { return mix + (size_t)(((qlo + i) << sh) + res) * MIXW; });
    if (hi == 0) ((float*)(F.ws + WS_LSE))[((size_t)b * SEQ + ((size_t)qpos << sh) + res) * 12 + hh] = l2;
}
__device__ __forceinline__ void unit_moba(Frame& F, int b, int h, int qb) {
    using namespace att;
    const int r32 = F.lane & 31, hi = F.lane >> 5;
    const lptr L = (lptr)(F.lds + RING_OFF);
    const size_t seq0 = (size_t)b * SEQ;
    const int qlo = qb * 256 + F.wave * 32, qpos = qlo + r32;
    const bf16_t* Q = (const bf16_t*)(F.ws + WS_Q) + seq0 * MIXW + h * 64;
    const bf16_t* K = (const bf16_t*)(F.ws + WS_K) + seq0 * MIXW + h * 64;
    const bf16_t* V = (const bf16_t*)(F.ws + WS_V) + seq0 * MIXW + h * 64;
    bf16x8 qr[4]; load_q(qr, Q + (size_t)qpos * MIXW, hi);
    unsigned sel = (qb >= 3) ? 7u : ((1u << qb) - 1u);
    if (qb > 3) {
        { const int j = F.tid >> 4, d4 = (F.tid & 15) * 4; const float* kp_ = (const float*)(F.ws + WS_KPART) + (size_t)((b * 32 + j) * 2) * MIXW + h * 64 + d4;
          const f32x4 a = *(const f32x4*)kp_, c = *(const f32x4*)(kp_ + MIXW);
          *(LAS f32x4*)(L + L_KM + (j * 64 + d4) * 4) = (a + c) * (1.0f / 256.0f); }
        asm volatile("s_waitcnt lgkmcnt(0)\n\ts_barrier" ::: "memory");
        float qf[32];
#pragma unroll
        for (int d0 = 0; d0 < 4; ++d0)
#pragma unroll
            for (int e = 0; e < 8; ++e) qf[d0 * 8 + e] = __uint_as_float(((unsigned)(unsigned short)qr[d0][e]) << 16);
        float v1 = NEG_INF, v2 = NEG_INF, v3 = NEG_INF; int i1 = 0, i2 = 0, i3 = 0;
        for (int j = 0; j < qb; ++j) {
            const LAS f32x4* km = (const LAS f32x4*)(L + L_KM + (j * 64 + 8 * hi) * 4);
            float gsum = 0.f;
#pragma unroll
            for (int d0 = 0; d0 < 4; ++d0) { const f32x4 k0 = km[d0 * 4], k1 = km[d0 * 4 + 1];
                gsum += qf[d0 * 8 + 0] * k0[0] + qf[d0 * 8 + 1] * k0[1] + qf[d0 * 8 + 2] * k0[2] + qf[d0 * 8 + 3] * k0[3] + qf[d0 * 8 + 4] * k1[0] + qf[d0 * 8 + 5] * k1[1] + qf[d0 * 8 + 6] * k1[2] + qf[d0 * 8 + 7] * k1[3]; }
            const float gt = gsum + swap_half(gsum);
            if (gt > v1) { v3 = v2; i3 = i2; v2 = v1; i2 = i1; v1 = gt; i1 = j; }
            else if (gt > v2) { v3 = v2; i3 = i2; v2 = gt; i2 = j; }
            else if (gt > v3) { v3 = gt; i3 = j; }
        }
        sel = (1u << i1) | (1u << i2) | (1u << i3);
    }
    f32x16 o[2]; o[0] = f32x16{}; o[1] = f32x16{}; float m_run = NEG_INF, l_run = 0.f;
    BMMoba bm; bm.band.init(qpos, qlo, 1 << 20, alibi2(h, 12), hi); bm.sel = sel; bm.qb = qb;
    flash_loop<64>(L, qr, K, V, MIXW, MIXW, qb * 4 + 3, 0, bm, o, m_run, l_run);
    bf16_t* mix = (bf16_t*)(F.ws + WS_MIX) + (seq0 + qlo) * MIXW + h * 64;
    finish_unit<64>(L, o, m_run, l_run, [=](int i) { return mix + (size_t)i * MIXW; });
}
__device__ __forceinline__ void unit_diff(Frame& F, int b, int h, int mp, int qb) {
    using namespace att;
    const int r32 = F.lane & 31, hi = F.lane >> 5;
    const lptr L = (lptr)(F.lds + RING_OFF);
    const size_t seq0 = (size_t)b * SEQ;
    const int qlo = qb * 256 + F.wave * 32, qpos = qlo + r32;
    const bf16_t* Q = (const bf16_t*)(F.ws + WS_Q) + seq0 * MIXW + (h * 2 + mp) * 64;
    const bf16_t* K = (const bf16_t*)(F.ws + WS_K) + seq0 * MIXW + (h * 2 + mp) * 64;
    const bf16_t* V = (const bf16_t*)(F.ws + WS_V) + seq0 * MIXW + h * 128;
    bf16x8 qr[4]; load_q(qr, Q + (size_t)qpos * MIXW, hi);
    f32x16 o[4]; o[0] = f32x16{}; o[1] = f32x16{}; o[2] = f32x16{}; o[3] = f32x16{}; float m_run = NEG_INF, l_run = 0.f;
    BMBand bm; bm.init(qpos, qlo, 1 << 20, alibi2(h, 6), hi);
    flash_loop<128>(L, qr, K, V, MIXW, MIXW, qb * 4 + 3, 0, bm, o, m_run, l_run);
    bf16_t* od = (bf16_t*)(F.ws + WS_MIX) + (seq0 + qlo) * 1536 + (h * 2 + mp) * 128;
    finish_unit<128>(L, o, m_run, l_run, [=](int i) { return od + (size_t)i * 1536; });
}
__device__ __forceinline__ void phase_attn(Frame& F, int layer) {
    const int kind = layer % 3, G = F.G, v = F.vcu;
    if (kind == 0) {
        for (int un = v; un < 768 + 256; un += G) { if (un < 768) unit_dsw(F, un); else unit_mem(F, layer, un - 768); }
    } else {
        for (int round = 0;; ++round) {
            const int idx = (round & 1) ? (round + 1) * G - 1 - v : round * G + v;
            if (round * G >= 768) break;
            if (idx < 768) { const int qb = 31 - idx / 24, s = idx % 24;
                if (kind == 1) unit_moba(F, s / 12, s % 12, qb); else unit_diff(F, s / 12, (s % 12) >> 1, s & 1, qb); }
        }
        for (int un = v; un < 256; un += G) unit_mem(F, layer, un);
    }
}
__device__ __forceinline__ float bf2f(unsigned short u) { return __uint_as_float(((unsigned)u) << 16); }
__device__ __forceinline__ void phase_finalize(Frame& F, const Args& A, int layer) {
    typedef unsigned short us8 __attribute__((ext_vector_type(8)));
    const int kind = layer % 3, gw = F.vcu * NWAVES + F.wave, NGW = F.G * NWAVES, lane = F.lane;
    bf16* gate = (bf16*)(F.ws + WS_GATE);
    const bf16* mix = (const bf16*)(F.ws + WS_MIX); const bf16* mo = (const bf16*)(F.ws + WS_MO);
    const float* lse = (const float*)(F.ws + WS_LSE);
    const float lam = ((const float*)(F.ws + WS_MISC))[0], lam_scale = 1.0f - diff_lambda_init();
    for (int m = gw; m < MROWS; m += NGW) {
        float v[16];
        if (lane < 48) {
            if (kind == 2) {
                const int h = lane >> 3, dd = (lane & 7) * 16;
                const us8* p1 = (const us8*)(mix + (size_t)m * 1536 + h * 256 + dd); const us8* p2 = (const us8*)(mix + (size_t)m * 1536 + h * 256 + 128 + dd);
                const us8 a0 = p1[0], a1 = p1[1], b0 = p2[0], b1 = p2[1];
#pragma unroll
                for (int e = 0; e < 8; ++e) { v[e] = bf2f(a0[e]) - lam * bf2f(b0[e]); v[8 + e] = bf2f(a1[e]) - lam * bf2f(b1[e]); }
            } else {
                const us8* p1 = (const us8*)(mix + (size_t)m * MIXW + lane * 16); const us8 a0 = p1[0], a1 = p1[1];
#pragma unroll
                for (int e = 0; e < 8; ++e) { v[e] = bf2f(a0[e]); v[8 + e] = bf2f(a1[e]); }
            }
        } else {
            const us8* p1 = (const us8*)(mo + (size_t)m * MEMW + (lane - 48) * 16); const us8 a0 = p1[0], a1 = p1[1];
#pragma unroll
            for (int e = 0; e < 8; ++e) { v[e] = bf2f(a0[e]); v[8 + e] = bf2f(a1[e]); }
        }
        float sc = 1.0f;
        if (kind == 2) {
            float ss = 0.f;
#pragma unroll
            for (int e = 0; e < 16; ++e) ss += v[e] * v[e];
            ss += __shfl_xor(ss, 1); ss += __shfl_xor(ss, 2); ss += __shfl_xor(ss, 4);
            sc = lam_scale / sqrtf(ss * (1.0f / 128.0f) + SUBLN_EPS);
            if (lane < 48) { const float* sg = IN_SUBLN_G(A) + (lane & 7) * 16;
#pragma unroll
                for (int e = 0; e < 16; ++e) v[e] *= sg[e]; }
            else sc = 1.0f;
        } else if (kind == 0 && lane < 48) {
            const int hh = lane >> 2, j = hh & 3, g = hh >> 2;
            const float* lr = lse + (size_t)m * 12;
            const float l0 = lr[j], l1 = lr[4 + j], l2 = lr[8 + j], mx = fmaxf(fmaxf(l0, l1), l2);
            const float e0 = exp2f(l0 - mx), e1 = exp2f(l1 - mx), e2 = exp2f(l2 - mx);
            sc = (g == 0 ? e0 : (g == 1 ? e1 : e2)) / (e0 + e1 + e2);
        }
        us8* gp = (us8*)(gate + (size_t)m * DMODEL + lane * 16);
        const us8 g0 = gp[0], g1 = gp[1]; us8 y0, y1;
#pragma unroll
        for (int e = 0; e < 8; ++e) {
            const float ga = bf2f(g0[e]), gb = bf2f(g1[e]);
            const float sa = ga / (1.0f + exp2f(-ga * LOG2E)), sb = gb / (1.0f + exp2f(-gb * LOG2E));
            y0[e] = (unsigned short)f2bf(v[e] * sc * sa); y1[e] = (unsigned short)f2bf(v[8 + e] * sc * sb);
        }
        gp[0] = y0; gp[1] = y1;
    }
}
__device__ __forceinline__ void phase_final_norm(Frame& F, const Args& A) {
    const int gw = F.vcu * NWAVES + F.wave, NGW = F.G * NWAVES;
    const float* ssq = (const float*)(F.ws + WS_SSQ);
    for (int m = gw; m < MROWS; m += NGW) {
        GAS f32x4* xr = (GAS f32x4*)(A.out + (size_t)m * DMODEL) + F.lane;
        const float p = (F.lane < 16) ? ssq[(size_t)m * 16 + F.lane] : 0.f;
        const float rstd = 1.0f / sqrtf(wave_sum(p) * (1.0f / DMODEL) + RMS_EPS);
#pragma unroll
        for (int j = 0; j < 4; ++j) { const f32x4 g = *((const f32x4*)IN_FINAL_G(A) + F.lane + 64 * j); f32x4 v = xr[64 * j]; v = v * rstd * g; xr[64 * j] = v; }
    }
}

__global__ void __launch_bounds__(NWAVES * 64, 2) trunk_fwd(Args args) {
    extern __shared__ __attribute__((aligned(16))) unsigned char lds[];
    Frame F;
    F.lds = (LAS unsigned char*)lds;
    volatile LAS unsigned* MISC = (volatile LAS unsigned*)(F.lds + MISC_OFF);
    F.tid = threadIdx.x; F.lane = F.tid & 63; F.wave = __builtin_amdgcn_readfirstlane(F.tid >> 6);
    F.G = gridDim.x; { const int bx = blockIdx.x; F.vcu = (F.G % 8 == 0) ? (bx % 8) * (F.G / 8) + bx / 8 : bx; }
    F.ws = args.ws;
    gu32* ctl = (gu32*)(F.ws + WS_CTL);
    for (int u = F.tid; u < (LDS_BYTES - LDSCTL_OFF) / 4; u += NWAVES * 64) ((LAS unsigned*)(F.lds + LDSCTL_OFF))[u] = 0u;
    __syncthreads();
    XcdBarrier bar; bar.bar = (unsigned*)(ctl + CW_BAR); bar.x = 0; bar.st = nullptr;
    if (!MK_PER_PHASE) bar = xcd_barrier_post((unsigned*)(ctl + CW_BAR), MISC + 8);
    const int lo = args.ph_lo, hi = args.ph_hi;
#define IN(k) (lo <= (k) && (k) < hi)
#define SEAM(k) do { if (IN(k) && IN((k) + 1)) xcd_barrier(bar); } while (0)

    #ifndef DIS_P0
    if (IN(0)) { p0_prologue(F, args); }
#endif
    SEAM(0);
#define FRESH_TID() do { int t_ = threadIdx.x; asm volatile("" : "+v"(t_)); F.tid = t_; F.lane = t_ & 63; F.wave = __builtin_amdgcn_readfirstlane(t_ >> 6); } while (0)
    for (int layer = 0; layer < DEPTH; ++layer) {
        const int pb = 1 + 4 * layer, kind = layer % 3;
#ifndef DIS_GIN
        if (IN(pb)) {
#ifndef DIS_INP
            { pg8::Gemm g{(const pg8::bf16_t*)(F.ws + WS_XB), (const pg8::bf16_t*)(F.ws + WS_WIN) + (size_t)layer * INW * DMODEL, MROWS, INW, DMODEL};
              pg8::StaticOrder S; S.init(MROWS, INW, F.G, (int)blockIdx.x);
              pg8::EpiIn E{F.ws, kind};
              pg8::gemm_phase<pg8::EpiIn, pg8::StaticOrder, true, true>(F.lds + RING_OFF, g, S, E); }
#endif
#ifndef DIS_MEMKV
            if (layer == 0) {
              pg8::Gemm g{(const pg8::bf16_t*)(F.ws + WS_MEMN), (const pg8::bf16_t*)(F.ws + WS_WMEM), BATCH * NMEM, DEPTH * 512, DMODEL};
              pg8::TailOrder S{2, 8, F.G, (int)blockIdx.x};
              pg8::EpiPlain E{(pg8::bf16_t*)(F.ws + WS_MEMKV), DEPTH * 512};
              pg8::gemm_phase<pg8::EpiPlain, pg8::TailOrder, true, true>(F.lds + RING_OFF, g, S, E); }
#endif
        }
#endif
        SEAM(pb);
#ifndef DIS_ATT
        if (IN(pb + 1)) { FRESH_TID(); phase_attn(F, layer); }
#endif
        SEAM(pb + 1);
#ifndef DIS_FIN
        if (IN(pb + 2)) { FRESH_TID(); phase_finalize(F, args, layer); }
#endif
        SEAM(pb + 2);
#ifndef DIS_GOUT
        if (IN(pb + 3)) {
            pg8::Gemm g{(const pg8::bf16_t*)(F.ws + WS_GATE), (const pg8::bf16_t*)(F.ws + WS_WOUT) + (size_t)layer * DMODEL * DMODEL, MROWS, DMODEL, DMODEL};
            pg8::StaticOrder S; S.init(MROWS, DMODEL, F.G, (int)blockIdx.x);
            pg8::EpiOut E{layer == 0 ? IN_X(args) : args.out, args.out, (pg8::bf16_t*)(F.ws + WS_XB), (float*)(F.ws + WS_SSQ)};
            pg8::gemm_phase<pg8::EpiOut, pg8::StaticOrder, true, true>(F.lds + RING_OFF, g, S, E);
        }
#endif
        SEAM(pb + 3);
    }
    if (IN(NPHASES - 1)) { FRESH_TID(); phase_final_norm(F, args); }
#undef IN
#undef SEAM
}

extern "C" void kernel_launch(void* const* d_in, const int* in_sizes, int n_in, void* d_out, int out_size, void* d_ws, size_t ws_size, hipStream_t stream) {
    static int grid = 0;
    if (grid == 0) {
        if (n_in != 13 || out_size != MROWS * DMODEL || ws_size < WS_END) { fprintf(stderr, "kernel_launch: unexpected problem shape (n_in %d, out %d, ws %zu); nothing launched\n", n_in, out_size, ws_size); grid = -1; return; }
        int dev = 0, cus = 0, per_cu = 0;
        if (hipGetDevice(&dev) != hipSuccess || hipDeviceGetAttribute(&cus, hipDeviceAttributeMultiprocessorCount, dev) != hipSuccess) { grid = -1; return; }
        if (hipFuncSetAttribute((const void*)trunk_fwd, hipFuncAttributeMaxDynamicSharedMemorySize, LDS_BYTES) != hipSuccess) { fprintf(stderr, "kernel_launch: hipFuncSetAttribute failed\n"); grid = -1; return; }
        if (hipOccupancyMaxActiveBlocksPerMultiprocessor(&per_cu, (const void*)trunk_fwd, NWAVES * 64, LDS_BYTES) != hipSuccess || per_cu < 1) { fprintf(stderr, "kernel_launch: occupancy query says %d workgroups per CU\n", per_cu); per_cu = 1; }
        (void)hipGetLastError();
        grid = cus;
    }
    if (grid < 0) return;
    if (hipMemsetAsync((char*)d_ws + WS_CTL, 0, CTL_ZERO_BYTES, stream) != hipSuccess) { fprintf(stderr, "kernel_launch: hipMemsetAsync failed\n"); return; }
    Args a{};
    for (int i = 0; i < 13; ++i) a.in[i] = (const float*)d_in[i];
    a.out = (float*)d_out; a.ws = (unsigned char*)d_ws;
#if MK_PER_PHASE
    for (int p = 0; p < NPHASES; ++p) { a.ph_lo = p; a.ph_hi = p + 1; a.li = p; hipLaunchKernelGGL(trunk_fwd, dim3(grid), dim3(NWAVES * 64), LDS_BYTES, stream, a); }
#else
    a.ph_lo = 0; a.ph_hi = NPHASES; a.li = 0;
    hipLaunchKernelGGL(trunk_fwd, dim3(grid), dim3(NWAVES * 64), LDS_BYTES, stream, a);
#endif
    const hipError_t le = hipPeekAtLastError();
    if (le != hipSuccess) fprintf(stderr, "kernel_launch: launch failed: %s\n", hipGetErrorName(le));
}
```

```cpp
#include <hip/hip_runtime.h>
#include <hip/hip_bf16.h>
#include <cstdio>
#include <cstdint>
#include <cmath>

#ifndef MK_PER_PHASE
#define MK_PER_PHASE 0
#endif

#ifndef PROBE_WORK
#define PROBE_WORK 0
#endif
#ifndef PROBE_OUT
#define PROBE_OUT 0
#endif
#ifndef PROBE_LAYERS
#define PROBE_LAYERS 15
#endif
#ifndef PROBE_DUP
#define PROBE_DUP 0
#endif
constexpr int BATCH = 2, SEQ = 8192, DMODEL = 1024, DEPTH = 4, MROWS = BATCH * SEQ;
constexpr int MIXW = 768, MEMW = 256, NMEM = 256, INW = 3584;
constexpr float RMS_EPS = 1e-6f, SUBLN_EPS = 1e-5f;
constexpr float LOG2E = 1.4426950408889634f;
constexpr float QSCALE = 0.125f * LOG2E;
constexpr size_t MiB = 1u << 20;
constexpr size_t WS_CTL = 0, CTL_ZERO_BYTES = 1 * MiB;
constexpr size_t WS_WIN = 1 * MiB;
constexpr size_t WS_WOUT = 29 * MiB;
constexpr size_t WS_WMEM = 37 * MiB;
constexpr size_t WS_XB = 41 * MiB;
constexpr size_t WS_Q = 73 * MiB, WS_K = 97 * MiB, WS_V = 121 * MiB;
constexpr size_t WS_QM = 145 * MiB;
constexpr size_t WS_GATE = 153 * MiB;
constexpr size_t WS_MIX = 185 * MiB;
constexpr size_t WS_MO = 233 * MiB;
constexpr size_t WS_MEMN = 241 * MiB;
constexpr size_t WS_MEMKV = 242 * MiB;
constexpr size_t WS_LSE = 244 * MiB;
constexpr size_t WS_SSQ = 245 * MiB;
constexpr size_t WS_KPART = 246 * MiB;
constexpr size_t WS_MISC = 247 * MiB;
constexpr size_t WS_NRM = 247 * MiB + 4096;
constexpr size_t WS_END = 248 * MiB;
constexpr size_t CTL_USED_BYTES = 64 * 1024;
constexpr int CW_QUEUE = 8192;
constexpr int CW_BAR = 4096;
namespace pg8 {
#define PG8_LAS __attribute__((address_space(3)))
typedef unsigned short bf16_t;
typedef short bf16x8 __attribute__((ext_vector_type(8)));
typedef float f32x4 __attribute__((ext_vector_type(4)));
typedef unsigned u32x4 __attribute__((ext_vector_type(4)));
constexpr int BM = 256, BK = 64, HALF = 128, HTB = HALF * BK * 2  , STAGE_BYTES = 8 * HTB, NXCD = 8, WGM = 8;

__host__ __device__ __forceinline__ int lds_byte(int r, int c) { const int st = (r >> 4) * 2 + (c >> 5), rr = r & 15, cc = c & 31, ob = rr * 64 + cc * 2; return st * 1024 + (ob ^ (((ob >> 9) & 1) << 5)); }
__host__ __device__ __forceinline__ void stage_rc(int b, int& R, int& C) { const int st = b / 1024, sb = b % 1024, swz = sb ^ (((sb >> 9) & 1) << 5); R = (st >> 1) * 16 + swz / 64; C = (st & 1) * 32 + (swz % 64) / 2; }
__host__ __device__ __forceinline__ int perm32(int rho) { const int n = rho >> 4, i = rho & 15; return 8 * (i >> 2) + 4 * n + (i & 3); }

struct Unit { int pm, pn; };
struct Gemm { const bf16_t* A; const bf16_t* Bt; int M, N, K; };

struct StaticOrder {
    int nM, nN, nwg, G, c;
    __host__ __device__ void init(int M, int N, int G_, int c_) { nM = M / BM; nN = N / BM; nwg = nM * nN; G = G_; c = c_; }
    __host__ __device__ bool next(int i, Unit& u) const {
        const long L = (long)i * G + c; if (L >= nwg) return false;
        int wgid = (int)L; { const int q = nwg / NXCD, r = nwg % NXCD, xcd = wgid % NXCD, off = wgid / NXCD; wgid = (xcd < r ? xcd * (q + 1) : r * (q + 1) + (xcd - r) * q) + off; }
        const int nig = WGM * nN, gid = wgid / nig, fm = gid * WGM, gsz = (nM - fm) < WGM ? (nM - fm) : WGM;
        u.pm = fm + ((wgid % nig) % gsz); u.pn = (wgid % nig) / gsz; return true;
    }
    __device__ __forceinline__ void a_ready(const Unit&) const {}
    __device__ __forceinline__ void done(const Unit&) const {}
};

typedef float f32x2 __attribute__((ext_vector_type(2)));
typedef __bf16 bf16x2_t __attribute__((ext_vector_type(2)));
typedef unsigned u32x2 __attribute__((ext_vector_type(2)));
__device__ __forceinline__ unsigned cvt_pk_bf16(float lo, float hi) { f32x2 v = {lo, hi}; bf16x2_t b = __builtin_convertvector(v, bf16x2_t); return __builtin_bit_cast(unsigned, b); }

struct EpiIn {
    static constexpr bool PERM = true, AFTER_DRAIN = false;
    unsigned char* ws; int kind, layer;
    __device__ __forceinline__ void operator()(const f32x4 (&acc)[2][2][4][2], const Unit& u, int wr, int wc, int fr, int fq) const {
        const int pn = u.pn;
        size_t boff; int ldc, colt, sh = 0;
        static_assert(WS_K - WS_Q == WS_V - WS_K, "q | k | v equally spaced");
        if (pn < 9) { const int sec = pn / 3, g = pn - 3 * sec; boff = WS_Q + (size_t)sec * (WS_K - WS_Q); ldc = MIXW; colt = g * 256; if (kind == 0) sh = 2 * g; }
        else if (pn == 9) { boff = WS_QM; ldc = MEMW; colt = 0; }
        else { boff = WS_GATE; ldc = DMODEL; colt = (pn - 10) * 256; }
        bf16_t* base = (bf16_t*)(ws + boff);
        const float* ssq = (const float*)(ws + WS_SSQ); float* kpart = (float*)(ws + WS_KPART);
        const int col0 = colt + wc * 32 + 8 * fq;
        const bool want_ksum = (kind == 1) && (pn >= 3) && (pn < 6);
#pragma unroll
        for (int ai = 0; ai < 2; ++ai)
#pragma unroll
            for (int m = 0; m < 4; ++m) {
                const int row = u.pm * BM + ai * HALF + wr * 64 + m * 16 + fr;
                const f32x4 sp = *(const f32x4*)(ssq + (size_t)row * 16 + 4 * fq);
                float s = (sp[0] + sp[1]) + (sp[2] + sp[3]);
                s += __shfl_xor(s, 16); s += __shfl_xor(s, 32);
                const float rstd = 1.0f / sqrtf(s * (1.0f / DMODEL) + RMS_EPS);
                int orow = row;
                if (sh) { const int b = row >> 13, t = row & (SEQ - 1); orow = (b << 13) + ((t & ((1 << sh) - 1)) << (13 - sh)) + (t >> sh); }
                bf16_t* rowp = base + (size_t)orow * ldc + col0;
#pragma unroll
                for (int bj = 0; bj < 2; ++bj) {
                    const f32x4 v0 = acc[ai][bj][m][0] * rstd, v1 = acc[ai][bj][m][1] * rstd;
                    u32x4 w; w.x = cvt_pk_bf16(v0[0], v0[1]); w.y = cvt_pk_bf16(v0[2], v0[3]); w.z = cvt_pk_bf16(v1[0], v1[1]); w.w = cvt_pk_bf16(v1[2], v1[3]);
                    *(u32x4*)(rowp + bj * HALF) = w;
                }
                if (m & 1) asm volatile("" ::: "memory");
            }
        if (kind != 0 && pn < 6) {
            float rs[2][4];
#pragma unroll
            for (int ai = 0; ai < 2; ++ai)
#pragma unroll
                for (int m = 0; m < 4; ++m) {
                    const int row = u.pm * BM + ai * HALF + wr * 64 + m * 16 + fr;
                    const f32x4 sp = *(const f32x4*)(ssq + (size_t)row * 16 + 4 * fq);
                    float s = (sp[0] + sp[1]) + (sp[2] + sp[3]);
                    s += __shfl_xor(s, 16); s += __shfl_xor(s, 32);
                    rs[ai][m] = 1.0f / sqrtf(s * (1.0f / DMODEL) + RMS_EPS);
                }
#pragma unroll
            for (int bj = 0; bj < 2; ++bj) {
                float mx = 0.f;
#pragma unroll
                for (int ai = 0; ai < 2; ++ai)
#pragma unroll
                    for (int m = 0; m < 4; ++m) {
                        const f32x4 v0 = acc[ai][bj][m][0] * rs[ai][m], v1 = acc[ai][bj][m][1] * rs[ai][m];
                        float q = ((v0[0] * v0[0] + v0[1] * v0[1]) + (v0[2] * v0[2] + v0[3] * v0[3])) + ((v1[0] * v1[0] + v1[1] * v1[1]) + (v1[2] * v1[2] + v1[3] * v1[3]));
                        q += __shfl_xor(q, 16); q += __shfl_xor(q, 32);
                        mx = fmaxf(mx, q);
                    }
                mx = fmaxf(mx, __shfl_xor(mx, 1)); mx = fmaxf(mx, __shfl_xor(mx, 2)); mx = fmaxf(mx, __shfl_xor(mx, 4)); mx = fmaxf(mx, __shfl_xor(mx, 8));
                if (fr == 0 && fq == 0) atomicMax((unsigned*)(ws + WS_NRM) + layer * 96 + ((u.pm >> 5) * 2 + pn / 3) * 24 + (pn % 3) * 8 + bj * 4 + wc, __float_as_uint(mx));
            }
            if (want_ksum) {
#pragma unroll
                for (int bj = 0; bj < 2; ++bj)
#pragma unroll
                    for (int n = 0; n < 2; ++n) {
                        f32x4 v = (f32x4){0.f, 0.f, 0.f, 0.f};
#pragma unroll
                        for (int ai = 0; ai < 2; ++ai)
#pragma unroll
                            for (int m = 0; m < 4; ++m) v += acc[ai][bj][m][n] * rs[ai][m];
#pragma unroll
                        for (int e = 0; e < 4; ++e) { float x = v[e]; x += __shfl_xor(x, 1); x += __shfl_xor(x, 2); x += __shfl_xor(x, 4); x += __shfl_xor(x, 8); v[e] = x; }
                        if (fr == 0) *(f32x4*)(kpart + (size_t)(u.pm * 2 + wr) * MIXW + (pn - 3) * 256 + bj * HALF + wc * 32 + 8 * fq + 4 * n) = v;
                    }
            }
        }
    }
};
struct EpiPlain {
    static constexpr bool PERM = true, AFTER_DRAIN = false;
    bf16_t* O; int ldc;
    __device__ __forceinline__ void operator()(const f32x4 (&acc)[2][2][4][2], const Unit& u, int wr, int wc, int fr, int fq) const {
        const int col0 = u.pn * BM + wc * 32 + 8 * fq;
#pragma unroll
        for (int ai = 0; ai < 2; ++ai)
#pragma unroll
            for (int m = 0; m < 4; ++m) {
                bf16_t* rowp = O + (size_t)(u.pm * BM + ai * HALF + wr * 64 + m * 16 + fr) * ldc + col0;
#pragma unroll
                for (int bj = 0; bj < 2; ++bj) {
                    const f32x4 v0 = acc[ai][bj][m][0], v1 = acc[ai][bj][m][1];
                    u32x4 w; w.x = cvt_pk_bf16(v0[0], v0[1]); w.y = cvt_pk_bf16(v0[2], v0[3]); w.z = cvt_pk_bf16(v1[0], v1[1]); w.w = cvt_pk_bf16(v1[2], v1[3]);
                    *(u32x4*)(rowp + bj * HALF) = w;
                }
            }
    }
};
struct EpiOut {
    static constexpr bool PERM = false, AFTER_DRAIN = false;
    const float* xin; float* xout; bf16_t* xb; float* ssq;
    __device__ __forceinline__ void operator()(const f32x4 (&acc)[2][2][4][2], const Unit& u, int wr, int wc, int fr, int fq) const {
        const int col0 = u.pn * BM + wc * 32 + 4 * fq;
#pragma unroll
        for (int ai = 0; ai < 2; ++ai)
#pragma unroll
            for (int m = 0; m < 4; ++m) {
                const int row = u.pm * BM + ai * HALF + wr * 64 + m * 16 + fr;
                const size_t off = (size_t)row * DMODEL + col0;
                float s = 0.f;
#pragma unroll
                for (int bj = 0; bj < 2; ++bj)
#pragma unroll
                    for (int n = 0; n < 2; ++n) {
                        const size_t o = off + bj * HALF + n * 16;
                        const f32x4 v = *(const f32x4*)(xin + o) + acc[ai][bj][m][n];
                        *(f32x4*)(xout + o) = v;
                        u32x2 w; w.x = cvt_pk_bf16(v[0], v[1]); w.y = cvt_pk_bf16(v[2], v[3]);
                        *(u32x2*)(xb + o) = w;
                        s += (v[0] * v[0] + v[1] * v[1]) + (v[2] * v[2] + v[3] * v[3]);
                    }
                s += __shfl_xor(s, 16); s += __shfl_xor(s, 32);
                if (fq == 0) ssq[(size_t)row * 16 + u.pn * 4 + wc] = s;
            }
    }
};
struct TailOrder {
    int nM, nN, G, c;
    __device__ bool next(int i, Unit& u) const { const int nwg = nM * nN; int idx = c - (G - nwg); if (G < nwg) idx = c; idx += i * G; if (idx < 0 || idx >= nwg || (i > 0 && G >= nwg)) return false; u.pm = idx % nM; u.pn = idx / nM; return true; }
    __device__ __forceinline__ void a_ready(const Unit&) const {}
    __device__ __forceinline__ void done(const Unit&) const {}
};
template <class Epi, class Sched, bool ALIGN_EPI = false, bool SP2 = false>
__device__ __forceinline__ void gemm_phase(PG8_LAS unsigned char* lds, const Gemm g, const Sched& S, const Epi& E) {
    int tid_ = threadIdx.x; asm volatile("" : "+v"(tid_));
    const int tid = tid_, wid = __builtin_amdgcn_readfirstlane(tid >> 6), lane = tid & 63, wr = wid >> 2, wc = wid & 3, fr = lane & 15, fq = lane >> 4;
    const int K = g.K, nt = K / BK;
    unsigned voffA[2], voffB[2];
#pragma unroll
    for (int i = 0; i < 2; ++i) { int R, C; stage_rc(tid * 16 + i * 8192, R, C); const int Rb = Epi::PERM ? ((R & ~31) + perm32(R & 31)) : R;
        voffA[i] = (unsigned)(R * K + C) * 2u; voffB[i] = (unsigned)(Rb * K + C) * 2u; }
    const size_t kstep = (size_t)(BK * 2);
    const size_t hstep = (size_t)HALF * K * 2;
    const size_t tstep = 2 * hstep;
    const unsigned ldsw = (unsigned)wid * 1024u;
    const int aoff = lds_byte(wr * 64 + fr, fq * 8), boff = lds_byte(wc * 32 + fr, fq * 8);
#define PG8_SA(b, h) (((b) * 2 + (h)) * HTB)
#define PG8_SB(b, h) ((4 + (b) * 2 + (h)) * HTB)
#define PG8_STAGE(bufoff, gbase, voff) do { _Pragma("unroll") for (int _i = 0; _i < 2; ++_i) \
        __builtin_amdgcn_global_load_lds((const unsigned*)((const char*)(gbase) + (voff)[_i]), (PG8_LAS unsigned*)(lds + (bufoff) + ldsw + _i * 8192), 16, 0, 0); } while (0)
#define PG8_LDA(dst, b, h) do { _Pragma("unroll") for (int m = 0; m < 4; ++m) _Pragma("unroll") for (int k = 0; k < 2; ++k) dst[m][k] = *(const PG8_LAS bf16x8*)(lds + PG8_SA(b, h) + aoff + m * 2048 + k * 1024); } while (0)
#define PG8_LDB(dst, b, h) do { _Pragma("unroll") for (int n = 0; n < 2; ++n) _Pragma("unroll") for (int k = 0; k < 2; ++k) dst[n][k] = *(const PG8_LAS bf16x8*)(lds + PG8_SB(b, h) + boff + n * 2048 + k * 1024); } while (0)
#define PG8_MMA(ai, bj, At, Bt) do { __builtin_amdgcn_s_setprio(1); _Pragma("unroll") for (int m = 0; m < 4; ++m) _Pragma("unroll") for (int n = 0; n < 2; ++n) _Pragma("unroll") for (int k = 0; k < 2; ++k) \
        acc[ai][bj][m][n] = __builtin_amdgcn_mfma_f32_16x16x32_bf16(Bt[n][k], At[m][k], acc[ai][bj][m][n], 0, 0, 0); __builtin_amdgcn_s_setprio(0); } while (0)
#define PG8_WAIT_V(n) asm volatile("s_waitcnt vmcnt(" #n ")" ::: "memory")
#define PG8_WAIT_L(n) asm volatile("s_waitcnt lgkmcnt(" #n ")" ::: "memory")
#define PG8_BAR __builtin_amdgcn_s_barrier()
#define PG8_SCHED __builtin_amdgcn_sched_barrier(0)
    Unit cur, nxt; int ui = 0;
    if (!S.next(0, cur)) return;
    f32x4 acc[2][2][4][2];
#pragma unroll
    for (int a = 0; a < 2; ++a)
#pragma unroll
        for (int b = 0; b < 2; ++b)
#pragma unroll
            for (int m = 0; m < 4; ++m)
#pragma unroll
                for (int n = 0; n < 2; ++n) acc[a][b][m][n] = (f32x4){0.f, 0.f, 0.f, 0.f};
    bf16x8 At[4][2], B0[2][2], B1[2][2];
    const char* cA = (const char*)g.A + (size_t)cur.pm * tstep; const char* cB = (const char*)g.Bt + (size_t)cur.pn * tstep;
    S.a_ready(cur);
    if constexpr (SP2) {
        PG8_STAGE(PG8_SB(0, 0), cB, voffB); PG8_STAGE(PG8_SB(0, 1), cB + hstep, voffB); PG8_STAGE(PG8_SA(0, 0), cA, voffA); PG8_STAGE(PG8_SA(0, 1), cA + hstep, voffA);
        if (wr == 1) PG8_BAR;
        PG8_WAIT_V(2); PG8_BAR;
        PG8_STAGE(PG8_SB(1, 0), cB + kstep, voffB); PG8_STAGE(PG8_SA(1, 0), cA + kstep, voffA); PG8_STAGE(PG8_SB(1, 1), cB + hstep + kstep, voffB);
        PG8_WAIT_V(6); PG8_BAR;
    } else {
        PG8_STAGE(PG8_SB(0, 0), cB, voffB); PG8_STAGE(PG8_SA(0, 0), cA, voffA); PG8_STAGE(PG8_SB(0, 1), cB + hstep, voffB); PG8_STAGE(PG8_SA(0, 1), cA + hstep, voffA);
        if (wr == 1) PG8_BAR;
        PG8_WAIT_V(4); PG8_BAR;
        PG8_STAGE(PG8_SB(1, 0), cB + kstep, voffB); PG8_STAGE(PG8_SA(1, 0), cA + kstep, voffA); PG8_STAGE(PG8_SB(1, 1), cB + hstep + kstep, voffB);
        PG8_WAIT_V(6); PG8_BAR;
    }
    for (;;) {
        const bool has_next = S.next(ui + 1, nxt);
        const char* nA = has_next ? (const char*)g.A + (size_t)nxt.pm * tstep : cA; const char* nB = has_next ? (const char*)g.Bt + (size_t)nxt.pn * tstep : cB;
        for (int t = 0; t < nt; t += 2) {
            const bool last = (t == nt - 2);
            const char* a1 = cA + (size_t)(t + 1) * kstep;
            const char* a2 = last ? nA : cA + (size_t)(t + 2) * kstep; const char* b2 = last ? nB : cB + (size_t)(t + 2) * kstep;
            const char* a3 = a2 + kstep; const char* b3 = b2 + kstep;
            if (last && has_next) S.a_ready(nxt);
            if constexpr (SP2) {
            PG8_LDB(B0, 0, 0); PG8_LDB(B1, 0, 1); PG8_SCHED; PG8_LDA(At, 0, 0); PG8_STAGE(PG8_SA(1, 1), a1 + hstep, voffA);
            PG8_WAIT_V(8); PG8_WAIT_L(0); PG8_BAR; PG8_MMA(0, 0, At, B0); PG8_MMA(0, 1, At, B1); PG8_BAR; PG8_SCHED;
            PG8_LDA(At, 0, 1); PG8_STAGE(PG8_SB(0, 0), b2, voffB); PG8_STAGE(PG8_SB(0, 1), b2 + hstep, voffB); PG8_STAGE(PG8_SA(0, 0), a2, voffA);
            PG8_WAIT_V(8); PG8_WAIT_L(0); PG8_BAR; PG8_MMA(1, 0, At, B0); PG8_MMA(1, 1, At, B1); PG8_BAR; PG8_SCHED;
            PG8_LDB(B0, 1, 0); PG8_LDB(B1, 1, 1); PG8_SCHED; PG8_LDA(At, 1, 0); PG8_STAGE(PG8_SA(0, 1), a2 + hstep, voffA);
            PG8_WAIT_V(8); PG8_WAIT_L(0); PG8_BAR; PG8_MMA(0, 0, At, B0); PG8_MMA(0, 1, At, B1); PG8_BAR; PG8_SCHED;
            PG8_LDA(At, 1, 1); PG8_STAGE(PG8_SB(1, 0), b3, voffB); PG8_STAGE(PG8_SB(1, 1), b3 + hstep, voffB); PG8_STAGE(PG8_SA(1, 0), a3, voffA);
            PG8_WAIT_V(8); PG8_WAIT_L(0); PG8_BAR; PG8_MMA(1, 0, At, B0); PG8_MMA(1, 1, At, B1); PG8_BAR; PG8_SCHED;
            } else {
            PG8_LDB(B0, 0, 0); PG8_SCHED; PG8_LDA(At, 0, 0); PG8_STAGE(PG8_SA(1, 1), a1 + hstep, voffA);
            PG8_WAIT_L(8); PG8_BAR; PG8_WAIT_L(0); PG8_MMA(0, 0, At, B0); PG8_BAR; PG8_SCHED;
            PG8_LDB(B1, 0, 1); PG8_STAGE(PG8_SB(0, 0), b2, voffB);
            PG8_BAR; PG8_WAIT_L(0); PG8_MMA(0, 1, At, B1); PG8_BAR;
            PG8_LDA(At, 0, 1); PG8_STAGE(PG8_SA(0, 0), a2, voffA);
            PG8_BAR; PG8_WAIT_L(0); PG8_MMA(1, 0, At, B0); PG8_BAR; PG8_SCHED;
            PG8_STAGE(PG8_SB(0, 1), b2 + hstep, voffB);
            PG8_WAIT_V(6); PG8_BAR; PG8_MMA(1, 1, At, B1); PG8_BAR;
            PG8_LDB(B0, 1, 0); PG8_SCHED; PG8_LDA(At, 1, 0); PG8_STAGE(PG8_SA(0, 1), a2 + hstep, voffA);
            PG8_WAIT_L(8); PG8_BAR; PG8_WAIT_L(0); PG8_MMA(0, 0, At, B0); PG8_BAR; PG8_SCHED;
            PG8_LDB(B1, 1, 1); PG8_STAGE(PG8_SB(1, 0), b3, voffB);
            PG8_BAR; PG8_WAIT_L(0); PG8_MMA(0, 1, At, B1); PG8_BAR;
            PG8_LDA(At, 1, 1); PG8_STAGE(PG8_SA(1, 0), a3, voffA);
            PG8_BAR; PG8_WAIT_L(0); PG8_MMA(1, 0, At, B0); PG8_BAR; PG8_SCHED;
            PG8_STAGE(PG8_SB(1, 1), b3 + hstep, voffB);
            PG8_WAIT_V(6); PG8_BAR; PG8_MMA(1, 1, At, B1); PG8_BAR;
            }
        }
        if constexpr (ALIGN_EPI) { if (wr == 0) PG8_BAR; }
        if constexpr (!Epi::AFTER_DRAIN) { E(acc, cur, wr, wc, fr, fq); S.done(cur); }
        if (!has_next) break;
#pragma unroll
        for (int a = 0; a < 2; ++a)
#pragma unroll
            for (int b = 0; b < 2; ++b)
#pragma unroll
                for (int m = 0; m < 4; ++m)
#pragma unroll
                    for (int n = 0; n < 2; ++n) acc[a][b][m][n] = (f32x4){0.f, 0.f, 0.f, 0.f};
        cur = nxt; cA = nA; cB = nB; ++ui;
        if constexpr (ALIGN_EPI) { if (wr == 1) PG8_BAR; }
    }
    PG8_WAIT_V(0);
    if constexpr (!ALIGN_EPI) { if (wr == 0) PG8_BAR; }
    PG8_BAR;
    if constexpr (Epi::AFTER_DRAIN) { E.fused(acc, cur, wr, wc, fr, fq, lds, wid, lane); S.done(cur); }
#undef PG8_SA
#undef PG8_SB
#undef PG8_STAGE
#undef PG8_LDA
#undef PG8_LDB
#undef PG8_MMA
#undef PG8_WAIT_V
#undef PG8_WAIT_L
#undef PG8_BAR
#undef PG8_SCHED
}
}
namespace att {
#define LAS __attribute__((address_space(3)))
typedef unsigned short bf16_t;
typedef short bf16x8 __attribute__((ext_vector_type(8)));
typedef short s16x4 __attribute__((ext_vector_type(4)));
typedef short v4i16_t __attribute__((ext_vector_type(4)));
typedef float f32x16 __attribute__((ext_vector_type(16)));
typedef float f32x4 __attribute__((ext_vector_type(4)));
typedef float f32x2_t __attribute__((ext_vector_type(2)));
typedef __bf16 bf16x2_t __attribute__((ext_vector_type(2)));
typedef unsigned u32x4 __attribute__((ext_vector_type(4)));
typedef LAS char* lptr;
typedef LAS const char* lcptr;
constexpr int NW = 8;
constexpr int KSLOT = 8192, VSLOT = 16384;
#define ATT_PD 2
#if PROBE_WORK == 3
#define ATT_CNT64 4
#define ATT_CNT128 6
#else
#define ATT_CNT64 2
#define ATT_CNT128 3
#endif
constexpr int PD = ATT_PD, NKS = PD + 2, NVS = PD + 3;
constexpr int L_K = 0, L_V = NKS * KSLOT, L_WS = L_V + NVS * VSLOT, L_KM = L_WS + NW * 256, L_END = L_KM + 8192;
constexpr int L_OST = 0;
static_assert(NW * 8192 <= L_WS, "output stage inside the rings");
constexpr float NEG_INF = -INFINITY;

__device__ __forceinline__ int crow(int r, int hi) { return (r & 3) + 8 * (r >> 2) + 4 * hi; }
__device__ __forceinline__ unsigned cvtpk(float lo, float hi) { f32x2_t v = {lo, hi}; bf16x2_t b = __builtin_convertvector(v, bf16x2_t); return __builtin_bit_cast(unsigned, b); }
__device__ __forceinline__ float bf2f_lo(unsigned w) { return __uint_as_float(w << 16); }
__device__ __forceinline__ float bf2f_hi(unsigned w) { return __uint_as_float(w & 0xffff0000u); }
__device__ __forceinline__ void glds16(const void* gsrc, unsigned lds_dst) { unsigned keep;
    asm volatile("s_mov_b32 %0, m0\n\ts_mov_b32 m0, %2\n\ts_nop 0\n\tglobal_load_lds_dwordx4 %1, off\n\ts_mov_b32 m0, %0" : "=&s"(keep) : "v"(gsrc), "s"(lds_dst) : "memory"); }
#define ATT_WAIT_BAR() asm volatile("s_waitcnt vmcnt(0) lgkmcnt(0)\n\ts_barrier" ::: "memory")
#define ATT_STR2(x) #x
#define ATT_STR(x) ATT_STR2(x)
#define ATT_WAIT_BAR_N(N) asm volatile("s_waitcnt vmcnt(" ATT_STR(N) ") lgkmcnt(0)\n\ts_barrier" ::: "memory")
#define ATT_MFMA(a, b, c) __builtin_amdgcn_mfma_f32_32x32x16_bf16(a, b, c, 0, 0, 0)
__device__ __forceinline__ s16x4 vtr(lcptr p) { return __builtin_bit_cast(s16x4, __builtin_amdgcn_ds_read_tr16_b64_v4i16((LAS v4i16_t*)p)); }
__device__ __forceinline__ float swap_half(float v) { auto rr = __builtin_amdgcn_permlane32_swap(__float_as_uint(v), __float_as_uint(v), false, false); const int hi = (threadIdx.x >> 5) & 1; return __uint_as_float(hi ? rr[0] : rr[1]); }
__device__ __forceinline__ float rowmax(const f32x16& p0, const f32x16& p1) {
    float a = fmaxf(fmaxf(p0[0], p0[1]), p1[0]), b = fmaxf(fmaxf(p0[2], p0[3]), p1[1]); a = fmaxf(fmaxf(a, p1[2]), p1[3]);
#pragma unroll
    for (int r = 4; r < 16; r += 4) { a = fmaxf(fmaxf(a, p0[r]), p0[r + 1]); b = fmaxf(fmaxf(b, p0[r + 2]), p0[r + 3]); a = fmaxf(fmaxf(a, p1[r]), p1[r + 1]); b = fmaxf(fmaxf(b, p1[r + 2]), p1[r + 3]); }
    const float m = fmaxf(a, b);
    return fmaxf(m, swap_half(m));
}

struct BMNone {
    __device__ __forceinline__ bool active(int) const { return true; }
    __device__ __forceinline__ float cbase(int, float mref) const { return -mref; }
    __device__ __forceinline__ float cslope() const { return 0.f; }
    __device__ __forceinline__ void mask(int, f32x16&, f32x16&) const {}
};
struct BMBand {
    int qpos, qlo, W, hi; float slope2;
    __device__ __forceinline__ void init(int qpos_, int qlo_, int W_, float slope2_, int hi_) { qpos = qpos_; qlo = qlo_; W = W_; slope2 = slope2_; hi = hi_; }
    __device__ __forceinline__ bool active(int t) const { return (64 * t <= qlo + 31) && (64 * t + 63 >= qlo - W); }
    __device__ __forceinline__ float cbase(int t, float mref) const { return slope2 * (float)(64 * t + 4 * hi - qpos) - mref; }
    __device__ __forceinline__ float cslope() const { return slope2; }
    __device__ __forceinline__ void mask(int t, f32x16& p0, f32x16& p1) const {
        if ((64 * t + 63 > qlo) || (64 * t < qlo + 31 - W)) {
            const int d0 = qpos - 64 * t - 4 * hi;
#pragma unroll
            for (int r = 0; r < 16; ++r) { const int d = d0 - ((r & 3) + 8 * (r >> 2)); if (d < 0 || d > W) p0[r] = NEG_INF; const int e = d - 32; if (e < 0 || e > W) p1[r] = NEG_INF; }
        }
    }
};
struct BMMoba {
    BMBand band; unsigned sel; int qb;
    __device__ __forceinline__ bool active(int t) const { const int j = t >> 2; if (j == qb) return band.active(t); return __builtin_amdgcn_ballot_w64(((sel >> j) & 1u) != 0u) != 0ull; }
    __device__ __forceinline__ float cbase(int t, float mref) const { const int j = t >> 2; return band.cbase(t, (j == qb || ((sel >> j) & 1u)) ? mref : INFINITY); }
    __device__ __forceinline__ float cslope() const { return band.slope2; }
    __device__ __forceinline__ void mask(int t, f32x16& p0, f32x16& p1) const { const int j = t >> 2;
        if (j == qb) band.mask(t, p0, p1); }
};

constexpr float ATT_THR = 8.0f;
template <int DV, bool DO_QK, bool DO_PV, class BM>
__device__ __forceinline__ void att_block(const BM& bm, int tn, float mref, lcptr kq_, lcptr vq_, const bf16x8 (&qr)[4], f32x16& s0, f32x16& s1, f32x16& q0, f32x16& q1,
                                          u32x4 (&pan)[4], const u32x4 (&pao)[4], f32x16 (&o)[DV / 32], float& l_run) {
    constexpr int NPV = DO_PV ? DV / 8 : 0, NQK = DO_QK ? 8 : 0, NG = NPV + NQK;
    constexpr int KAH = 4, VAH = 3;
    constexpr int CG0 = NPV >= 8 ? NPV - 8 : 0;
    s16x4 lo[4], hh[4]; bf16x8 kfr[8];
    const bf16x8 pa_[4] = {__builtin_bit_cast(bf16x8, pao[0]), __builtin_bit_cast(bf16x8, pao[1]), __builtin_bit_cast(bf16x8, pao[2]), __builtin_bit_cast(bf16x8, pao[3])};
    float e0 = 0.f, e1 = 0.f;
    const float cb0 = DO_QK ? bm.cbase(tn, mref) : 0.f, csl = DO_QK ? bm.cslope() : 0.f, cb1 = cb0 + 32.f * csl;
#define ATT_VRD(f_) do { lo[(f_) & 3] = vtr(vq_ + ((f_) >> 2) * 4096 + ((f_) & 3) * 1024); hh[(f_) & 3] = vtr(vq_ + ((f_) >> 2) * 4096 + ((f_) & 3) * 1024 + 512); } while (0)
#define ATT_KRD(k_) do { kfr[k_] = *(const LAS bf16x8*)(kq_ + ((k_) >> 1) * 2048 + ((k_) & 1) * 512); } while (0)
#define ATT_PK(k) (bf16x8){lo[k][0], lo[k][1], lo[k][2], lo[k][3], hh[k][0], hh[k][1], hh[k][2], hh[k][3]}
#define ATT_EXP1(e_) do { if ((e_) < 16) { s0[(e_) & 15] = __builtin_amdgcn_exp2f(s0[(e_) & 15]); e0 += s0[(e_) & 15]; asm volatile("" : "+v"(e0)); } else { s1[(e_) & 15] = __builtin_amdgcn_exp2f(s1[(e_) & 15]); e1 += s1[(e_) & 15]; asm volatile("" : "+v"(e1)); } } while (0)
#define ATT_PACK1(p_) do { pan[(p_) >> 2][(p_) & 3] = ((p_) < 8) ? cvtpk(s0[(2 * (p_)) & 15], s0[(2 * (p_) + 1) & 15]) : cvtpk(s1[(2 * (p_)) & 15], s1[(2 * (p_) + 1) & 15]); } while (0)
#define ATT_CEL(c_) do { const float cf_ = (float)((((c_) & 15) & 3) + 8 * (((c_) & 15) >> 2)); if ((c_) < 16) q0[(c_) & 15] = __builtin_fmaf(csl, cf_, cb0); else q1[(c_) & 15] = __builtin_fmaf(csl, cf_, cb1); } while (0)
    if (DO_PV) {
#pragma unroll
        for (int f = 0; f < VAH; ++f) ATT_VRD(f);
    }
    if (DO_QK && NPV < KAH) {
#pragma unroll
        for (int k = 0; k < KAH - NPV; ++k) ATT_KRD(k);
    }
    if (DO_QK && NPV < 8) {
#pragma unroll
        for (int c = 0; c < 32; ++c) ATT_CEL(c);
    }
    __builtin_amdgcn_sched_barrier(0);
#pragma unroll
    for (int g = 0; g < NG; ++g) {
        if (g < NPV && g + VAH < NPV) ATT_VRD(g + VAH);
        if (DO_QK && g + KAH >= NPV && g + KAH - NPV < 8) ATT_KRD(g + KAH - NPV);
        if (g < NPV) o[g >> 2] = ATT_MFMA(pa_[g & 3], ATT_PK(g & 3), o[g >> 2]);
        else { const int k = g - NPV; if (k & 1) q1 = ATT_MFMA(kfr[k], qr[k >> 1], q1); else q0 = ATT_MFMA(kfr[k], qr[k >> 1], q0); }
        {
            const int e_lo = (32 * g) / NG, e_hi = (32 * (g + 1)) / NG;
#pragma unroll
            for (int e_ = 0; e_ < 32; ++e_) if (e_ >= e_lo && e_ < e_hi) ATT_EXP1(e_);
#pragma unroll
            for (int p_ = 0; p_ < 16; ++p_) if (2 * p_ + 1 < e_lo && 2 * p_ + 1 >= (g == 0 ? 0 : (32 * (g - 1)) / NG)) ATT_PACK1(p_);
        }
        if (DO_QK && NPV >= 8 && g >= CG0 && g < CG0 + 8) { ATT_CEL(4 * (g - CG0)); ATT_CEL(4 * (g - CG0) + 1); ATT_CEL(4 * (g - CG0) + 2); ATT_CEL(4 * (g - CG0) + 3); }
        __builtin_amdgcn_sched_barrier(0);
    }
    if (NG == 0) {
#pragma unroll
        for (int e_ = 0; e_ < 32; ++e_) ATT_EXP1(e_);
    }
#pragma unroll
    for (int p_ = 0; p_ < 16; ++p_) if (NG == 0 || 2 * p_ + 1 >= (32 * (NG - 1)) / NG) ATT_PACK1(p_);
    l_run += e0 + e1;
#undef ATT_VRD
#undef ATT_KRD
#undef ATT_PK
#undef ATT_EXP1
#undef ATT_PACK1
#undef ATT_CEL
}
template <int DV, class BM, bool PERWAVE = false>
__device__ __forceinline__ void flash_loop(lptr L, const bf16x8 (&qr)[4], const bf16_t* Kb, const bf16_t* Vb, int kp, int vp, int t_hi, int t_lo, const BM& bm,
                                           f32x16 (&o)[DV / 32], float& m_run, float& l_run) {
    int tid_ = threadIdx.x; asm volatile("" : "+v"(tid_));
    const int tid = tid_, lane = tid & 63, r32 = lane & 31, hi = lane >> 5;
    const int wid = __builtin_amdgcn_readfirstlane(tid >> 6);
    const unsigned lds0 = (unsigned)(uintptr_t)L;
    LAS float* wsf = (LAS float*)(L + L_WS) + wid * 64;
    const bf16_t* ksrc = Kb + (size_t)lane * kp + wid * 8;
    const bf16_t* vsrc = Vb + (size_t)(16 * (wid & 3) + (lane >> 2)) * vp + (wid >> 2) * 32 + (lane & 3) * 8;
    const unsigned kdst = lds0 + L_K + wid * 1024, vdst = lds0 + L_V + wid * 1024;
#define ATT_DMA(t, ks, vs) do { glds16(ksrc + (size_t)(t) * 64 * kp, (unsigned)__builtin_amdgcn_readfirstlane(kdst + (ks) * KSLOT)); \
        glds16(vsrc + (size_t)(t) * 64 * vp, (unsigned)__builtin_amdgcn_readfirstlane(vdst + (vs) * VSLOT)); \
        if (DV == 128) glds16(vsrc + (size_t)(t) * 64 * vp + 64, (unsigned)__builtin_amdgcn_readfirstlane(vdst + (vs) * VSLOT + 8192)); } while (0)
    const lcptr kp0 = (lcptr)L + L_K + hi * 1024 + r32 * 16;
    const lcptr vp0 = (lcptr)L + L_V + ((lane >> 4) & 1) * 32 + (lane & 3) * 8 + (4 * hi + ((lane & 15) >> 2)) * 64;
#define ATT_INC(x, N) ((x) + 1 == (N) ? 0 : (x) + 1)
#define ATT_WAIT_CNT() do { if (DV == 128) ATT_WAIT_BAR_N(ATT_CNT128); else ATT_WAIT_BAR_N(ATT_CNT64); } while (0)
#define ATT_DECIDE(t, q0, q1, pan) do { bm.mask(t, q0, q1); const float rm = rowmax(q0, q1); \
        if (__builtin_amdgcn_ballot_w64(rm > ATT_THR) != 0ull) { const float dl = fmaxf(rm, 0.f), f = __builtin_amdgcn_exp2f(-dl); \
            mref += dl; l_run *= f; \
            _Pragma("unroll") for (int r = 0; r < 16; ++r) { q0[r] -= dl; q1[r] -= dl; } \
            if (hi == 0) wsf[r32] = f; \
            _Pragma("unroll") for (int r = 0; r < 16; ++r) { const float fr_ = wsf[crow(r, hi)]; _Pragma("unroll") for (int d = 0; d < DV / 32; ++d) o[d][r] *= fr_; } \
            _Pragma("unroll") for (int w = 0; w < 4; ++w) _Pragma("unroll") for (int e = 0; e < 4; ++e) pan[w][e] = cvtpk(bf2f_lo(pan[w][e]) * f, bf2f_hi(pan[w][e]) * f); } } while (0)
    const int n = t_hi - t_lo + 1;
    float mref = 0.f;
    u32x4 PA[4] = {u32x4{}, u32x4{}, u32x4{}, u32x4{}}, PB[4] = {u32x4{}, u32x4{}, u32x4{}, u32x4{}};
    ATT_WAIT_BAR();
    int kd = 0, vd = 0;
#pragma unroll
    for (int j = 0; j <= PD; ++j) if (j < n) { ATT_DMA(t_hi - j, kd, vd); kd = ATT_INC(kd, NKS); vd = ATT_INC(vd, NVS); }
    if (n > PD) ATT_WAIT_CNT(); else ATT_WAIT_BAR();
    int jA = 0, jE = n;
    if constexpr (PERWAVE) { jA = n; jE = 0; for (int j = 0; j < n; ++j) if (bm.active(t_hi - j)) { if (j < jA) jA = j; jE = j + 1; } if (jE <= jA) { jA = 0; jE = 1; } }
    f32x16 A0, A1, B0, B1;
    int ks = 1, vs_prev = 0, vsn = 0, i = 0;
#define ATT_ADV() do { ks = ATT_INC(ks, NKS); vs_prev = vsn; vsn = ATT_INC(vsn, NVS); ++i; } while (0)
#define ATT_STEP_DMA() do { if (i + 1 + PD < n) { ATT_DMA(t_hi - i - 1 - PD, kd, vd); kd = ATT_INC(kd, NKS); vd = ATT_INC(vd, NVS); } } while (0)
#define ATT_STEP_END() do { if (i + 1 + PD < n) ATT_WAIT_CNT(); else ATT_WAIT_BAR(); ATT_ADV(); } while (0)
#define ATT_PROLOGUE_QK(tile_, kslot_) do { const float cb0 = bm.cbase(tile_, 0.f), csl = bm.cslope(), cb1 = cb0 + 32.f * csl; const lcptr kq_ = kp0 + (kslot_) * KSLOT; \
      _Pragma("unroll") for (int r = 0; r < 16; ++r) { const float cf = (float)((r & 3) + 8 * (r >> 2)); A0[r] = __builtin_fmaf(csl, cf, cb0); A1[r] = __builtin_fmaf(csl, cf, cb1); } \
      _Pragma("unroll") for (int d0 = 0; d0 < 4; ++d0) { const bf16x8 k0 = *(const LAS bf16x8*)(kq_ + d0 * 2048), k1 = *(const LAS bf16x8*)(kq_ + d0 * 2048 + 512); A0 = ATT_MFMA(k0, qr[d0], A0); A1 = ATT_MFMA(k1, qr[d0], A1); } \
      bm.mask(tile_, A0, A1); \
      const float rm = rowmax(A0, A1); mref = (rm == NEG_INF) ? 0.f : rm; \
      _Pragma("unroll") for (int r = 0; r < 16; ++r) { A0[r] -= mref; A1[r] -= mref; } } while (0)
    if (jA == 0) ATT_PROLOGUE_QK(t_hi, 0);
    else {
#pragma nounroll
        while (i + 1 < jA) { ATT_STEP_DMA(); ATT_STEP_END(); }
        ATT_STEP_DMA(); ATT_PROLOGUE_QK(t_hi - jA, ks); ATT_STEP_END();
    }
#define ATT_STEP(S0, S1, PS, Q0, Q1, PQ, DO_QK, DO_PV) do { const int tn = t_hi - i - 1; \
        ATT_STEP_DMA(); \
        att_block<DV, DO_QK, DO_PV>(bm, tn, mref, kp0 + ks * KSLOT, vp0 + vs_prev * VSLOT, qr, S0, S1, Q0, Q1, PS, PQ, o, l_run); \
        if (DO_QK) ATT_DECIDE(tn, Q0, Q1, PS); \
        ATT_STEP_END(); } while (0)
    float ldead = 0.f;
    bool last_in_A;
    if (jE - jA > 1) ATT_STEP(A0, A1, PA, B0, B1, PB, true, false); else ATT_STEP(A0, A1, PA, B0, B1, PB, false, false);
#pragma nounroll
    while (i + 2 < jE) { ATT_STEP(B0, B1, PB, A0, A1, PA, true, true); ATT_STEP(A0, A1, PA, B0, B1, PB, true, true); }
    if (i + 2 == jE) { ATT_STEP(B0, B1, PB, A0, A1, PA, true, true); ATT_STEP(A0, A1, PA, B0, B1, PB, false, true); last_in_A = true; }
    else if (i + 1 == jE) { ATT_STEP(B0, B1, PB, A0, A1, PA, false, true); last_in_A = false; }
    else last_in_A = true;
    if (jE < n) ATT_STEP_DMA();
    if (last_in_A) att_block<DV, false, true>(bm, 0, mref, kp0, vp0 + vs_prev * VSLOT, qr, B0, B1, B0, B1, PB, PA, o, ldead);
    else att_block<DV, false, true>(bm, 0, mref, kp0, vp0 + vs_prev * VSLOT, qr, A0, A1, A0, A1, PA, PB, o, ldead);
    if (jE < n) { ATT_STEP_END();
#pragma nounroll
        while (i < n) { ATT_STEP_DMA(); ATT_STEP_END(); } }
    ATT_WAIT_BAR();
    m_run = mref;
#undef ATT_STEP
#undef ATT_ADV
#undef ATT_STEP_DMA
#undef ATT_STEP_END
#undef ATT_PROLOGUE_QK
#undef ATT_DMA
#undef ATT_INC
#undef ATT_WAIT_CNT
#undef ATT_DECIDE
}

__device__ __forceinline__ float bf2f_(unsigned short u) { return __uint_as_float(((unsigned)u) << 16); }
__device__ __forceinline__ float silu_(float g) { return g * __builtin_amdgcn_rcpf(1.0f + __builtin_amdgcn_exp2f(-g * LOG2E)); }
template <int DV, bool GATED, class RowPtr>
__device__ __forceinline__ float finish_unit(lptr L, f32x16 (&o)[DV / 32], float m_run, float l_run, const RowPtr& rp) {
    int tid_ = threadIdx.x; asm volatile("" : "+v"(tid_));
    const int tid = tid_, lane = tid & 63, r32 = lane & 31, hi = lane >> 5;
    const int wid = __builtin_amdgcn_readfirstlane(tid >> 6);
    LAS float* wsf = (LAS float*)(L + L_WS) + wid * 64;
    const float l_tot = l_run + swap_half(l_run);
    if (hi == 0) wsf[32 + r32] = l_tot;
    LAS bf16_t* stg = (LAS bf16_t*)(L + L_OST + wid * 8192);
#pragma unroll
    for (int r = 0; r < 16; ++r) { const int orow = crow(r, hi); const float rl = __builtin_amdgcn_rcpf(wsf[32 + orow]);
#pragma unroll
        for (int d = 0; d < DV / 32; ++d) { const __hip_bfloat16 hv = __float2bfloat16(o[d][r] * rl); stg[orow * DV + d * 32 + r32] = __builtin_bit_cast(unsigned short, hv); } }
    constexpr int CPR = DV / 8;
#pragma unroll
    for (int it = 0; it < DV / 16; ++it) { const int idx = it * 64 + lane, row = idx / CPR, ch = idx % CPR;
        u32x4 v = *(const LAS u32x4*)((lcptr)stg + row * (DV * 2) + ch * 16);
        u32x4* gp = (u32x4*)(rp(row) + ch * 8);
        if (GATED) { const u32x4 g = *gp;
#pragma unroll
            for (int e = 0; e < 4; ++e) { const float o0 = bf2f_((unsigned short)(v[e] & 0xffffu)), o1 = bf2f_((unsigned short)(v[e] >> 16));
                const float g0 = bf2f_((unsigned short)(g[e] & 0xffffu)), g1 = bf2f_((unsigned short)(g[e] >> 16));
                v[e] = cvtpk(o0 * silu_(g0), o1 * silu_(g1)); } }
        *gp = v; }
    return m_run + __builtin_amdgcn_logf(l_tot);
}
__device__ __forceinline__ void load_q(bf16x8 (&qr)[4], const bf16_t* qrow, int hi) {
#pragma unroll
    for (int d0 = 0; d0 < 4; ++d0) qr[d0] = *(const bf16x8*)(qrow + d0 * 16 + hi * 8);
}
__device__ __forceinline__ float alibi2(int i, int n) { return exp2f(-8.0f * (float)(i + 1) / (float)n) * LOG2E; }
}
constexpr int RING_OFF = 0, RING_BYTES = 131072;
constexpr int ATT_BYTES = 144 * 1024;
constexpr int LDSCTL_OFF = ATT_BYTES, MISC_OFF = LDSCTL_OFF + 320;
constexpr int LDS_BYTES = 148480;
static_assert(att::L_END <= ATT_BYTES && RING_BYTES <= ATT_BYTES && MISC_OFF + 128 <= LDS_BYTES, "LDS map");
constexpr int NWAVES = 8;
constexpr int NPHASES = 2 + 4 * DEPTH;

#define GAS __attribute__((address_space(1)))
#define LAS __attribute__((address_space(3)))
typedef unsigned short bf16;
typedef unsigned v4u __attribute__((ext_vector_type(4)));
typedef float f32x4 __attribute__((ext_vector_type(4)));
typedef short bf16x8 __attribute__((ext_vector_type(8)));
typedef GAS unsigned gu32;
typedef GAS unsigned long long gu64;
#define RLX_AGENT __ATOMIC_RELAXED, __HIP_MEMORY_SCOPE_AGENT
#define LDS_WAIT() asm volatile("s_waitcnt lgkmcnt(0)" ::: "memory")
#define VM_WAIT() asm volatile("s_waitcnt vmcnt(0)" ::: "memory")
__device__ __forceinline__ unsigned long long rt() { return __builtin_amdgcn_s_memrealtime(); }
__device__ __forceinline__ unsigned f2bf(float f) { unsigned u = __builtin_bit_cast(unsigned, f); return (u + 0x7fffu + ((u >> 16) & 1u)) >> 16; }
__device__ __forceinline__ unsigned pk2(float lo, float hi) { return f2bf(lo) | (f2bf(hi) << 16); }
#define XB_TMO      128
#define XB_XCNT(j)  (256  + 64 * (j))
#define XB_XSUB(j)  (1280 + 64 * (j))
#define XB_XGEN(j)  (2304 + 64 * (j))
#define XB_TOP      3328
#define XB_TOPGEN   3392
#define XCD_BAR_WORDS 3456
#define XB_SPIN_CAP (1u << 18)

__device__ __forceinline__ unsigned xb_ld(unsigned* p)              { return __hip_atomic_load(p, __ATOMIC_RELAXED, __HIP_MEMORY_SCOPE_AGENT); }
__device__ __forceinline__ unsigned xb_add(unsigned* p, unsigned v) { return __hip_atomic_fetch_add(p, v, __ATOMIC_RELAXED, __HIP_MEMORY_SCOPE_AGENT); }
__device__ __forceinline__ unsigned xb_xcc_id() { return (unsigned)__builtin_amdgcn_s_getreg((3 << 11) | 20) & 0xFu; }
#define XB_SPIN(cond, bar) do { unsigned _sp = 0; while (cond) { __builtin_amdgcn_s_sleep(1); \
    if ((++_sp & 255u) == 0u) { if (xb_ld(&(bar)[XB_TMO])) break; if (_sp > XB_SPIN_CAP) { atomicAdd(&(bar)[XB_TMO], 1u); break; } } } } while (0)

struct XcdBarrier {
    unsigned* bar; unsigned x;
    volatile LAS unsigned* st;
};

__device__ __forceinline__ XcdBarrier xcd_barrier_post(unsigned* bar, volatile LAS unsigned* st) {
    XcdBarrier b; b.bar = bar; b.x = xb_xcc_id(); b.st = st;
    if (threadIdx.x == 0) (void)xb_add(&bar[XB_XCNT(b.x)], 1u);
    return b;
}
__device__ __forceinline__ void xcd_barrier_complete(unsigned* bar, unsigned x, unsigned& nloc, unsigned& nx) {
    const unsigned G = gridDim.x * gridDim.y * gridDim.z;
    unsigned sum, cnt, mine, sp = 0u;
    for (;;) {
        sum = 0u; cnt = 0u; mine = 0u;
#pragma unroll
        for (unsigned j = 0; j < 16; ++j) { const unsigned c = xb_ld(&bar[XB_XCNT(j)]); sum += c; cnt += (c > 0u) ? 1u : 0u; mine = (j == x) ? c : mine; }
        if (sum == G) break;
        __builtin_amdgcn_s_sleep(1);
        if ((++sp & 255u) == 0u) { if (xb_ld(&bar[XB_TMO])) break; if (sp > XB_SPIN_CAP) { atomicAdd(&bar[XB_TMO], 1u); break; } }
    }
    nloc = mine > 0u ? mine : 1u; nx = cnt > 0u ? cnt : 1u;
}

__device__ __forceinline__ void xcd_barrier(const XcdBarrier& b) {
    asm volatile("s_waitcnt vmcnt(0)" ::: "memory");
    __syncthreads();
    if (threadIdx.x == 0) {
        unsigned* bar = b.bar;
        __builtin_amdgcn_s_waitcnt(0);
        unsigned nloc = b.st[0], nx = b.st[1];
        if (nloc == 0u) { xcd_barrier_complete(bar, b.x, nloc, nx); b.st[0] = nloc; b.st[1] = nx; }
        const unsigned old = xb_add(&bar[XB_XSUB(b.x)], 1u);
        const unsigned gen = old / nloc;
        if (old + 1u == (gen + 1u) * nloc) {
            __builtin_amdgcn_fence(__ATOMIC_RELEASE, "agent");
            asm volatile("s_waitcnt vmcnt(0)" ::: "memory");
            const unsigned og = xb_add(&bar[XB_TOP], 1u);
            const unsigned tg = og / nx;
            if (og + 1u == (tg + 1u) * nx) xb_add(&bar[XB_TOPGEN], 1u);
            else XB_SPIN(xb_ld(&bar[XB_TOPGEN]) == tg, bar);
            __builtin_amdgcn_fence(__ATOMIC_ACQUIRE, "agent");
            xb_add(&bar[XB_XGEN(b.x)], 1u);
            asm volatile("s_waitcnt vmcnt(0)" ::: "memory");
        } else {
            XB_SPIN(xb_ld(&bar[XB_XGEN(b.x)]) == gen, bar);
            __builtin_amdgcn_fence(__ATOMIC_ACQUIRE, "agent");
            asm volatile("s_waitcnt vmcnt(0)" ::: "memory");
        }
    }
    __syncthreads();
}
struct Args { const float* in[13]; float* out; unsigned char* ws; int ph_lo, ph_hi, li, pad; };
struct Frame {
    LAS unsigned char* lds;
    int tid, lane, wave, vcu, G;
    unsigned char* ws;
};
#define IN_X(a) ((a).in[0])
#define IN_MEM(a) ((a).in[1])
#define IN_NORM_G(a) ((a).in[2])
#define IN_W_IN(a) ((a).in[3])
#define IN_W_OUT(a) ((a).in[4])
#define IN_MEM_NORM_G(a) ((a).in[5])
#define IN_W_MEM_KV(a) ((a).in[6])
#define IN_LQ1(a) ((a).in[7])
#define IN_LK1(a) ((a).in[8])
#define IN_LQ2(a) ((a).in[9])
#define IN_LK2(a) ((a).in[10])
#define IN_SUBLN_G(a) ((a).in[11])
#define IN_FINAL_G(a) ((a).in[12])
__device__ __forceinline__ float wave_sum(float v) {
#pragma unroll
    for (int o = 1; o < 64; o <<= 1) v += __shfl_xor(v, o);
    return v;
}
__device__ __forceinline__ void p0_transpose_item(const float* W, int K, int N, bf16* WT, int row_off, const float* gk, float cs, LAS float* scr, int item, int lane) {
    const int nblk = N / 32, kb = item / nblk, nb = item % nblk, k0 = 64 * kb, n0 = 32 * nb;
    const int kq = lane >> 3, n4 = (lane & 7) * 4;
#pragma unroll
    for (int i = 0; i < 8; ++i) { const int kk = 8 * i + kq; const float g = gk ? gk[k0 + kk] * cs : cs; const f32x4 w = *(const GAS f32x4*)(W + (size_t)(k0 + kk) * N + n0 + n4);
        LAS float* d = scr + kk * 33 + n4; d[0] = w.x * g; d[1] = w.y * g; d[2] = w.z * g; d[3] = w.w * g; }
    LDS_WAIT(); asm volatile("" ::: "memory");
    const int c = lane & 7;
#pragma unroll
    for (int j = 0; j < 4; ++j) { const int n = (lane >> 3) + 8 * j; const LAS float* s = scr + (8 * c) * 33 + n;
        v4u o; o.x = pk2(s[0 * 33], s[1 * 33]); o.y = pk2(s[2 * 33], s[3 * 33]); o.z = pk2(s[4 * 33], s[5 * 33]); o.w = pk2(s[6 * 33], s[7 * 33]);
        *(GAS v4u*)(WT + (size_t)(row_off + n0 + n) * K + k0 + 8 * c) = o; }
    LDS_WAIT(); asm volatile("" ::: "memory");
}
constexpr int I_IN = (DMODEL / 64) * (INW / 32), I_OUT = (DMODEL / 64) * (DMODEL / 32), I_MEM = (DMODEL / 64) * (512 / 32);
__device__ __forceinline__ void convert_item(Frame& F, const Args& A, int which, int l, int q, LAS float* scr) {
    if (which == 0) { const int nb = q % (INW / 32), n0 = nb * 32; const float cs = (n0 < MIXW || (n0 >= 3 * MIXW && n0 < 3 * MIXW + MEMW)) ? QSCALE : 1.0f;
        p0_transpose_item(IN_W_IN(A) + (size_t)l * DMODEL * INW, DMODEL, INW, (bf16*)(F.ws + WS_WIN) + (size_t)l * INW * DMODEL, 0, IN_NORM_G(A) + l * DMODEL, cs, scr, q, F.lane); }
    else if (which == 1) p0_transpose_item(IN_W_OUT(A) + (size_t)l * DMODEL * DMODEL, DMODEL, DMODEL, (bf16*)(F.ws + WS_WOUT) + (size_t)l * DMODEL * DMODEL, 0, nullptr, 1.0f, scr, q, F.lane);
    else p0_transpose_item(IN_W_MEM_KV(A) + (size_t)l * DMODEL * 512, DMODEL, 512, (bf16*)(F.ws + WS_WMEM), l * 512, IN_MEM_NORM_G(A) + l * DMODEL, 1.0f, scr, q, F.lane);
}
__device__ __forceinline__ void convert_deferred(Frame& F, const Args& A, int l, int worker, int nworkers) {
    LAS float* scr = (LAS float*)(F.lds + RING_OFF + F.wave * 16384);
    const int nitems = I_OUT + (l + 1 < DEPTH ? I_IN : 0);
    for (int it = worker; it < nitems; it += nworkers) { if (it < I_OUT) convert_item(F, A, 1, l, it, scr); else convert_item(F, A, 0, l + 1, it - I_OUT, scr); }
}
__device__ __forceinline__ void p0_prologue(Frame& F, const Args& A) {
    LAS float* scr = (LAS float*)(F.lds + RING_OFF + F.wave * 16384);
    const int gw = F.vcu * NWAVES + F.wave, NGW = F.G * NWAVES;
    constexpr int NITEMS = I_IN + DEPTH * I_MEM;
    for (int it = gw; it < NITEMS; it += NGW) { if (it < I_IN) convert_item(F, A, 0, 0, it, scr); else convert_item(F, A, 2, (it - I_IN) / I_MEM, (it - I_IN) % I_MEM, scr); }
    bf16* xb = (bf16*)(F.ws + WS_XB); float* ssq = (float*)(F.ws + WS_SSQ);
    for (int m = gw; m < MROWS; m += NGW) {
        const GAS f32x4* xr = (const GAS f32x4*)(IN_X(A) + (size_t)m * DMODEL) + F.lane;
        GAS unsigned long long* o8 = (GAS unsigned long long*)(xb + (size_t)m * DMODEL) + F.lane;
        float s = 0.f;
#pragma unroll
        for (int j = 0; j < 4; ++j) { const f32x4 v = xr[64 * j]; s += (v.x * v.x + v.y * v.y) + (v.z * v.z + v.w * v.w);
            o8[64 * j] = (unsigned long long)pk2(v.x, v.y) | ((unsigned long long)pk2(v.z, v.w) << 32); }
        s = wave_sum(s);
        if (F.lane < 16) ssq[(size_t)m * 16 + F.lane] = (F.lane == 0) ? s : 0.f;
    }
    bf16* memn = (bf16*)(F.ws + WS_MEMN);
    for (int m = gw; m < BATCH * NMEM; m += NGW) {
        const GAS f32x4* xr = (const GAS f32x4*)(IN_MEM(A) + (size_t)m * DMODEL) + F.lane;
        GAS unsigned long long* o8 = (GAS unsigned long long*)(memn + (size_t)m * DMODEL) + F.lane;
        f32x4 v[4]; float s = 0.f;
#pragma unroll
        for (int j = 0; j < 4; ++j) { v[j] = xr[64 * j]; s += (v[j].x * v[j].x + v[j].y * v[j].y) + (v[j].z * v[j].z + v[j].w * v[j].w); }
        const float rstd = 1.0f / sqrtf(wave_sum(s) * (1.0f / DMODEL) + RMS_EPS);
#pragma unroll
        for (int j = 0; j < 4; ++j) o8[64 * j] = (unsigned long long)pk2(v[j].x * rstd, v[j].y * rstd) | ((unsigned long long)pk2(v[j].z * rstd, v[j].w * rstd) << 32);
    }
    if (gw == 1) { float* nz = (float*)(F.ws + WS_NRM); for (int i = F.lane; i < DEPTH * 96; i += 64) nz[i] = 0.f; }
    if (gw == 0) {
        const float a = wave_sum(IN_LQ1(A)[F.lane] * IN_LK1(A)[F.lane]), b = wave_sum(IN_LQ2(A)[F.lane] * IN_LK2(A)[F.lane]);
        const float lam_init = 0.8f - 0.6f * expf(-0.3f * 2.0f);
        if (F.lane == 0) ((float*)(F.ws + WS_MISC))[0] = expf(a) - expf(b) + lam_init;
    }
}
__device__ __forceinline__ float diff_lambda_init() { return 0.8f - 0.6f * expf(-0.3f * 2.0f); }

__device__ __forceinline__ void unit_mem(Frame& F, int layer, int un) {
    using namespace att;
    const int hm = un & 3, rb = un >> 2;
    const int r32 = F.lane & 31, hi = F.lane >> 5;
    const int row0 = rb * 256 + F.wave * 32, b = rb >> 5;
    const bf16_t* qm = (const bf16_t*)(F.ws + WS_QM);
    const bf16_t* kv = (const bf16_t*)(F.ws + WS_MEMKV) + (size_t)(b * NMEM) * 2048 + layer * 512 + hm * 64;
    bf16x8 qr[4]; load_q(qr, qm + (size_t)(row0 + r32) * MEMW + hm * 64, hi);
    f32x16 o[2]; o[0] = f32x16{}; o[1] = f32x16{}; float m_run = NEG_INF, l_run = 0.f;
    BMNone bm;
    flash_loop<64>((lptr)(F.lds + RING_OFF), qr, kv, kv + 256, 2048, 2048, 3, 0, bm, o, m_run, l_run);
    bf16_t* yg = (bf16_t*)(F.ws + WS_GATE) + (size_t)row0 * DMODEL + MIXW + hm * 64;
    finish_unit<64, true>((lptr)(F.lds + RING_OFF), o, m_run, l_run, [=](int i) { return yg + (size_t)i * DMODEL; });
}
__device__ __forceinline__ void unit_dsw(Frame& F, int un) {
    using namespace att;
    const int x = un & 31, hh = (un >> 5) % 12, b = un / 384;
    const int g = hh >> 2, sh = 2 * g, dil = 1 << sh, U = SEQ >> sh, nb = U >> 8;
    const int res = x / nb, ub = x % nb;
    const int r32 = F.lane & 31, hi = F.lane >> 5;
    const size_t seq0 = (size_t)b * SEQ + (size_t)res * U;
    const int qlo = ub * 256 + F.wave * 32, qpos = qlo + r32;
    const bf16_t* Q = (const bf16_t*)(F.ws + WS_Q) + seq0 * MIXW + hh * 64;
    const bf16_t* K = (const bf16_t*)(F.ws + WS_K) + seq0 * MIXW + hh * 64;
    const bf16_t* V = (const bf16_t*)(F.ws + WS_V) + seq0 * MIXW + hh * 64;
    bf16x8 qr[4]; load_q(qr, Q + (size_t)qpos * MIXW, hi);
    f32x16 o[2]; o[0] = f32x16{}; o[1] = f32x16{}; float m_run = NEG_INF, l_run = 0.f;
    BMBand bm; bm.init(qpos, qlo, 128, alibi2(hh, 12) * (float)dil, hi);
    const int t_hi = ub * 4 + 3, t_lo = (ub * 4 - 2) > 0 ? (ub * 4 - 2) : 0;
    flash_loop<64, att::BMBand, true>((lptr)(F.lds + RING_OFF), qr, K, V, MIXW, MIXW, t_hi, t_lo, bm, o, m_run, l_run);
    bf16_t* mix = (bf16_t*)(F.ws + WS_MIX) + ((size_t)b * SEQ) * MIXW + hh * 64;
    const float l2 = finish_unit<64, false>((lptr)(F.lds + RING_OFF), o, m_run, l_run, [=](int i) { return mix + (size_t)(((qlo + i) << sh) + res) * MIXW; });
    if (hi == 0) ((float*)(F.ws + WS_LSE))[((size_t)b * SEQ + ((size_t)qpos << sh) + res) * 12 + hh] = l2;
}
__device__ __forceinline__ int skip_first_tile(Frame& F, int layer, int b, int stream, float slope2, int q_first) {
    const float* nr = (const float*)(F.ws + WS_NRM) + layer * 96 + b * 48 + 2 * stream;
    const float qn2 = nr[0] + nr[1], kn2 = nr[24] + nr[25];
    const float S = sqrtf(qn2 * kn2) * 1.02f + 0.5f;
    const float dskip = (160.0f + 2.0f * S) / slope2 + 1.0f;
    const float kminf = (float)q_first - dskip;
    return kminf <= 0.f ? 0 : (((int)kminf) >> 6);
}
__device__ __forceinline__ void unit_moba(Frame& F, int layer, int b, int h, int qb) {
    using namespace att;
    const int r32 = F.lane & 31, hi = F.lane >> 5;
    const lptr L = (lptr)(F.lds + RING_OFF);
    const size_t seq0 = (size_t)b * SEQ;
    const int qlo = qb * 256 + F.wave * 32, qpos = qlo + r32;
    const bf16_t* Q = (const bf16_t*)(F.ws + WS_Q) + seq0 * MIXW + h * 64;
    const bf16_t* K = (const bf16_t*)(F.ws + WS_K) + seq0 * MIXW + h * 64;
    const bf16_t* V = (const bf16_t*)(F.ws + WS_V) + seq0 * MIXW + h * 64;
    bf16x8 qr[4]; load_q(qr, Q + (size_t)qpos * MIXW, hi);
    unsigned sel = (qb >= 3) ? 7u : ((1u << qb) - 1u);
    if (qb > 3) {
        { const int j = F.tid >> 4, d4 = (F.tid & 15) * 4; const float* kp_ = (const float*)(F.ws + WS_KPART) + (size_t)((b * 32 + j) * 2) * MIXW + h * 64 + d4;
          const f32x4 a = *(const f32x4*)kp_, c = *(const f32x4*)(kp_ + MIXW);
          *(LAS f32x4*)(L + L_KM + (j * 64 + d4) * 4) = (a + c) * (1.0f / 256.0f); }
        asm volatile("s_waitcnt lgkmcnt(0)\n\ts_barrier" ::: "memory");
        float qf[32];
#pragma unroll
        for (int d0 = 0; d0 < 4; ++d0)
#pragma unroll
            for (int e = 0; e < 8; ++e) qf[d0 * 8 + e] = __uint_as_float(((unsigned)(unsigned short)qr[d0][e]) << 16);
        float v1 = NEG_INF, v2 = NEG_INF, v3 = NEG_INF; int i1 = 0, i2 = 0, i3 = 0;
        for (int j = 0; j < qb; ++j) {
            const LAS f32x4* km = (const LAS f32x4*)(L + L_KM + (j * 64 + 8 * hi) * 4);
            float gsum = 0.f;
#pragma unroll
            for (int d0 = 0; d0 < 4; ++d0) { const f32x4 k0 = km[d0 * 4], k1 = km[d0 * 4 + 1];
                gsum += qf[d0 * 8 + 0] * k0[0] + qf[d0 * 8 + 1] * k0[1] + qf[d0 * 8 + 2] * k0[2] + qf[d0 * 8 + 3] * k0[3] + qf[d0 * 8 + 4] * k1[0] + qf[d0 * 8 + 5] * k1[1] + qf[d0 * 8 + 6] * k1[2] + qf[d0 * 8 + 7] * k1[3]; }
            const float gt = gsum + swap_half(gsum);
            if (gt > v1) { v3 = v2; i3 = i2; v2 = v1; i2 = i1; v1 = gt; i1 = j; }
            else if (gt > v2) { v3 = v2; i3 = i2; v2 = gt; i2 = j; }
            else if (gt > v3) { v3 = gt; i3 = j; }
        }
        sel = (1u << i1) | (1u << i2) | (1u << i3);
    }
    f32x16 o[2]; o[0] = f32x16{}; o[1] = f32x16{}; float m_run = NEG_INF, l_run = 0.f;
    BMMoba bm; bm.band.init(qpos, qlo, 1 << 20, alibi2(h, 12), hi); bm.sel = sel; bm.qb = qb;
    flash_loop<64>(L, qr, K, V, MIXW, MIXW, qb * 4 + 3, skip_first_tile(F, layer, b, h, alibi2(h, 12), qb * 256), bm, o, m_run, l_run);
    bf16_t* yg = (bf16_t*)(F.ws + WS_GATE) + (seq0 + qlo) * DMODEL + h * 64;
    finish_unit<64, true>(L, o, m_run, l_run, [=](int i) { return yg + (size_t)i * DMODEL; });
}
__device__ __forceinline__ void unit_diff(Frame& F, int layer, int b, int h, int mp, int qb) {
    using namespace att;
    const int r32 = F.lane & 31, hi = F.lane >> 5;
    const lptr L = (lptr)(F.lds + RING_OFF);
    const size_t seq0 = (size_t)b * SEQ;
    const int qlo = qb * 256 + F.wave * 32, qpos = qlo + r32;
    const bf16_t* Q = (const bf16_t*)(F.ws + WS_Q) + seq0 * MIXW + (h * 2 + mp) * 64;
    const bf16_t* K = (const bf16_t*)(F.ws + WS_K) + seq0 * MIXW + (h * 2 + mp) * 64;
    const bf16_t* V = (const bf16_t*)(F.ws + WS_V) + seq0 * MIXW + h * 128;
    bf16x8 qr[4]; load_q(qr, Q + (size_t)qpos * MIXW, hi);
    f32x16 o[4]; o[0] = f32x16{}; o[1] = f32x16{}; o[2] = f32x16{}; o[3] = f32x16{}; float m_run = NEG_INF, l_run = 0.f;
    BMBand bm; bm.init(qpos, qlo, 1 << 20, alibi2(h, 6), hi);
#if PROBE_OUT
    const int tl_ = skip_first_tile(F, layer, b, h * 2 + mp, alibi2(h, 6), qb * 256);
    const unsigned long long c0_ = __builtin_amdgcn_s_memtime(), r0_ = __builtin_amdgcn_s_memrealtime();
    flash_loop<128>(L, qr, K, V, MIXW, MIXW, qb * 4 + 3, tl_, bm, o, m_run, l_run);
    const unsigned long long c1_ = __builtin_amdgcn_s_memtime(), r1_ = __builtin_amdgcn_s_memrealtime();
    if (b == 0 && h == 5 && mp == 0 && qb == 31 && F.tid == 0) {
        const float steps = (float)(qb * 4 + 3 - tl_ + 2);
        float* pm = (float*)(F.ws + WS_MISC);
        pm[4] = (float)(c1_ - c0_) / steps;
        pm[5] = (float)(c1_ - c0_) / (float)(r1_ - r0_) * 0.1f;
        pm[6] = steps;
    }
#else
    flash_loop<128>(L, qr, K, V, MIXW, MIXW, qb * 4 + 3, skip_first_tile(F, layer, b, h * 2 + mp, alibi2(h, 6), qb * 256), bm, o, m_run, l_run);
#endif
    bf16_t* od = (bf16_t*)(F.ws + WS_MIX) + (seq0 + qlo) * 1536 + (h * 2 + mp) * 128;
    finish_unit<128, false>(L, o, m_run, l_run, [=](int i) { return od + (size_t)i * 1536; });
}
__device__ __forceinline__ void phase_attn(Frame& F, int layer, int rep) {
    const int kind = layer % 3, G = F.G, v = F.vcu;
    if (kind == 0) {
#ifndef DIS_DSW
        for (int un = v; un < 768 + 256; un += G) { if (un < 768) unit_dsw(F, un); else unit_mem(F, layer, un - 768); }
#endif
    } else {
        volatile LAS unsigned* MISC = (volatile LAS unsigned*)(F.lds + MISC_OFF);
        const int x0 = (int)(xb_xcc_id() & 7u);
        gu32* ctr0 = (gu32*)(F.ws + WS_CTL) + CW_QUEUE + 64 * (layer * 8 + 32 * rep);
        int qi = 0;
        for (int it = 0;; ++it) {
            if (F.tid == 0) {
                unsigned code = 0xffffffffu; int q = qi;
                for (; q < 8; ++q) { const int x = (x0 + q) & 7; const unsigned idx = __hip_atomic_fetch_add(ctr0 + 64 * x, 1u, __ATOMIC_RELAXED, __HIP_MEMORY_SCOPE_AGENT); if (idx < 96u + 32u) { code = ((unsigned)q << 8) | idx; break; } }
                MISC[12 + (it & 1)] = code;
            }
            asm volatile("s_waitcnt vmcnt(0) lgkmcnt(0)\n\ts_barrier" ::: "memory");
            const unsigned code = MISC[12 + (it & 1)];
            if (code == 0xffffffffu) break;
            qi = (int)(code >> 8); const int idx = (int)(code & 0xffu), x = (x0 + qi) & 7, b = x >> 2, j = x & 3;
            if (idx < 96) { const int sl = idx >> 5, qb = 31 - (idx & 31);
#ifndef DIS_MOBA
                if (kind == 1) { const int h = sl == 0 ? 8 + j : (sl == 1 ? 7 - j : j); unit_moba(F, layer, b, h, qb); }
                else
#endif
#ifndef DIS_DIFF
                { const int h = sl == 0 ? 4 + (j >> 1) : (sl == 1 ? 3 - (j >> 1) : (j >> 1)), mp = j & 1; unit_diff(F, layer, b, h, mp, qb); }
#else
                {}
#endif
            }
#ifndef DIS_MEM
            else unit_mem(F, layer, x * 32 + (idx - 96));
#endif
        }
    }
}
__device__ __forceinline__ float bf2f(unsigned short u) { return __uint_as_float(((unsigned)u) << 16); }
__device__ __forceinline__ void phase_finalize(Frame& F, const Args& A, int layer) {
    typedef unsigned short us8 __attribute__((ext_vector_type(8)));
    const int kind = layer % 3, gw = F.vcu * NWAVES + F.wave, NGW = F.G * NWAVES, lane = F.lane;
    bf16* gate = (bf16*)(F.ws + WS_GATE);
    const bf16* mix = (const bf16*)(F.ws + WS_MIX);
    const float* lse = (const float*)(F.ws + WS_LSE);
    const float lam = ((const float*)(F.ws + WS_MISC))[0], lam_scale = 1.0f - diff_lambda_init();
    for (int m = gw; m < MROWS; m += NGW) {
        float v[16];
        if (lane < 48) {
            if (kind == 2) {
                const int h = lane >> 3, dd = (lane & 7) * 16;
                const us8* p1 = (const us8*)(mix + (size_t)m * 1536 + h * 256 + dd); const us8* p2 = (const us8*)(mix + (size_t)m * 1536 + h * 256 + 128 + dd);
                const us8 a0 = p1[0], a1 = p1[1], b0 = p2[0], b1 = p2[1];
#pragma unroll
                for (int e = 0; e < 8; ++e) { v[e] = bf2f(a0[e]) - lam * bf2f(b0[e]); v[8 + e] = bf2f(a1[e]) - lam * bf2f(b1[e]); }
            } else {
                const us8* p1 = (const us8*)(mix + (size_t)m * MIXW + lane * 16); const us8 a0 = p1[0], a1 = p1[1];
#pragma unroll
                for (int e = 0; e < 8; ++e) { v[e] = bf2f(a0[e]); v[8 + e] = bf2f(a1[e]); }
            }
        } else {
#pragma unroll
            for (int e = 0; e < 16; ++e) v[e] = 0.f;
        }
        float sc = 1.0f;
        if (kind == 2) {
            float ss = 0.f;
#pragma unroll
            for (int e = 0; e < 16; ++e) ss += v[e] * v[e];
            ss += __shfl_xor(ss, 1); ss += __shfl_xor(ss, 2); ss += __shfl_xor(ss, 4);
            sc = lam_scale / sqrtf(ss * (1.0f / 128.0f) + SUBLN_EPS);
            if (lane < 48) { const float* sg = IN_SUBLN_G(A) + (lane & 7) * 16;
#pragma unroll
                for (int e = 0; e < 16; ++e) v[e] *= sg[e]; }
            else sc = 1.0f;
        } else if (kind == 0 && lane < 48) {
            const int hh = lane >> 2, j = hh & 3, g = hh >> 2;
            const float* lr = lse + (size_t)m * 12;
            const float l0 = lr[j], l1 = lr[4 + j], l2 = lr[8 + j], mx = fmaxf(fmaxf(l0, l1), l2);
            const float e0 = exp2f(l0 - mx), e1 = exp2f(l1 - mx), e2 = exp2f(l2 - mx);
            sc = (g == 0 ? e0 : (g == 1 ? e1 : e2)) / (e0 + e1 + e2);
        }
        if (lane >= 48) continue;
        us8* gp = (us8*)(gate + (size_t)m * DMODEL + lane * 16);
        const us8 g0 = gp[0], g1 = gp[1]; us8 y0, y1;
#pragma unroll
        for (int e = 0; e < 8; ++e) {
            const float ga = bf2f(g0[e]), gb = bf2f(g1[e]);
            const float sa = ga / (1.0f + exp2f(-ga * LOG2E)), sb = gb / (1.0f + exp2f(-gb * LOG2E));
            y0[e] = (unsigned short)f2bf(v[e] * sc * sa); y1[e] = (unsigned short)f2bf(v[8 + e] * sc * sb);
        }
        gp[0] = y0; gp[1] = y1;
    }
}
__device__ __forceinline__ void phase_final_norm(Frame& F, const Args& A) {
    const int gw = F.vcu * NWAVES + F.wave, NGW = F.G * NWAVES;
    const float* ssq = (const float*)(F.ws + WS_SSQ);
    for (int m = gw; m < MROWS; m += NGW) {
        GAS f32x4* xr = (GAS f32x4*)(A.out + (size_t)m * DMODEL) + F.lane;
        const float p = (F.lane < 16) ? ssq[(size_t)m * 16 + F.lane] : 0.f;
        const float rstd = 1.0f / sqrtf(wave_sum(p) * (1.0f / DMODEL) + RMS_EPS);
#pragma unroll
        for (int j = 0; j < 4; ++j) { const f32x4 g = *((const f32x4*)IN_FINAL_G(A) + F.lane + 64 * j); f32x4 v = xr[64 * j]; v = v * rstd * g; xr[64 * j] = v; }
#if PROBE_OUT
        if (m == 0 && F.lane == 0) { const float* pm = (const float*)(F.ws + WS_MISC); float pv = PROBE_OUT == 300 ? 8.f + floorf((float)(__builtin_amdgcn_s_memrealtime() - ((const unsigned long long*)(F.ws + WS_MISC + 1024))[0]) * 0.01f * 0.05f) - 60.f : PROBE_OUT >= 200 ? 8.f + floorf((float)(((const unsigned long long*)(F.ws + WS_MISC + 1024))[PROBE_OUT - 200] - ((const unsigned long long*)(F.ws + WS_MISC + 1024))[0]) * 0.01f * 0.02f) : PROBE_OUT >= 100 ? 8.f + floorf((float)(((const unsigned long long*)(F.ws + WS_MISC + 1024))[PROBE_OUT - 100 + 1] - ((const unsigned long long*)(F.ws + WS_MISC + 1024))[PROBE_OUT - 100]) * 0.01f * 0.2f) : PROBE_OUT >= 10 ? 8.f + floorf(pm[16 + PROBE_OUT - 10] * 0.1f) : PROBE_OUT == 1 ? 8.f + floorf(pm[4] * (1.0f / 200.0f)) : (PROBE_OUT == 2 ? floorf(pm[5] * 10.f) : pm[6] * 0.25f); A.out[0] = fminf(pv, 45.f); }
#endif
    }
}

__global__ void __launch_bounds__(NWAVES * 64, 2) trunk_fwd(Args args) {
    extern __shared__ __attribute__((aligned(16))) unsigned char lds[];
    Frame F;
    F.lds = (LAS unsigned char*)lds;
    volatile LAS unsigned* MISC = (volatile LAS unsigned*)(F.lds + MISC_OFF);
    F.tid = threadIdx.x; F.lane = F.tid & 63; F.wave = __builtin_amdgcn_readfirstlane(F.tid >> 6);
    F.G = gridDim.x; { const int bx = blockIdx.x; F.vcu = (F.G % 8 == 0) ? (bx % 8) * (F.G / 8) + bx / 8 : bx; }
    F.ws = args.ws;
    gu32* ctl = (gu32*)(F.ws + WS_CTL);
    for (int u = F.tid; u < (LDS_BYTES - LDSCTL_OFF) / 4; u += NWAVES * 64) ((LAS unsigned*)(F.lds + LDSCTL_OFF))[u] = 0u;
    __syncthreads();
    XcdBarrier bar; bar.bar = (unsigned*)(ctl + CW_BAR); bar.x = 0; bar.st = nullptr;
    if (!MK_PER_PHASE) bar = xcd_barrier_post((unsigned*)(ctl + CW_BAR), MISC + 8);
    const int lo = args.ph_lo, hi = args.ph_hi;
#define IN(k) (lo <= (k) && (k) < hi)
#if PROBE_OUT >= 100
#define PSTAMP_PH(k) do { if (blockIdx.x == 0 && threadIdx.x == 0) ((unsigned long long*)(F.ws + WS_MISC + 1024))[(k)] = __builtin_amdgcn_s_memrealtime(); } while (0)
#else
#define PSTAMP_PH(k) do {} while (0)
#endif
#define SEAM(k) do { if (IN(k) && IN((k) + 1)) xcd_barrier(bar); PSTAMP_PH((k) + 1); } while (0)

        PSTAMP_PH(0);
#ifndef DIS_P0
    if (IN(0)) { p0_prologue(F, args);
#if PROBE_DUP & 4
        __syncthreads(); p0_prologue(F, args);
#endif
    }
#endif
    SEAM(0);
#define FRESH_TID() do { int t_ = threadIdx.x; asm volatile("" : "+v"(t_)); F.tid = t_; F.lane = t_ & 63; F.wave = __builtin_amdgcn_readfirstlane(t_ >> 6); } while (0)
    for (int layer = 0; layer < DEPTH; ++layer) {
        const int pb = 1 + 4 * layer, kind = layer % 3;
#ifndef DIS_GIN
        if (IN(pb)) for (int rep_ = 0; rep_ < (((PROBE_DUP & 1) && ((PROBE_LAYERS >> layer) & 1)) ? 2 : 1); ++rep_) {
#ifndef DIS_INP
            { pg8::Gemm g{(const pg8::bf16_t*)(F.ws + WS_XB), (const pg8::bf16_t*)(F.ws + WS_WIN) + (size_t)layer * INW * DMODEL, MROWS, INW, DMODEL};
              pg8::StaticOrder S; S.init(MROWS, INW, F.G, (int)blockIdx.x);
              pg8::EpiIn E{F.ws, kind, layer};
              pg8::gemm_phase<pg8::EpiIn, pg8::StaticOrder, true, true>(F.lds + RING_OFF, g, S, E); }
#endif
#ifndef DIS_MEMKV
            if (layer == 0) {
              pg8::Gemm g{(const pg8::bf16_t*)(F.ws + WS_MEMN), (const pg8::bf16_t*)(F.ws + WS_WMEM), BATCH * NMEM, DEPTH * 512, DMODEL};
              pg8::TailOrder S{2, 8, F.G, (int)blockIdx.x};
              pg8::EpiPlain E{(pg8::bf16_t*)(F.ws + WS_MEMKV), DEPTH * 512};
              pg8::gemm_phase<pg8::EpiPlain, pg8::TailOrder, true, true>(F.lds + RING_OFF, g, S, E); }
#endif
            if (rep_ == 0) {
                FRESH_TID();
                const int c = (int)blockIdx.x;
                if (F.G == 256) { const int hi_c = (layer == 0) ? 240 : 256; if (c >= 128 && c < hi_c) convert_deferred(F, args, layer, (c - 128) * NWAVES + F.wave, (hi_c - 128) * NWAVES); }
                else convert_deferred(F, args, layer, c * NWAVES + F.wave, F.G * NWAVES);
            }
        }
#endif
        SEAM(pb);
#ifndef DIS_ATT
        if (IN(pb + 1)) for (int rep_ = 0; rep_ < (((PROBE_DUP & 2) && ((PROBE_LAYERS >> layer) & 1)) ? 2 : 1); ++rep_) { FRESH_TID();
#if PROBE_OUT >= 10
            const unsigned long long r0_ = __builtin_amdgcn_s_memrealtime();
#endif
            phase_attn(F, layer, rep_);
#if PROBE_OUT >= 10
            if (blockIdx.x == 0 && F.tid == 0) ((float*)(F.ws + WS_MISC))[16 + layer] = (float)(__builtin_amdgcn_s_memrealtime() - r0_) * 0.01f;
#endif
        }
#endif
        SEAM(pb + 1);
#ifndef DIS_FIN
        if (IN(pb + 2) && kind != 1) { FRESH_TID(); phase_finalize(F, args, layer); }
#endif
        if (kind != 1) SEAM(pb + 2);
#ifndef DIS_GOUT
        if (IN(pb + 3)) for (int rep_ = 0; rep_ < (((PROBE_DUP & 8) && layer == 0) ? 2 : 1); ++rep_) {
            pg8::Gemm g{(const pg8::bf16_t*)(F.ws + WS_GATE), (const pg8::bf16_t*)(F.ws + WS_WOUT) + (size_t)layer * DMODEL * DMODEL, MROWS, DMODEL, DMODEL};
            pg8::StaticOrder S; S.init(MROWS, DMODEL, F.G, (int)blockIdx.x);
            pg8::EpiOut E{layer == 0 ? IN_X(args) : args.out, args.out, (pg8::bf16_t*)(F.ws + WS_XB), (float*)(F.ws + WS_SSQ)};
            pg8::gemm_phase<pg8::EpiOut, pg8::StaticOrder, true, true>(F.lds + RING_OFF, g, S, E);
        }
#endif
        SEAM(pb + 3);
    }
    if (IN(NPHASES - 1)) { FRESH_TID(); phase_final_norm(F, args); }
#undef IN
#undef SEAM
}

extern "C" void kernel_launch(void* const* d_in, const int* in_sizes, int n_in, void* d_out, int out_size, void* d_ws, size_t ws_size, hipStream_t stream) {
    static int grid = 0;
    if (grid == 0) {
        if (n_in != 13 || out_size != MROWS * DMODEL || ws_size < WS_END) { fprintf(stderr, "kernel_launch: unexpected problem shape (n_in %d, out %d, ws %zu); nothing launched\n", n_in, out_size, ws_size); grid = -1; return; }
        int dev = 0, cus = 0, per_cu = 0;
        if (hipGetDevice(&dev) != hipSuccess || hipDeviceGetAttribute(&cus, hipDeviceAttributeMultiprocessorCount, dev) != hipSuccess) { grid = -1; return; }
        if (hipFuncSetAttribute((const void*)trunk_fwd, hipFuncAttributeMaxDynamicSharedMemorySize, LDS_BYTES) != hipSuccess) { fprintf(stderr, "kernel_launch: hipFuncSetAttribute failed\n"); grid = -1; return; }
        if (hipOccupancyMaxActiveBlocksPerMultiprocessor(&per_cu, (const void*)trunk_fwd, NWAVES * 64, LDS_BYTES) != hipSuccess || per_cu < 1) { fprintf(stderr, "kernel_launch: occupancy query says %d workgroups per CU\n", per_cu); per_cu = 1; }
        (void)hipGetLastError();
        grid = cus;
    }
    if (grid < 0) return;
    if (hipMemsetAsync((char*)d_ws + WS_CTL, 0, CTL_USED_BYTES, stream) != hipSuccess) { fprintf(stderr, "kernel_launch: hipMemsetAsync failed\n"); return; }
    Args a{};
    for (int i = 0; i < 13; ++i) a.in[i] = (const float*)d_in[i];
    a.out = (float*)d_out; a.ws = (unsigned char*)d_ws;
#if MK_PER_PHASE
    for (int p = 0; p < NPHASES; ++p) { a.ph_lo = p; a.ph_hi = p + 1; a.li = p; hipLaunchKernelGGL(trunk_fwd, dim3(grid), dim3(NWAVES * 64), LDS_BYTES, stream, a); }
#else
    a.ph_lo = 0; a.ph_hi = NPHASES; a.li = 0;
    hipLaunchKernelGGL(trunk_fwd, dim3(grid), dim3(NWAVES * 64), LDS_BYTES, stream, a);
#endif
    const hipError_t le = hipPeekAtLastError();
    if (le != hipSuccess) fprintf(stderr, "kernel_launch: launch failed: %s\n", hipGetErrorName(le));
}
```

```cpp
#include <hip/hip_runtime.h>
#include <hip/hip_bf16.h>
#include <cstdio>
#include <cstdint>
#include <cmath>

#ifndef MK_PER_PHASE
#define MK_PER_PHASE 0
#endif

#ifndef PROBE_WORK
#define PROBE_WORK 0
#endif
#ifndef PROBE_OUT
#define PROBE_OUT 0
#endif
#ifndef PROBE_LAYERS
#define PROBE_LAYERS 15
#endif
#ifndef PROBE_DUP
#define PROBE_DUP 0
#endif
constexpr int BATCH = 2, SEQ = 8192, DMODEL = 1024, DEPTH = 4, MROWS = BATCH * SEQ;
constexpr int MIXW = 768, MEMW = 256, NMEM = 256, INW = 3584;
constexpr float RMS_EPS = 1e-6f, SUBLN_EPS = 1e-5f;
constexpr float LOG2E = 1.4426950408889634f;
constexpr float QSCALE = 0.125f * LOG2E;
constexpr size_t MiB = 1u << 20;
constexpr size_t WS_CTL = 0, CTL_ZERO_BYTES = 1 * MiB;
constexpr size_t WS_WIN = 1 * MiB;
constexpr size_t WS_WOUT = 29 * MiB;
constexpr size_t WS_WMEM = 37 * MiB;
constexpr size_t WS_XB = 41 * MiB;
constexpr size_t WS_Q = 73 * MiB, WS_K = 97 * MiB, WS_V = 121 * MiB;
constexpr size_t WS_QM = 145 * MiB;
constexpr size_t WS_GATE = 153 * MiB;
constexpr size_t WS_MIX = 185 * MiB;
constexpr size_t WS_MO = 233 * MiB;
constexpr size_t WS_MEMN = 241 * MiB;
constexpr size_t WS_MEMKV = 242 * MiB;
constexpr size_t WS_LSE = 244 * MiB;
constexpr size_t WS_SSQ = 245 * MiB;
constexpr size_t WS_KPART = 246 * MiB;
constexpr size_t WS_MISC = 247 * MiB;
constexpr size_t WS_NRM = 247 * MiB + 4096;
constexpr size_t WS_END = 248 * MiB;
constexpr size_t CTL_USED_BYTES = 64 * 1024;
constexpr int CW_QUEUE = 8192;
constexpr int CW_BAR = 4096;
namespace pg8 {
#define PG8_LAS __attribute__((address_space(3)))
typedef unsigned short bf16_t;
typedef short bf16x8 __attribute__((ext_vector_type(8)));
typedef float f32x4 __attribute__((ext_vector_type(4)));
typedef unsigned u32x4 __attribute__((ext_vector_type(4)));
constexpr int BM = 256, BK = 64, HALF = 128, HTB = HALF * BK * 2  , STAGE_BYTES = 8 * HTB, NXCD = 8, WGM = 8;

__host__ __device__ __forceinline__ int lds_byte(int r, int c) { const int st = (r >> 4) * 2 + (c >> 5), rr = r & 15, cc = c & 31, ob = rr * 64 + cc * 2; return st * 1024 + (ob ^ (((ob >> 9) & 1) << 5)); }
__host__ __device__ __forceinline__ void stage_rc(int b, int& R, int& C) { const int st = b / 1024, sb = b % 1024, swz = sb ^ (((sb >> 9) & 1) << 5); R = (st >> 1) * 16 + swz / 64; C = (st & 1) * 32 + (swz % 64) / 2; }
__host__ __device__ __forceinline__ int perm32(int rho) { const int n = rho >> 4, i = rho & 15; return 8 * (i >> 2) + 4 * n + (i & 3); }

struct Unit { int pm, pn; };
struct Gemm { const bf16_t* A; const bf16_t* Bt; int M, N, K; };

struct StaticOrder {
    int nM, nN, nwg, G, c;
    __host__ __device__ void init(int M, int N, int G_, int c_) { nM = M / BM; nN = N / BM; nwg = nM * nN; G = G_; c = c_; }
    __host__ __device__ bool next(int i, Unit& u) const {
        const long L = (long)i * G + c; if (L >= nwg) return false;
        int wgid = (int)L; { const int q = nwg / NXCD, r = nwg % NXCD, xcd = wgid % NXCD, off = wgid / NXCD; wgid = (xcd < r ? xcd * (q + 1) : r * (q + 1) + (xcd - r) * q) + off; }
        const int nig = WGM * nN, gid = wgid / nig, fm = gid * WGM, gsz = (nM - fm) < WGM ? (nM - fm) : WGM;
        u.pm = fm + ((wgid % nig) % gsz); u.pn = (wgid % nig) / gsz; return true;
    }
    __device__ __forceinline__ void a_ready(const Unit&) const {}
    __device__ __forceinline__ void done(const Unit&) const {}
};

typedef float f32x2 __attribute__((ext_vector_type(2)));
typedef __bf16 bf16x2_t __attribute__((ext_vector_type(2)));
typedef unsigned u32x2 __attribute__((ext_vector_type(2)));
__device__ __forceinline__ unsigned cvt_pk_bf16(float lo, float hi) { f32x2 v = {lo, hi}; bf16x2_t b = __builtin_convertvector(v, bf16x2_t); return __builtin_bit_cast(unsigned, b); }

struct EpiIn {
    static constexpr bool PERM = true, AFTER_DRAIN = false;
    unsigned char* ws; int kind, layer;
    __device__ __forceinline__ void operator()(const f32x4 (&acc)[2][2][4][2], const Unit& u, int wr, int wc, int fr, int fq) const {
        const int pn = u.pn;
        size_t boff; int ldc, colt, sh = 0;
        static_assert(WS_K - WS_Q == WS_V - WS_K, "q | k | v equally spaced");
        if (pn < 9) { const int sec = pn / 3, g = pn - 3 * sec; boff = WS_Q + (size_t)sec * (WS_K - WS_Q); ldc = MIXW; colt = g * 256; if (kind == 0) sh = 2 * g; }
        else if (pn == 9) { boff = WS_QM; ldc = MEMW; colt = 0; }
        else { boff = WS_GATE; ldc = DMODEL; colt = (pn - 10) * 256; }
        bf16_t* base = (bf16_t*)(ws + boff);
        const float* ssq = (const float*)(ws + WS_SSQ); float* kpart = (float*)(ws + WS_KPART);
        const int col0 = colt + wc * 32 + 8 * fq;
        const bool want_ksum = (kind == 1) && (pn >= 3) && (pn < 6);
#pragma unroll
        for (int ai = 0; ai < 2; ++ai)
#pragma unroll
            for (int m = 0; m < 4; ++m) {
                const int row = u.pm * BM + ai * HALF + wr * 64 + m * 16 + fr;
                const f32x4 sp = *(const f32x4*)(ssq + (size_t)row * 16 + 4 * fq);
                float s = (sp[0] + sp[1]) + (sp[2] + sp[3]);
                s += __shfl_xor(s, 16); s += __shfl_xor(s, 32);
                const float rstd = 1.0f / sqrtf(s * (1.0f / DMODEL) + RMS_EPS);
                int orow = row;
                if (sh) { const int b = row >> 13, t = row & (SEQ - 1); orow = (b << 13) + ((t & ((1 << sh) - 1)) << (13 - sh)) + (t >> sh); }
                bf16_t* rowp = base + (size_t)orow * ldc + col0;
#pragma unroll
                for (int bj = 0; bj < 2; ++bj) {
                    const f32x4 v0 = acc[ai][bj][m][0] * rstd, v1 = acc[ai][bj][m][1] * rstd;
                    u32x4 w; w.x = cvt_pk_bf16(v0[0], v0[1]); w.y = cvt_pk_bf16(v0[2], v0[3]); w.z = cvt_pk_bf16(v1[0], v1[1]); w.w = cvt_pk_bf16(v1[2], v1[3]);
                    *(u32x4*)(rowp + bj * HALF) = w;
                }
                if (m & 1) asm volatile("" ::: "memory");
            }
        if (kind != 0 && pn < 6) {
            float rs[2][4];
#pragma unroll
            for (int ai = 0; ai < 2; ++ai)
#pragma unroll
                for (int m = 0; m < 4; ++m) {
                    const int row = u.pm * BM + ai * HALF + wr * 64 + m * 16 + fr;
                    const f32x4 sp = *(const f32x4*)(ssq + (size_t)row * 16 + 4 * fq);
                    float s = (sp[0] + sp[1]) + (sp[2] + sp[3]);
                    s += __shfl_xor(s, 16); s += __shfl_xor(s, 32);
                    rs[ai][m] = 1.0f / sqrtf(s * (1.0f / DMODEL) + RMS_EPS);
                }
#pragma unroll
            for (int bj = 0; bj < 2; ++bj) {
                float mx = 0.f;
#pragma unroll
                for (int ai = 0; ai < 2; ++ai)
#pragma unroll
                    for (int m = 0; m < 4; ++m) {
                        const f32x4 v0 = acc[ai][bj][m][0] * rs[ai][m], v1 = acc[ai][bj][m][1] * rs[ai][m];
                        float q = ((v0[0] * v0[0] + v0[1] * v0[1]) + (v0[2] * v0[2] + v0[3] * v0[3])) + ((v1[0] * v1[0] + v1[1] * v1[1]) + (v1[2] * v1[2] + v1[3] * v1[3]));
                        q += __shfl_xor(q, 16); q += __shfl_xor(q, 32);
                        mx = fmaxf(mx, q);
                    }
                mx = fmaxf(mx, __shfl_xor(mx, 1)); mx = fmaxf(mx, __shfl_xor(mx, 2)); mx = fmaxf(mx, __shfl_xor(mx, 4)); mx = fmaxf(mx, __shfl_xor(mx, 8));
                if (fr == 0 && fq == 0) atomicMax((unsigned*)(ws + WS_NRM) + layer * 96 + ((u.pm >> 5) * 2 + pn / 3) * 24 + (pn % 3) * 8 + bj * 4 + wc, __float_as_uint(mx));
            }
            if (want_ksum) {
#pragma unroll
                for (int bj = 0; bj < 2; ++bj)
#pragma unroll
                    for (int n = 0; n < 2; ++n) {
                        f32x4 v = (f32x4){0.f, 0.f, 0.f, 0.f};
#pragma unroll
                        for (int ai = 0; ai < 2; ++ai)
#pragma unroll
                            for (int m = 0; m < 4; ++m) v += acc[ai][bj][m][n] * rs[ai][m];
#pragma unroll
                        for (int e = 0; e < 4; ++e) { float x = v[e]; x += __shfl_xor(x, 1); x += __shfl_xor(x, 2); x += __shfl_xor(x, 4); x += __shfl_xor(x, 8); v[e] = x; }
                        if (fr == 0) *(f32x4*)(kpart + (size_t)(u.pm * 2 + wr) * MIXW + (pn - 3) * 256 + bj * HALF + wc * 32 + 8 * fq + 4 * n) = v;
                    }
            }
        }
    }
};
struct EpiPlain {
    static constexpr bool PERM = true, AFTER_DRAIN = false;
    bf16_t* O; int ldc;
    __device__ __forceinline__ void operator()(const f32x4 (&acc)[2][2][4][2], const Unit& u, int wr, int wc, int fr, int fq) const {
        const int col0 = u.pn * BM + wc * 32 + 8 * fq;
#pragma unroll
        for (int ai = 0; ai < 2; ++ai)
#pragma unroll
            for (int m = 0; m < 4; ++m) {
                bf16_t* rowp = O + (size_t)(u.pm * BM + ai * HALF + wr * 64 + m * 16 + fr) * ldc + col0;
#pragma unroll
                for (int bj = 0; bj < 2; ++bj) {
                    const f32x4 v0 = acc[ai][bj][m][0], v1 = acc[ai][bj][m][1];
                    u32x4 w; w.x = cvt_pk_bf16(v0[0], v0[1]); w.y = cvt_pk_bf16(v0[2], v0[3]); w.z = cvt_pk_bf16(v1[0], v1[1]); w.w = cvt_pk_bf16(v1[2], v1[3]);
                    *(u32x4*)(rowp + bj * HALF) = w;
                }
            }
    }
};
struct EpiOut {
    static constexpr bool PERM = false, AFTER_DRAIN = false;
    const float* xin; float* xout; bf16_t* xb; float* ssq; int want_xb;
    __device__ __forceinline__ void operator()(const f32x4 (&acc)[2][2][4][2], const Unit& u, int wr, int wc, int fr, int fq) const {
        const int col0 = u.pn * BM + wc * 32 + 4 * fq;
#pragma unroll
        for (int ai = 0; ai < 2; ++ai)
#pragma unroll
            for (int m = 0; m < 4; ++m) {
                const int row = u.pm * BM + ai * HALF + wr * 64 + m * 16 + fr;
                const size_t off = (size_t)row * DMODEL + col0;
                float s = 0.f;
#pragma unroll
                for (int bj = 0; bj < 2; ++bj)
#pragma unroll
                    for (int n = 0; n < 2; ++n) {
                        const size_t o = off + bj * HALF + n * 16;
                        const f32x4 v = *(const f32x4*)(xin + o) + acc[ai][bj][m][n];
                        *(f32x4*)(xout + o) = v;
                        if (want_xb) { u32x2 w; w.x = cvt_pk_bf16(v[0], v[1]); w.y = cvt_pk_bf16(v[2], v[3]); *(u32x2*)(xb + o) = w; }
                        s += (v[0] * v[0] + v[1] * v[1]) + (v[2] * v[2] + v[3] * v[3]);
                    }
                s += __shfl_xor(s, 16); s += __shfl_xor(s, 32);
                if (fq == 0) ssq[(size_t)row * 16 + u.pn * 4 + wc] = s;
            }
    }
};
struct TailOrder {
    int nM, nN, G, c;
    __device__ bool next(int i, Unit& u) const { const int nwg = nM * nN; int idx = c - (G - nwg); if (G < nwg) idx = c; idx += i * G; if (idx < 0 || idx >= nwg || (i > 0 && G >= nwg)) return false; u.pm = idx % nM; u.pn = idx / nM; return true; }
    __device__ __forceinline__ void a_ready(const Unit&) const {}
    __device__ __forceinline__ void done(const Unit&) const {}
};
template <class Epi, class Sched, bool ALIGN_EPI = false, bool SP2 = false>
__device__ __forceinline__ void gemm_phase(PG8_LAS unsigned char* lds, const Gemm g, const Sched& S, const Epi& E) {
    int tid_ = threadIdx.x; asm volatile("" : "+v"(tid_));
    const int tid = tid_, wid = __builtin_amdgcn_readfirstlane(tid >> 6), lane = tid & 63, wr = wid >> 2, wc = wid & 3, fr = lane & 15, fq = lane >> 4;
    const int K = g.K, nt = K / BK;
    unsigned voffA[2], voffB[2];
#pragma unroll
    for (int i = 0; i < 2; ++i) { int R, C; stage_rc(tid * 16 + i * 8192, R, C); const int Rb = Epi::PERM ? ((R & ~31) + perm32(R & 31)) : R;
        voffA[i] = (unsigned)(R * K + C) * 2u; voffB[i] = (unsigned)(Rb * K + C) * 2u; }
    const size_t kstep = (size_t)(BK * 2);
    const size_t hstep = (size_t)HALF * K * 2;
    const size_t tstep = 2 * hstep;
    const unsigned ldsw = (unsigned)wid * 1024u;
    const int aoff = lds_byte(wr * 64 + fr, fq * 8), boff = lds_byte(wc * 32 + fr, fq * 8);
#define PG8_SA(b, h) (((b) * 2 + (h)) * HTB)
#define PG8_SB(b, h) ((4 + (b) * 2 + (h)) * HTB)
#define PG8_STAGE(bufoff, gbase, voff) do { _Pragma("unroll") for (int _i = 0; _i < 2; ++_i) \
        __builtin_amdgcn_global_load_lds((const unsigned*)((const char*)(gbase) + (voff)[_i]), (PG8_LAS unsigned*)(lds + (bufoff) + ldsw + _i * 8192), 16, 0, 0); } while (0)
#define PG8_LDA(dst, b, h) do { _Pragma("unroll") for (int m = 0; m < 4; ++m) _Pragma("unroll") for (int k = 0; k < 2; ++k) dst[m][k] = *(const PG8_LAS bf16x8*)(lds + PG8_SA(b, h) + aoff + m * 2048 + k * 1024); } while (0)
#define PG8_LDB(dst, b, h) do { _Pragma("unroll") for (int n = 0; n < 2; ++n) _Pragma("unroll") for (int k = 0; k < 2; ++k) dst[n][k] = *(const PG8_LAS bf16x8*)(lds + PG8_SB(b, h) + boff + n * 2048 + k * 1024); } while (0)
#define PG8_MMA(ai, bj, At, Bt) do { __builtin_amdgcn_s_setprio(1); _Pragma("unroll") for (int m = 0; m < 4; ++m) _Pragma("unroll") for (int n = 0; n < 2; ++n) _Pragma("unroll") for (int k = 0; k < 2; ++k) \
        acc[ai][bj][m][n] = __builtin_amdgcn_mfma_f32_16x16x32_bf16(Bt[n][k], At[m][k], acc[ai][bj][m][n], 0, 0, 0); __builtin_amdgcn_s_setprio(0); } while (0)
#define PG8_WAIT_V(n) asm volatile("s_waitcnt vmcnt(" #n ")" ::: "memory")
#define PG8_WAIT_L(n) asm volatile("s_waitcnt lgkmcnt(" #n ")" ::: "memory")
#define PG8_BAR __builtin_amdgcn_s_barrier()
#define PG8_SCHED __builtin_amdgcn_sched_barrier(0)
    Unit cur, nxt; int ui = 0;
    if (!S.next(0, cur)) return;
    f32x4 acc[2][2][4][2];
#pragma unroll
    for (int a = 0; a < 2; ++a)
#pragma unroll
        for (int b = 0; b < 2; ++b)
#pragma unroll
            for (int m = 0; m < 4; ++m)
#pragma unroll
                for (int n = 0; n < 2; ++n) acc[a][b][m][n] = (f32x4){0.f, 0.f, 0.f, 0.f};
    bf16x8 At[4][2], B0[2][2], B1[2][2];
    const char* cA = (const char*)g.A + (size_t)cur.pm * tstep; const char* cB = (const char*)g.Bt + (size_t)cur.pn * tstep;
    S.a_ready(cur);
    if constexpr (SP2) {
        PG8_STAGE(PG8_SB(0, 0), cB, voffB); PG8_STAGE(PG8_SB(0, 1), cB + hstep, voffB); PG8_STAGE(PG8_SA(0, 0), cA, voffA); PG8_STAGE(PG8_SA(0, 1), cA + hstep, voffA);
        if (wr == 1) PG8_BAR;
        PG8_WAIT_V(2); PG8_BAR;
        PG8_STAGE(PG8_SB(1, 0), cB + kstep, voffB); PG8_STAGE(PG8_SA(1, 0), cA + kstep, voffA); PG8_STAGE(PG8_SB(1, 1), cB + hstep + kstep, voffB);
        PG8_WAIT_V(6); PG8_BAR;
    } else {
        PG8_STAGE(PG8_SB(0, 0), cB, voffB); PG8_STAGE(PG8_SA(0, 0), cA, voffA); PG8_STAGE(PG8_SB(0, 1), cB + hstep, voffB); PG8_STAGE(PG8_SA(0, 1), cA + hstep, voffA);
        if (wr == 1) PG8_BAR;
        PG8_WAIT_V(4); PG8_BAR;
        PG8_STAGE(PG8_SB(1, 0), cB + kstep, voffB); PG8_STAGE(PG8_SA(1, 0), cA + kstep, voffA); PG8_STAGE(PG8_SB(1, 1), cB + hstep + kstep, voffB);
        PG8_WAIT_V(6); PG8_BAR;
    }
    for (;;) {
        const bool has_next = S.next(ui + 1, nxt);
        const char* nA = has_next ? (const char*)g.A + (size_t)nxt.pm * tstep : cA; const char* nB = has_next ? (const char*)g.Bt + (size_t)nxt.pn * tstep : cB;
        for (int t = 0; t < nt; t += 2) {
            const bool last = (t == nt - 2);
            const char* a1 = cA + (size_t)(t + 1) * kstep;
            const char* a2 = last ? nA : cA + (size_t)(t + 2) * kstep; const char* b2 = last ? nB : cB + (size_t)(t + 2) * kstep;
            const char* a3 = a2 + kstep; const char* b3 = b2 + kstep;
            if (last && has_next) S.a_ready(nxt);
            if constexpr (SP2) {
            PG8_LDB(B0, 0, 0); PG8_LDB(B1, 0, 1); PG8_SCHED; PG8_LDA(At, 0, 0); PG8_STAGE(PG8_SA(1, 1), a1 + hstep, voffA);
            PG8_WAIT_V(8); PG8_WAIT_L(0); PG8_BAR; PG8_MMA(0, 0, At, B0); PG8_MMA(0, 1, At, B1); PG8_BAR; PG8_SCHED;
            PG8_LDA(At, 0, 1); PG8_STAGE(PG8_SB(0, 0), b2, voffB); PG8_STAGE(PG8_SB(0, 1), b2 + hstep, voffB); PG8_STAGE(PG8_SA(0, 0), a2, voffA);
            PG8_WAIT_V(8); PG8_WAIT_L(0); PG8_BAR; PG8_MMA(1, 0, At, B0); PG8_MMA(1, 1, At, B1); PG8_BAR; PG8_SCHED;
            PG8_LDB(B0, 1, 0); PG8_LDB(B1, 1, 1); PG8_SCHED; PG8_LDA(At, 1, 0); PG8_STAGE(PG8_SA(0, 1), a2 + hstep, voffA);
            PG8_WAIT_V(8); PG8_WAIT_L(0); PG8_BAR; PG8_MMA(0, 0, At, B0); PG8_MMA(0, 1, At, B1); PG8_BAR; PG8_SCHED;
            PG8_LDA(At, 1, 1); PG8_STAGE(PG8_SB(1, 0), b3, voffB); PG8_STAGE(PG8_SB(1, 1), b3 + hstep, voffB); PG8_STAGE(PG8_SA(1, 0), a3, voffA);
            PG8_WAIT_V(8); PG8_WAIT_L(0); PG8_BAR; PG8_MMA(1, 0, At, B0); PG8_MMA(1, 1, At, B1); PG8_BAR; PG8_SCHED;
            } else {
            PG8_LDB(B0, 0, 0); PG8_SCHED; PG8_LDA(At, 0, 0); PG8_STAGE(PG8_SA(1, 1), a1 + hstep, voffA);
            PG8_WAIT_L(8); PG8_BAR; PG8_WAIT_L(0); PG8_MMA(0, 0, At, B0); PG8_BAR; PG8_SCHED;
            PG8_LDB(B1, 0, 1); PG8_STAGE(PG8_SB(0, 0), b2, voffB);
            PG8_BAR; PG8_WAIT_L(0); PG8_MMA(0, 1, At, B1); PG8_BAR;
            PG8_LDA(At, 0, 1); PG8_STAGE(PG8_SA(0, 0), a2, voffA);
            PG8_BAR; PG8_WAIT_L(0); PG8_MMA(1, 0, At, B0); PG8_BAR; PG8_SCHED;
            PG8_STAGE(PG8_SB(0, 1), b2 + hstep, voffB);
            PG8_WAIT_V(6); PG8_BAR; PG8_MMA(1, 1, At, B1); PG8_BAR;
            PG8_LDB(B0, 1, 0); PG8_SCHED; PG8_LDA(At, 1, 0); PG8_STAGE(PG8_SA(0, 1), a2 + hstep, voffA);
            PG8_WAIT_L(8); PG8_BAR; PG8_WAIT_L(0); PG8_MMA(0, 0, At, B0); PG8_BAR; PG8_SCHED;
            PG8_LDB(B1, 1, 1); PG8_STAGE(PG8_SB(1, 0), b3, voffB);
            PG8_BAR; PG8_WAIT_L(0); PG8_MMA(0, 1, At, B1); PG8_BAR;
            PG8_LDA(At, 1, 1); PG8_STAGE(PG8_SA(1, 0), a3, voffA);
            PG8_BAR; PG8_WAIT_L(0); PG8_MMA(1, 0, At, B0); PG8_BAR; PG8_SCHED;
            PG8_STAGE(PG8_SB(1, 1), b3 + hstep, voffB);
            PG8_WAIT_V(6); PG8_BAR; PG8_MMA(1, 1, At, B1); PG8_BAR;
            }
        }
        if constexpr (ALIGN_EPI) { if (wr == 0) PG8_BAR; }
        if constexpr (!Epi::AFTER_DRAIN) { E(acc, cur, wr, wc, fr, fq); S.done(cur); }
        if (!has_next) break;
#pragma unroll
        for (int a = 0; a < 2; ++a)
#pragma unroll
            for (int b = 0; b < 2; ++b)
#pragma unroll
                for (int m = 0; m < 4; ++m)
#pragma unroll
                    for (int n = 0; n < 2; ++n) acc[a][b][m][n] = (f32x4){0.f, 0.f, 0.f, 0.f};
        cur = nxt; cA = nA; cB = nB; ++ui;
        if constexpr (ALIGN_EPI) { if (wr == 1) PG8_BAR; }
    }
    PG8_WAIT_V(0);
    if constexpr (!ALIGN_EPI) { if (wr == 0) PG8_BAR; }
    PG8_BAR;
    if constexpr (Epi::AFTER_DRAIN) { E.fused(acc, cur, wr, wc, fr, fq, lds, wid, lane); S.done(cur); }
#undef PG8_SA
#undef PG8_SB
#undef PG8_STAGE
#undef PG8_LDA
#undef PG8_LDB
#undef PG8_MMA
#undef PG8_WAIT_V
#undef PG8_WAIT_L
#undef PG8_BAR
#undef PG8_SCHED
}
}
namespace att {
#define LAS __attribute__((address_space(3)))
typedef unsigned short bf16_t;
typedef short bf16x8 __attribute__((ext_vector_type(8)));
typedef short s16x4 __attribute__((ext_vector_type(4)));
typedef short v4i16_t __attribute__((ext_vector_type(4)));
typedef float f32x16 __attribute__((ext_vector_type(16)));
typedef float f32x4 __attribute__((ext_vector_type(4)));
typedef float f32x2_t __attribute__((ext_vector_type(2)));
typedef __bf16 bf16x2_t __attribute__((ext_vector_type(2)));
typedef unsigned u32x4 __attribute__((ext_vector_type(4)));
typedef LAS char* lptr;
typedef LAS const char* lcptr;
constexpr int NW = 8;
constexpr int KSLOT = 8192, VSLOT = 16384;
#define ATT_PD 2
#if PROBE_WORK == 3
#define ATT_CNT64 4
#define ATT_CNT128 6
#else
#define ATT_CNT64 2
#define ATT_CNT128 3
#endif
constexpr int PD = ATT_PD, NKS = PD + 2, NVS = PD + 3;
constexpr int L_K = 0, L_V = NKS * KSLOT, L_WS = L_V + NVS * VSLOT, L_KM = L_WS + NW * 256, L_END = L_KM + 8192;
constexpr int L_OST = 0;
static_assert(NW * 8192 <= L_WS, "output stage inside the rings");
constexpr float NEG_INF = -INFINITY;

__device__ __forceinline__ int crow(int r, int hi) { return (r & 3) + 8 * (r >> 2) + 4 * hi; }
__device__ __forceinline__ unsigned cvtpk(float lo, float hi) { f32x2_t v = {lo, hi}; bf16x2_t b = __builtin_convertvector(v, bf16x2_t); return __builtin_bit_cast(unsigned, b); }
__device__ __forceinline__ float bf2f_lo(unsigned w) { return __uint_as_float(w << 16); }
__device__ __forceinline__ float bf2f_hi(unsigned w) { return __uint_as_float(w & 0xffff0000u); }
__device__ __forceinline__ void glds16(const void* gsrc, unsigned lds_dst) { unsigned keep;
    asm volatile("s_mov_b32 %0, m0\n\ts_mov_b32 m0, %2\n\ts_nop 0\n\tglobal_load_lds_dwordx4 %1, off\n\ts_mov_b32 m0, %0" : "=&s"(keep) : "v"(gsrc), "s"(lds_dst) : "memory"); }
#define ATT_WAIT_BAR() asm volatile("s_waitcnt vmcnt(0) lgkmcnt(0)\n\ts_barrier" ::: "memory")
#define ATT_STR2(x) #x
#define ATT_STR(x) ATT_STR2(x)
#define ATT_WAIT_BAR_N(N) asm volatile("s_waitcnt vmcnt(" ATT_STR(N) ") lgkmcnt(0)\n\ts_barrier" ::: "memory")
#define ATT_MFMA(a, b, c) __builtin_amdgcn_mfma_f32_32x32x16_bf16(a, b, c, 0, 0, 0)
__device__ __forceinline__ s16x4 vtr(lcptr p) { return __builtin_bit_cast(s16x4, __builtin_amdgcn_ds_read_tr16_b64_v4i16((LAS v4i16_t*)p)); }
__device__ __forceinline__ float swap_half(float v) { auto rr = __builtin_amdgcn_permlane32_swap(__float_as_uint(v), __float_as_uint(v), false, false); const int hi = (threadIdx.x >> 5) & 1; return __uint_as_float(hi ? rr[0] : rr[1]); }
__device__ __forceinline__ float rowmax(const f32x16& p0, const f32x16& p1) {
    float a = fmaxf(fmaxf(p0[0], p0[1]), p1[0]), b = fmaxf(fmaxf(p0[2], p0[3]), p1[1]); a = fmaxf(fmaxf(a, p1[2]), p1[3]);
#pragma unroll
    for (int r = 4; r < 16; r += 4) { a = fmaxf(fmaxf(a, p0[r]), p0[r + 1]); b = fmaxf(fmaxf(b, p0[r + 2]), p0[r + 3]); a = fmaxf(fmaxf(a, p1[r]), p1[r + 1]); b = fmaxf(fmaxf(b, p1[r + 2]), p1[r + 3]); }
    const float m = fmaxf(a, b);
    return fmaxf(m, swap_half(m));
}

struct BMNone {
    __device__ __forceinline__ bool active(int) const { return true; }
    __device__ __forceinline__ float cbase(int, float mref) const { return -mref; }
    __device__ __forceinline__ float cslope() const { return 0.f; }
    __device__ __forceinline__ void mask(int, f32x16&, f32x16&) const {}
};
struct BMBand {
    int qpos, qlo, W, hi; float slope2;
    __device__ __forceinline__ void init(int qpos_, int qlo_, int W_, float slope2_, int hi_) { qpos = qpos_; qlo = qlo_; W = W_; slope2 = slope2_; hi = hi_; }
    __device__ __forceinline__ bool active(int t) const { return (64 * t <= qlo + 31) && (64 * t + 63 >= qlo - W); }
    __device__ __forceinline__ float cbase(int t, float mref) const { return slope2 * (float)(64 * t + 4 * hi - qpos) - mref; }
    __device__ __forceinline__ float cslope() const { return slope2; }
    __device__ __forceinline__ void mask(int t, f32x16& p0, f32x16& p1) const {
        if ((64 * t + 63 > qlo) || (64 * t < qlo + 31 - W)) {
            const int d0 = qpos - 64 * t - 4 * hi;
#pragma unroll
            for (int r = 0; r < 16; ++r) { const int d = d0 - ((r & 3) + 8 * (r >> 2)); if (d < 0 || d > W) p0[r] = NEG_INF; const int e = d - 32; if (e < 0 || e > W) p1[r] = NEG_INF; }
        }
    }
};
struct BMMoba {
    BMBand band; unsigned sel; int qb;
    __device__ __forceinline__ bool active(int t) const { const int j = t >> 2; if (j == qb) return band.active(t); return __builtin_amdgcn_ballot_w64(((sel >> j) & 1u) != 0u) != 0ull; }
    __device__ __forceinline__ float cbase(int t, float mref) const { const int j = t >> 2; return band.cbase(t, (j == qb || ((sel >> j) & 1u)) ? mref : INFINITY); }
    __device__ __forceinline__ float cslope() const { return band.slope2; }
    __device__ __forceinline__ void mask(int t, f32x16& p0, f32x16& p1) const { const int j = t >> 2;
        if (j == qb) band.mask(t, p0, p1); }
};

constexpr float ATT_THR = 8.0f;
template <int DV, bool DO_QK, bool DO_PV, class BM>
__device__ __forceinline__ void att_block(const BM& bm, int tn, float mref, lcptr kq_, lcptr vq_, const bf16x8 (&qr)[4], f32x16& s0, f32x16& s1, f32x16& q0, f32x16& q1,
                                          u32x4 (&pan)[4], const u32x4 (&pao)[4], f32x16 (&o)[DV / 32], float& l_run) {
    constexpr int NPV = DO_PV ? DV / 8 : 0, NQK = DO_QK ? 8 : 0, NG = NPV + NQK;
    constexpr int KAH = 4, VAH = 3;
    constexpr int CG0 = NPV >= 8 ? NPV - 8 : 0;
    s16x4 lo[4], hh[4]; bf16x8 kfr[8];
    const bf16x8 pa_[4] = {__builtin_bit_cast(bf16x8, pao[0]), __builtin_bit_cast(bf16x8, pao[1]), __builtin_bit_cast(bf16x8, pao[2]), __builtin_bit_cast(bf16x8, pao[3])};
    float e0 = 0.f, e1 = 0.f;
    const float cb0 = DO_QK ? bm.cbase(tn, mref) : 0.f, csl = DO_QK ? bm.cslope() : 0.f, cb1 = cb0 + 32.f * csl;
#define ATT_VRD(f_) do { lo[(f_) & 3] = vtr(vq_ + ((f_) >> 2) * 4096 + ((f_) & 3) * 1024); hh[(f_) & 3] = vtr(vq_ + ((f_) >> 2) * 4096 + ((f_) & 3) * 1024 + 512); } while (0)
#define ATT_KRD(k_) do { kfr[k_] = *(const LAS bf16x8*)(kq_ + ((k_) >> 1) * 2048 + ((k_) & 1) * 512); } while (0)
#define ATT_PK(k) (bf16x8){lo[k][0], lo[k][1], lo[k][2], lo[k][3], hh[k][0], hh[k][1], hh[k][2], hh[k][3]}
#define ATT_EXP1(e_) do { if ((e_) < 16) { s0[(e_) & 15] = __builtin_amdgcn_exp2f(s0[(e_) & 15]); e0 += s0[(e_) & 15]; asm volatile("" : "+v"(e0)); } else { s1[(e_) & 15] = __builtin_amdgcn_exp2f(s1[(e_) & 15]); e1 += s1[(e_) & 15]; asm volatile("" : "+v"(e1)); } } while (0)
#define ATT_PACK1(p_) do { pan[(p_) >> 2][(p_) & 3] = ((p_) < 8) ? cvtpk(s0[(2 * (p_)) & 15], s0[(2 * (p_) + 1) & 15]) : cvtpk(s1[(2 * (p_)) & 15], s1[(2 * (p_) + 1) & 15]); } while (0)
#define ATT_CEL(c_) do { const float cf_ = (float)((((c_) & 15) & 3) + 8 * (((c_) & 15) >> 2)); if ((c_) < 16) q0[(c_) & 15] = __builtin_fmaf(csl, cf_, cb0); else q1[(c_) & 15] = __builtin_fmaf(csl, cf_, cb1); } while (0)
    if (DO_PV) {
#pragma unroll
        for (int f = 0; f < VAH; ++f) ATT_VRD(f);
    }
    if (DO_QK && NPV < KAH) {
#pragma unroll
        for (int k = 0; k < KAH - NPV; ++k) ATT_KRD(k);
    }
    if (DO_QK && NPV < 8) {
#pragma unroll
        for (int c = 0; c < 32; ++c) ATT_CEL(c);
    }
    __builtin_amdgcn_sched_barrier(0);
#pragma unroll
    for (int g = 0; g < NG; ++g) {
        if (g < NPV && g + VAH < NPV) ATT_VRD(g + VAH);
        if (DO_QK && g + KAH >= NPV && g + KAH - NPV < 8) ATT_KRD(g + KAH - NPV);
        if (g < NPV) o[g >> 2] = ATT_MFMA(pa_[g & 3], ATT_PK(g & 3), o[g >> 2]);
        else { const int k = g - NPV; if (k & 1) q1 = ATT_MFMA(kfr[k], qr[k >> 1], q1); else q0 = ATT_MFMA(kfr[k], qr[k >> 1], q0); }
        {
            const int e_lo = (32 * g) / NG, e_hi = (32 * (g + 1)) / NG;
#pragma unroll
            for (int e_ = 0; e_ < 32; ++e_) if (e_ >= e_lo && e_ < e_hi) ATT_EXP1(e_);
#pragma unroll
            for (int p_ = 0; p_ < 16; ++p_) if (2 * p_ + 1 < e_lo && 2 * p_ + 1 >= (g == 0 ? 0 : (32 * (g - 1)) / NG)) ATT_PACK1(p_);
        }
        if (DO_QK && NPV >= 8 && g >= CG0 && g < CG0 + 8) { ATT_CEL(4 * (g - CG0)); ATT_CEL(4 * (g - CG0) + 1); ATT_CEL(4 * (g - CG0) + 2); ATT_CEL(4 * (g - CG0) + 3); }
        __builtin_amdgcn_sched_barrier(0);
    }
    if (NG == 0) {
#pragma unroll
        for (int e_ = 0; e_ < 32; ++e_) ATT_EXP1(e_);
    }
#pragma unroll
    for (int p_ = 0; p_ < 16; ++p_) if (NG == 0 || 2 * p_ + 1 >= (32 * (NG - 1)) / NG) ATT_PACK1(p_);
    l_run += e0 + e1;
#undef ATT_VRD
#undef ATT_KRD
#undef ATT_PK
#undef ATT_EXP1
#undef ATT_PACK1
#undef ATT_CEL
}
template <int DV, class BM, bool PERWAVE = false>
__device__ __forceinline__ void flash_loop(lptr L, const bf16x8 (&qr)[4], const bf16_t* Kb, const bf16_t* Vb, int kp, int vp, int t_hi, int t_lo, const BM& bm,
                                           f32x16 (&o)[DV / 32], float& m_run, float& l_run) {
    int tid_ = threadIdx.x; asm volatile("" : "+v"(tid_));
    const int tid = tid_, lane = tid & 63, r32 = lane & 31, hi = lane >> 5;
    const int wid = __builtin_amdgcn_readfirstlane(tid >> 6);
    const unsigned lds0 = (unsigned)(uintptr_t)L;
    LAS float* wsf = (LAS float*)(L + L_WS) + wid * 64;
    const bf16_t* ksrc = Kb + (size_t)lane * kp + wid * 8;
    const bf16_t* vsrc = Vb + (size_t)(16 * (wid & 3) + (lane >> 2)) * vp + (wid >> 2) * 32 + (lane & 3) * 8;
    const unsigned kdst = lds0 + L_K + wid * 1024, vdst = lds0 + L_V + wid * 1024;
#define ATT_DMA(t, ks, vs) do { glds16(ksrc + (size_t)(t) * 64 * kp, (unsigned)__builtin_amdgcn_readfirstlane(kdst + (ks) * KSLOT)); \
        glds16(vsrc + (size_t)(t) * 64 * vp, (unsigned)__builtin_amdgcn_readfirstlane(vdst + (vs) * VSLOT)); \
        if (DV == 128) glds16(vsrc + (size_t)(t) * 64 * vp + 64, (unsigned)__builtin_amdgcn_readfirstlane(vdst + (vs) * VSLOT + 8192)); } while (0)
    const lcptr kp0 = (lcptr)L + L_K + hi * 1024 + r32 * 16;
    const lcptr vp0 = (lcptr)L + L_V + ((lane >> 4) & 1) * 32 + (lane & 3) * 8 + (4 * hi + ((lane & 15) >> 2)) * 64;
#define ATT_INC(x, N) ((x) + 1 == (N) ? 0 : (x) + 1)
#define ATT_WAIT_CNT() do { if (DV == 128) ATT_WAIT_BAR_N(ATT_CNT128); else ATT_WAIT_BAR_N(ATT_CNT64); } while (0)
#define ATT_DECIDE(t, q0, q1, pan) do { bm.mask(t, q0, q1); const float rm = rowmax(q0, q1); \
        if (__builtin_amdgcn_ballot_w64(rm > ATT_THR) != 0ull) { const float dl = fmaxf(rm, 0.f), f = __builtin_amdgcn_exp2f(-dl); \
            mref += dl; l_run *= f; \
            _Pragma("unroll") for (int r = 0; r < 16; ++r) { q0[r] -= dl; q1[r] -= dl; } \
            if (hi == 0) wsf[r32] = f; \
            _Pragma("unroll") for (int r = 0; r < 16; ++r) { const float fr_ = wsf[crow(r, hi)]; _Pragma("unroll") for (int d = 0; d < DV / 32; ++d) o[d][r] *= fr_; } \
            _Pragma("unroll") for (int w = 0; w < 4; ++w) _Pragma("unroll") for (int e = 0; e < 4; ++e) pan[w][e] = cvtpk(bf2f_lo(pan[w][e]) * f, bf2f_hi(pan[w][e]) * f); } } while (0)
    const int n = t_hi - t_lo + 1;
    float mref = 0.f;
    u32x4 PA[4] = {u32x4{}, u32x4{}, u32x4{}, u32x4{}}, PB[4] = {u32x4{}, u32x4{}, u32x4{}, u32x4{}};
    ATT_WAIT_BAR();
    int kd = 0, vd = 0;
#pragma unroll
    for (int j = 0; j <= PD; ++j) if (j < n) { ATT_DMA(t_hi - j, kd, vd); kd = ATT_INC(kd, NKS); vd = ATT_INC(vd, NVS); }
    if (n > PD) ATT_WAIT_CNT(); else ATT_WAIT_BAR();
    int jA = 0, jE = n;
    if constexpr (PERWAVE) { jA = n; jE = 0; for (int j = 0; j < n; ++j) if (bm.active(t_hi - j)) { if (j < jA) jA = j; jE = j + 1; } if (jE <= jA) { jA = 0; jE = 1; } }
    f32x16 A0, A1, B0, B1;
    int ks = 1, vs_prev = 0, vsn = 0, i = 0;
#define ATT_ADV() do { ks = ATT_INC(ks, NKS); vs_prev = vsn; vsn = ATT_INC(vsn, NVS); ++i; } while (0)
#define ATT_STEP_DMA() do { if (i + 1 + PD < n) { ATT_DMA(t_hi - i - 1 - PD, kd, vd); kd = ATT_INC(kd, NKS); vd = ATT_INC(vd, NVS); } } while (0)
#define ATT_STEP_END() do { if (i + 1 + PD < n) ATT_WAIT_CNT(); else ATT_WAIT_BAR(); ATT_ADV(); } while (0)
#define ATT_PROLOGUE_QK(tile_, kslot_) do { const float cb0 = bm.cbase(tile_, 0.f), csl = bm.cslope(), cb1 = cb0 + 32.f * csl; const lcptr kq_ = kp0 + (kslot_) * KSLOT; \
      _Pragma("unroll") for (int r = 0; r < 16; ++r) { const float cf = (float)((r & 3) + 8 * (r >> 2)); A0[r] = __builtin_fmaf(csl, cf, cb0); A1[r] = __builtin_fmaf(csl, cf, cb1); } \
      _Pragma("unroll") for (int d0 = 0; d0 < 4; ++d0) { const bf16x8 k0 = *(const LAS bf16x8*)(kq_ + d0 * 2048), k1 = *(const LAS bf16x8*)(kq_ + d0 * 2048 + 512); A0 = ATT_MFMA(k0, qr[d0], A0); A1 = ATT_MFMA(k1, qr[d0], A1); } \
      bm.mask(tile_, A0, A1); \
      const float rm = rowmax(A0, A1); mref = (rm == NEG_INF) ? 0.f : rm; \
      _Pragma("unroll") for (int r = 0; r < 16; ++r) { A0[r] -= mref; A1[r] -= mref; } } while (0)
    if (jA == 0) ATT_PROLOGUE_QK(t_hi, 0);
    else {
#pragma nounroll
        while (i + 1 < jA) { ATT_STEP_DMA(); ATT_STEP_END(); }
        ATT_STEP_DMA(); ATT_PROLOGUE_QK(t_hi - jA, ks); ATT_STEP_END();
    }
#define ATT_STEP(S0, S1, PS, Q0, Q1, PQ, DO_QK, DO_PV) do { const int tn = t_hi - i - 1; \
        ATT_STEP_DMA(); \
        att_block<DV, DO_QK, DO_PV>(bm, tn, mref, kp0 + ks * KSLOT, vp0 + vs_prev * VSLOT, qr, S0, S1, Q0, Q1, PS, PQ, o, l_run); \
        if (DO_QK) ATT_DECIDE(tn, Q0, Q1, PS); \
        ATT_STEP_END(); } while (0)
    float ldead = 0.f;
    bool last_in_A;
    if (jE - jA > 1) ATT_STEP(A0, A1, PA, B0, B1, PB, true, false); else ATT_STEP(A0, A1, PA, B0, B1, PB, false, false);
#pragma nounroll
    while (i + 2 < jE) { ATT_STEP(B0, B1, PB, A0, A1, PA, true, true); ATT_STEP(A0, A1, PA, B0, B1, PB, true, true); }
    if (i + 2 == jE) { ATT_STEP(B0, B1, PB, A0, A1, PA, true, true); ATT_STEP(A0, A1, PA, B0, B1, PB, false, true); last_in_A = true; }
    else if (i + 1 == jE) { ATT_STEP(B0, B1, PB, A0, A1, PA, false, true); last_in_A = false; }
    else last_in_A = true;
    if (jE < n) ATT_STEP_DMA();
    if (last_in_A) att_block<DV, false, true>(bm, 0, mref, kp0, vp0 + vs_prev * VSLOT, qr, B0, B1, B0, B1, PB, PA, o, ldead);
    else att_block<DV, false, true>(bm, 0, mref, kp0, vp0 + vs_prev * VSLOT, qr, A0, A1, A0, A1, PA, PB, o, ldead);
    if (jE < n) { ATT_STEP_END();
#pragma nounroll
        while (i < n) { ATT_STEP_DMA(); ATT_STEP_END(); } }
    ATT_WAIT_BAR();
    m_run = mref;
#undef ATT_STEP
#undef ATT_ADV
#undef ATT_STEP_DMA
#undef ATT_STEP_END
#undef ATT_PROLOGUE_QK
#undef ATT_DMA
#undef ATT_INC
#undef ATT_WAIT_CNT
#undef ATT_DECIDE
}

__device__ __forceinline__ float bf2f_(unsigned short u) { return __uint_as_float(((unsigned)u) << 16); }
__device__ __forceinline__ float silu_(float g) { return g * __builtin_amdgcn_rcpf(1.0f + __builtin_amdgcn_exp2f(-g * LOG2E)); }
template <int DV, bool GATED, class RowPtr>
__device__ __forceinline__ float finish_unit(lptr L, f32x16 (&o)[DV / 32], float m_run, float l_run, const RowPtr& rp) {
    int tid_ = threadIdx.x; asm volatile("" : "+v"(tid_));
    const int tid = tid_, lane = tid & 63, r32 = lane & 31, hi = lane >> 5;
    const int wid = __builtin_amdgcn_readfirstlane(tid >> 6);
    LAS float* wsf = (LAS float*)(L + L_WS) + wid * 64;
    const float l_tot = l_run + swap_half(l_run);
    if (hi == 0) wsf[32 + r32] = l_tot;
    LAS bf16_t* stg = (LAS bf16_t*)(L + L_OST + wid * 8192);
#pragma unroll
    for (int r = 0; r < 16; ++r) { const int orow = crow(r, hi); const float rl = __builtin_amdgcn_rcpf(wsf[32 + orow]);
#pragma unroll
        for (int d = 0; d < DV / 32; ++d) { const __hip_bfloat16 hv = __float2bfloat16(o[d][r] * rl); stg[orow * DV + d * 32 + r32] = __builtin_bit_cast(unsigned short, hv); } }
    constexpr int CPR = DV / 8;
#pragma unroll
    for (int it = 0; it < DV / 16; ++it) { const int idx = it * 64 + lane, row = idx / CPR, ch = idx % CPR;
        u32x4 v = *(const LAS u32x4*)((lcptr)stg + row * (DV * 2) + ch * 16);
        u32x4* gp = (u32x4*)(rp(row) + ch * 8);
        if (GATED) { const u32x4 g = *gp;
#pragma unroll
            for (int e = 0; e < 4; ++e) { const float o0 = bf2f_((unsigned short)(v[e] & 0xffffu)), o1 = bf2f_((unsigned short)(v[e] >> 16));
                const float g0 = bf2f_((unsigned short)(g[e] & 0xffffu)), g1 = bf2f_((unsigned short)(g[e] >> 16));
                v[e] = cvtpk(o0 * silu_(g0), o1 * silu_(g1)); } }
        *gp = v; }
    return m_run + __builtin_amdgcn_logf(l_tot);
}
__device__ __forceinline__ void load_q(bf16x8 (&qr)[4], const bf16_t* qrow, int hi) {
#pragma unroll
    for (int d0 = 0; d0 < 4; ++d0) qr[d0] = *(const bf16x8*)(qrow + d0 * 16 + hi * 8);
}
__device__ __forceinline__ float alibi2(int i, int n) { return exp2f(-8.0f * (float)(i + 1) / (float)n) * LOG2E; }
}
constexpr int RING_OFF = 0, RING_BYTES = 131072;
constexpr int ATT_BYTES = 144 * 1024;
constexpr int LDSCTL_OFF = ATT_BYTES, MISC_OFF = LDSCTL_OFF + 320;
constexpr int LDS_BYTES = 148480;
static_assert(att::L_END <= ATT_BYTES && RING_BYTES <= ATT_BYTES && MISC_OFF + 128 <= LDS_BYTES, "LDS map");
constexpr int NWAVES = 8;
constexpr int NPHASES = 2 + 4 * DEPTH;

#define GAS __attribute__((address_space(1)))
#define LAS __attribute__((address_space(3)))
typedef unsigned short bf16;
typedef unsigned v4u __attribute__((ext_vector_type(4)));
typedef float f32x4 __attribute__((ext_vector_type(4)));
typedef short bf16x8 __attribute__((ext_vector_type(8)));
typedef GAS unsigned gu32;
typedef GAS unsigned long long gu64;
#define RLX_AGENT __ATOMIC_RELAXED, __HIP_MEMORY_SCOPE_AGENT
#define LDS_WAIT() asm volatile("s_waitcnt lgkmcnt(0)" ::: "memory")
#define VM_WAIT() asm volatile("s_waitcnt vmcnt(0)" ::: "memory")
__device__ __forceinline__ unsigned long long rt() { return __builtin_amdgcn_s_memrealtime(); }
__device__ __forceinline__ unsigned f2bf(float f) { unsigned u = __builtin_bit_cast(unsigned, f); return (u + 0x7fffu + ((u >> 16) & 1u)) >> 16; }
__device__ __forceinline__ unsigned pk2(float lo, float hi) { return f2bf(lo) | (f2bf(hi) << 16); }
#define XB_TMO      128
#define XB_XCNT(j)  (256  + 64 * (j))
#define XB_XSUB(j)  (1280 + 64 * (j))
#define XB_XGEN(j)  (2304 + 64 * (j))
#define XB_TOP      3328
#define XB_TOPGEN   3392
#define XCD_BAR_WORDS 3456
#define XB_SPIN_CAP (1u << 18)

__device__ __forceinline__ unsigned xb_ld(unsigned* p)              { return __hip_atomic_load(p, __ATOMIC_RELAXED, __HIP_MEMORY_SCOPE_AGENT); }
__device__ __forceinline__ unsigned xb_add(unsigned* p, unsigned v) { return __hip_atomic_fetch_add(p, v, __ATOMIC_RELAXED, __HIP_MEMORY_SCOPE_AGENT); }
__device__ __forceinline__ unsigned xb_xcc_id() { return (unsigned)__builtin_amdgcn_s_getreg((3 << 11) | 20) & 0xFu; }
#define XB_SPIN(cond, bar) do { unsigned _sp = 0; while (cond) { __builtin_amdgcn_s_sleep(1); \
    if ((++_sp & 255u) == 0u) { if (xb_ld(&(bar)[XB_TMO])) break; if (_sp > XB_SPIN_CAP) { atomicAdd(&(bar)[XB_TMO], 1u); break; } } } } while (0)

struct XcdBarrier {
    unsigned* bar; unsigned x;
    volatile LAS unsigned* st;
};

__device__ __forceinline__ XcdBarrier xcd_barrier_post(unsigned* bar, volatile LAS unsigned* st) {
    XcdBarrier b; b.bar = bar; b.x = xb_xcc_id(); b.st = st;
    if (threadIdx.x == 0) (void)xb_add(&bar[XB_XCNT(b.x)], 1u);
    return b;
}
__device__ __forceinline__ void xcd_barrier_complete(unsigned* bar, unsigned x, unsigned& nloc, unsigned& nx) {
    const unsigned G = gridDim.x * gridDim.y * gridDim.z;
    unsigned sum, cnt, mine, sp = 0u;
    for (;;) {
        sum = 0u; cnt = 0u; mine = 0u;
#pragma unroll
        for (unsigned j = 0; j < 16; ++j) { const unsigned c = xb_ld(&bar[XB_XCNT(j)]); sum += c; cnt += (c > 0u) ? 1u : 0u; mine = (j == x) ? c : mine; }
        if (sum == G) break;
        __builtin_amdgcn_s_sleep(1);
        if ((++sp & 255u) == 0u) { if (xb_ld(&bar[XB_TMO])) break; if (sp > XB_SPIN_CAP) { atomicAdd(&bar[XB_TMO], 1u); break; } }
    }
    nloc = mine > 0u ? mine : 1u; nx = cnt > 0u ? cnt : 1u;
}

__device__ __forceinline__ void xcd_barrier(const XcdBarrier& b) {
    asm volatile("s_waitcnt vmcnt(0)" ::: "memory");
    __syncthreads();
    if (threadIdx.x == 0) {
        unsigned* bar = b.bar;
        __builtin_amdgcn_s_waitcnt(0);
        unsigned nloc = b.st[0], nx = b.st[1];
        if (nloc == 0u) { xcd_barrier_complete(bar, b.x, nloc, nx); b.st[0] = nloc; b.st[1] = nx; }
        const unsigned old = xb_add(&bar[XB_XSUB(b.x)], 1u);
        const unsigned gen = old / nloc;
        if (old + 1u == (gen + 1u) * nloc) {
            __builtin_amdgcn_fence(__ATOMIC_RELEASE, "agent");
            asm volatile("s_waitcnt vmcnt(0)" ::: "memory");
            const unsigned og = xb_add(&bar[XB_TOP], 1u);
            const unsigned tg = og / nx;
            if (og + 1u == (tg + 1u) * nx) xb_add(&bar[XB_TOPGEN], 1u);
            else XB_SPIN(xb_ld(&bar[XB_TOPGEN]) == tg, bar);
            __builtin_amdgcn_fence(__ATOMIC_ACQUIRE, "agent");
            xb_add(&bar[XB_XGEN(b.x)], 1u);
            asm volatile("s_waitcnt vmcnt(0)" ::: "memory");
        } else {
            XB_SPIN(xb_ld(&bar[XB_XGEN(b.x)]) == gen, bar);
            __builtin_amdgcn_fence(__ATOMIC_ACQUIRE, "agent");
            asm volatile("s_waitcnt vmcnt(0)" ::: "memory");
        }
    }
    __syncthreads();
}
struct Args { const float* in[13]; float* out; unsigned char* ws; int ph_lo, ph_hi, li, pad; };
struct Frame {
    LAS unsigned char* lds;
    int tid, lane, wave, vcu, G;
    unsigned char* ws;
};
#define IN_X(a) ((a).in[0])
#define IN_MEM(a) ((a).in[1])
#define IN_NORM_G(a) ((a).in[2])
#define IN_W_IN(a) ((a).in[3])
#define IN_W_OUT(a) ((a).in[4])
#define IN_MEM_NORM_G(a) ((a).in[5])
#define IN_W_MEM_KV(a) ((a).in[6])
#define IN_LQ1(a) ((a).in[7])
#define IN_LK1(a) ((a).in[8])
#define IN_LQ2(a) ((a).in[9])
#define IN_LK2(a) ((a).in[10])
#define IN_SUBLN_G(a) ((a).in[11])
#define IN_FINAL_G(a) ((a).in[12])
__device__ __forceinline__ float wave_sum(float v) {
#pragma unroll
    for (int o = 1; o < 64; o <<= 1) v += __shfl_xor(v, o);
    return v;
}
__device__ __forceinline__ void p0_transpose_item(const float* W, int K, int N, bf16* WT, int row_off, const float* gk, float cs, LAS float* scr, int item, int lane) {
    const int nblk = N / 32, kb = item / nblk, nb = item % nblk, k0 = 64 * kb, n0 = 32 * nb;
    const int kq = lane >> 3, n4 = (lane & 7) * 4;
#pragma unroll
    for (int i = 0; i < 8; ++i) { const int kk = 8 * i + kq; const float g = gk ? gk[k0 + kk] * cs : cs; const f32x4 w = *(const GAS f32x4*)(W + (size_t)(k0 + kk) * N + n0 + n4);
        LAS float* d = scr + kk * 33 + n4; d[0] = w.x * g; d[1] = w.y * g; d[2] = w.z * g; d[3] = w.w * g; }
    LDS_WAIT(); asm volatile("" ::: "memory");
    const int c = lane & 7;
#pragma unroll
    for (int j = 0; j < 4; ++j) { const int n = (lane >> 3) + 8 * j; const LAS float* s = scr + (8 * c) * 33 + n;
        v4u o; o.x = pk2(s[0 * 33], s[1 * 33]); o.y = pk2(s[2 * 33], s[3 * 33]); o.z = pk2(s[4 * 33], s[5 * 33]); o.w = pk2(s[6 * 33], s[7 * 33]);
        *(GAS v4u*)(WT + (size_t)(row_off + n0 + n) * K + k0 + 8 * c) = o; }
    LDS_WAIT(); asm volatile("" ::: "memory");
}
constexpr int I_IN = (DMODEL / 64) * (INW / 32), I_OUT = (DMODEL / 64) * (DMODEL / 32), I_MEM = (DMODEL / 64) * (512 / 32);
__device__ __forceinline__ void convert_item(Frame& F, const Args& A, int which, int l, int q, LAS float* scr) {
    if (which == 0) { const int nb = q % (INW / 32), n0 = nb * 32; const float cs = (n0 < MIXW || (n0 >= 3 * MIXW && n0 < 3 * MIXW + MEMW)) ? QSCALE : 1.0f;
        p0_transpose_item(IN_W_IN(A) + (size_t)l * DMODEL * INW, DMODEL, INW, (bf16*)(F.ws + WS_WIN) + (size_t)l * INW * DMODEL, 0, IN_NORM_G(A) + l * DMODEL, cs, scr, q, F.lane); }
    else if (which == 1) p0_transpose_item(IN_W_OUT(A) + (size_t)l * DMODEL * DMODEL, DMODEL, DMODEL, (bf16*)(F.ws + WS_WOUT) + (size_t)l * DMODEL * DMODEL, 0, nullptr, 1.0f, scr, q, F.lane);
    else p0_transpose_item(IN_W_MEM_KV(A) + (size_t)l * DMODEL * 512, DMODEL, 512, (bf16*)(F.ws + WS_WMEM), l * 512, IN_MEM_NORM_G(A) + l * DMODEL, 1.0f, scr, q, F.lane);
}
__device__ __forceinline__ void convert_deferred(Frame& F, const Args& A, int l, int worker, int nworkers) {
    LAS float* scr = (LAS float*)(F.lds + RING_OFF + F.wave * 16384);
    const int nitems = I_OUT + (l + 1 < DEPTH ? I_IN : 0);
    for (int it = worker; it < nitems; it += nworkers) { if (it < I_OUT) convert_item(F, A, 1, l, it, scr); else convert_item(F, A, 0, l + 1, it - I_OUT, scr); }
}
__device__ __forceinline__ void p0_prologue(Frame& F, const Args& A) {
    LAS float* scr = (LAS float*)(F.lds + RING_OFF + F.wave * 16384);
    const int gw = F.vcu * NWAVES + F.wave, NGW = F.G * NWAVES;
    constexpr int NITEMS = I_IN + DEPTH * I_MEM;
    for (int it = gw; it < NITEMS; it += NGW) { if (it < I_IN) convert_item(F, A, 0, 0, it, scr); else convert_item(F, A, 2, (it - I_IN) / I_MEM, (it - I_IN) % I_MEM, scr); }
    bf16* xb = (bf16*)(F.ws + WS_XB); float* ssq = (float*)(F.ws + WS_SSQ);
    for (int m = gw; m < MROWS; m += NGW) {
        const GAS f32x4* xr = (const GAS f32x4*)(IN_X(A) + (size_t)m * DMODEL) + F.lane;
        GAS unsigned long long* o8 = (GAS unsigned long long*)(xb + (size_t)m * DMODEL) + F.lane;
        float s = 0.f;
#pragma unroll
        for (int j = 0; j < 4; ++j) { const f32x4 v = xr[64 * j]; s += (v.x * v.x + v.y * v.y) + (v.z * v.z + v.w * v.w);
            o8[64 * j] = (unsigned long long)pk2(v.x, v.y) | ((unsigned long long)pk2(v.z, v.w) << 32); }
        s = wave_sum(s);
        if (F.lane < 16) ssq[(size_t)m * 16 + F.lane] = (F.lane == 0) ? s : 0.f;
    }
    bf16* memn = (bf16*)(F.ws + WS_MEMN);
    for (int m = gw; m < BATCH * NMEM; m += NGW) {
        const GAS f32x4* xr = (const GAS f32x4*)(IN_MEM(A) + (size_t)m * DMODEL) + F.lane;
        GAS unsigned long long* o8 = (GAS unsigned long long*)(memn + (size_t)m * DMODEL) + F.lane;
        f32x4 v[4]; float s = 0.f;
#pragma unroll
        for (int j = 0; j < 4; ++j) { v[j] = xr[64 * j]; s += (v[j].x * v[j].x + v[j].y * v[j].y) + (v[j].z * v[j].z + v[j].w * v[j].w); }
        const float rstd = 1.0f / sqrtf(wave_sum(s) * (1.0f / DMODEL) + RMS_EPS);
#pragma unroll
        for (int j = 0; j < 4; ++j) o8[64 * j] = (unsigned long long)pk2(v[j].x * rstd, v[j].y * rstd) | ((unsigned long long)pk2(v[j].z * rstd, v[j].w * rstd) << 32);
    }
    if (gw == 1) { float* nz = (float*)(F.ws + WS_NRM); for (int i = F.lane; i < DEPTH * 96; i += 64) nz[i] = 0.f; }
    if (gw == 0) {
        const float a = wave_sum(IN_LQ1(A)[F.lane] * IN_LK1(A)[F.lane]), b = wave_sum(IN_LQ2(A)[F.lane] * IN_LK2(A)[F.lane]);
        const float lam_init = 0.8f - 0.6f * expf(-0.3f * 2.0f);
        if (F.lane == 0) ((float*)(F.ws + WS_MISC))[0] = expf(a) - expf(b) + lam_init;
    }
}
__device__ __forceinline__ float diff_lambda_init() { return 0.8f - 0.6f * expf(-0.3f * 2.0f); }

__device__ __forceinline__ void unit_mem(Frame& F, int layer, int un) {
    using namespace att;
    const int hm = un & 3, rb = un >> 2;
    const int r32 = F.lane & 31, hi = F.lane >> 5;
    const int row0 = rb * 256 + F.wave * 32, b = rb >> 5;
    const bf16_t* qm = (const bf16_t*)(F.ws + WS_QM);
    const bf16_t* kv = (const bf16_t*)(F.ws + WS_MEMKV) + (size_t)(b * NMEM) * 2048 + layer * 512 + hm * 64;
    bf16x8 qr[4]; load_q(qr, qm + (size_t)(row0 + r32) * MEMW + hm * 64, hi);
    f32x16 o[2]; o[0] = f32x16{}; o[1] = f32x16{}; float m_run = NEG_INF, l_run = 0.f;
    BMNone bm;
    flash_loop<64>((lptr)(F.lds + RING_OFF), qr, kv, kv + 256, 2048, 2048, 3, 0, bm, o, m_run, l_run);
    bf16_t* yg = (bf16_t*)(F.ws + WS_GATE) + (size_t)row0 * DMODEL + MIXW + hm * 64;
    finish_unit<64, true>((lptr)(F.lds + RING_OFF), o, m_run, l_run, [=](int i) { return yg + (size_t)i * DMODEL; });
}
__device__ __forceinline__ void unit_dsw(Frame& F, int un) {
    using namespace att;
    const int x = un & 31, hh = (un >> 5) % 12, b = un / 384;
    const int g = hh >> 2, sh = 2 * g, dil = 1 << sh, U = SEQ >> sh, nb = U >> 8;
    const int res = x / nb, ub = x % nb;
    const int r32 = F.lane & 31, hi = F.lane >> 5;
    const size_t seq0 = (size_t)b * SEQ + (size_t)res * U;
    const int qlo = ub * 256 + F.wave * 32, qpos = qlo + r32;
    const bf16_t* Q = (const bf16_t*)(F.ws + WS_Q) + seq0 * MIXW + hh * 64;
    const bf16_t* K = (const bf16_t*)(F.ws + WS_K) + seq0 * MIXW + hh * 64;
    const bf16_t* V = (const bf16_t*)(F.ws + WS_V) + seq0 * MIXW + hh * 64;
    bf16x8 qr[4]; load_q(qr, Q + (size_t)qpos * MIXW, hi);
    f32x16 o[2]; o[0] = f32x16{}; o[1] = f32x16{}; float m_run = NEG_INF, l_run = 0.f;
    BMBand bm; bm.init(qpos, qlo, 128, alibi2(hh, 12) * (float)dil, hi);
    const int t_hi = ub * 4 + 3, t_lo = (ub * 4 - 2) > 0 ? (ub * 4 - 2) : 0;
    flash_loop<64, att::BMBand, true>((lptr)(F.lds + RING_OFF), qr, K, V, MIXW, MIXW, t_hi, t_lo, bm, o, m_run, l_run);
    bf16_t* mix = (bf16_t*)(F.ws + WS_MIX) + ((size_t)b * SEQ) * MIXW + hh * 64;
    const float l2 = finish_unit<64, false>((lptr)(F.lds + RING_OFF), o, m_run, l_run, [=](int i) { return mix + (size_t)(((qlo + i) << sh) + res) * MIXW; });
    if (hi == 0) ((float*)(F.ws + WS_LSE))[((size_t)b * SEQ + ((size_t)qpos << sh) + res) * 12 + hh] = l2;
}
__device__ __forceinline__ int skip_first_tile(Frame& F, int layer, int b, int stream, float slope2, int q_first) {
    const float* nr = (const float*)(F.ws + WS_NRM) + layer * 96 + b * 48 + 2 * stream;
    const float qn2 = nr[0] + nr[1], kn2 = nr[24] + nr[25];
    const float S = sqrtf(qn2 * kn2) * 1.02f + 0.5f;
    const float dskip = (160.0f + 2.0f * S) / slope2 + 1.0f;
    const float kminf = (float)q_first - dskip;
    return kminf <= 0.f ? 0 : (((int)kminf) >> 6);
}
__device__ __forceinline__ void unit_moba(Frame& F, int layer, int b, int h, int qb) {
    using namespace att;
    const int r32 = F.lane & 31, hi = F.lane >> 5;
    const lptr L = (lptr)(F.lds + RING_OFF);
    const size_t seq0 = (size_t)b * SEQ;
    const int qlo = qb * 256 + F.wave * 32, qpos = qlo + r32;
    const bf16_t* Q = (const bf16_t*)(F.ws + WS_Q) + seq0 * MIXW + h * 64;
    const bf16_t* K = (const bf16_t*)(F.ws + WS_K) + seq0 * MIXW + h * 64;
    const bf16_t* V = (const bf16_t*)(F.ws + WS_V) + seq0 * MIXW + h * 64;
    bf16x8 qr[4]; load_q(qr, Q + (size_t)qpos * MIXW, hi);
    unsigned sel = (qb >= 3) ? 7u : ((1u << qb) - 1u);
    if (qb > 3) {
        { const int j = F.tid >> 4, d4 = (F.tid & 15) * 4; const float* kp_ = (const float*)(F.ws + WS_KPART) + (size_t)((b * 32 + j) * 2) * MIXW + h * 64 + d4;
          const f32x4 a = *(const f32x4*)kp_, c = *(const f32x4*)(kp_ + MIXW);
          *(LAS f32x4*)(L + L_KM + (j * 64 + d4) * 4) = (a + c) * (1.0f / 256.0f); }
        asm volatile("s_waitcnt lgkmcnt(0)\n\ts_barrier" ::: "memory");
        float qf[32];
#pragma unroll
        for (int d0 = 0; d0 < 4; ++d0)
#pragma unroll
            for (int e = 0; e < 8; ++e) qf[d0 * 8 + e] = __uint_as_float(((unsigned)(unsigned short)qr[d0][e]) << 16);
        float v1 = NEG_INF, v2 = NEG_INF, v3 = NEG_INF; int i1 = 0, i2 = 0, i3 = 0;
        for (int j = 0; j < qb; ++j) {
            const LAS f32x4* km = (const LAS f32x4*)(L + L_KM + (j * 64 + 8 * hi) * 4);
            float gsum = 0.f;
#pragma unroll
            for (int d0 = 0; d0 < 4; ++d0) { const f32x4 k0 = km[d0 * 4], k1 = km[d0 * 4 + 1];
                gsum += qf[d0 * 8 + 0] * k0[0] + qf[d0 * 8 + 1] * k0[1] + qf[d0 * 8 + 2] * k0[2] + qf[d0 * 8 + 3] * k0[3] + qf[d0 * 8 + 4] * k1[0] + qf[d0 * 8 + 5] * k1[1] + qf[d0 * 8 + 6] * k1[2] + qf[d0 * 8 + 7] * k1[3]; }
            const float gt = gsum + swap_half(gsum);
            if (gt > v1) { v3 = v2; i3 = i2; v2 = v1; i2 = i1; v1 = gt; i1 = j; }
            else if (gt > v2) { v3 = v2; i3 = i2; v2 = gt; i2 = j; }
            else if (gt > v3) { v3 = gt; i3 = j; }
        }
        sel = (1u << i1) | (1u << i2) | (1u << i3);
    }
    f32x16 o[2]; o[0] = f32x16{}; o[1] = f32x16{}; float m_run = NEG_INF, l_run = 0.f;
    BMMoba bm; bm.band.init(qpos, qlo, 1 << 20, alibi2(h, 12), hi); bm.sel = sel; bm.qb = qb;
    flash_loop<64>(L, qr, K, V, MIXW, MIXW, qb * 4 + 3, skip_first_tile(F, layer, b, h, alibi2(h, 12), qb * 256), bm, o, m_run, l_run);
    bf16_t* yg = (bf16_t*)(F.ws + WS_GATE) + (seq0 + qlo) * DMODEL + h * 64;
    finish_unit<64, true>(L, o, m_run, l_run, [=](int i) { return yg + (size_t)i * DMODEL; });
}
__device__ __forceinline__ void unit_diff(Frame& F, int layer, int b, int h, int mp, int qb) {
    using namespace att;
    const int r32 = F.lane & 31, hi = F.lane >> 5;
    const lptr L = (lptr)(F.lds + RING_OFF);
    const size_t seq0 = (size_t)b * SEQ;
    const int qlo = qb * 256 + F.wave * 32, qpos = qlo + r32;
    const bf16_t* Q = (const bf16_t*)(F.ws + WS_Q) + seq0 * MIXW + (h * 2 + mp) * 64;
    const bf16_t* K = (const bf16_t*)(F.ws + WS_K) + seq0 * MIXW + (h * 2 + mp) * 64;
    const bf16_t* V = (const bf16_t*)(F.ws + WS_V) + seq0 * MIXW + h * 128;
    bf16x8 qr[4]; load_q(qr, Q + (size_t)qpos * MIXW, hi);
    f32x16 o[4]; o[0] = f32x16{}; o[1] = f32x16{}; o[2] = f32x16{}; o[3] = f32x16{}; float m_run = NEG_INF, l_run = 0.f;
    BMBand bm; bm.init(qpos, qlo, 1 << 20, alibi2(h, 6), hi);
#if PROBE_OUT
    const int tl_ = skip_first_tile(F, layer, b, h * 2 + mp, alibi2(h, 6), qb * 256);
    const unsigned long long c0_ = __builtin_amdgcn_s_memtime(), r0_ = __builtin_amdgcn_s_memrealtime();
    flash_loop<128>(L, qr, K, V, MIXW, MIXW, qb * 4 + 3, tl_, bm, o, m_run, l_run);
    const unsigned long long c1_ = __builtin_amdgcn_s_memtime(), r1_ = __builtin_amdgcn_s_memrealtime();
    if (b == 0 && h == 5 && mp == 0 && qb == 31 && F.tid == 0) {
        const float steps = (float)(qb * 4 + 3 - tl_ + 2);
        float* pm = (float*)(F.ws + WS_MISC);
        pm[4] = (float)(c1_ - c0_) / steps;
        pm[5] = (float)(c1_ - c0_) / (float)(r1_ - r0_) * 0.1f;
        pm[6] = steps;
    }
#else
    flash_loop<128>(L, qr, K, V, MIXW, MIXW, qb * 4 + 3, skip_first_tile(F, layer, b, h * 2 + mp, alibi2(h, 6), qb * 256), bm, o, m_run, l_run);
#endif
    bf16_t* od = (bf16_t*)(F.ws + WS_MIX) + (seq0 + qlo) * 1536 + (h * 2 + mp) * 128;
    finish_unit<128, false>(L, o, m_run, l_run, [=](int i) { return od + (size_t)i * 1536; });
}
__device__ __forceinline__ void phase_attn(Frame& F, int layer, int rep) {
    const int kind = layer % 3, G = F.G, v = F.vcu;
    if (kind == 0) {
#ifndef DIS_DSW
        for (int un = v; un < 768 + 256; un += G) { if (un < 768) unit_dsw(F, un); else unit_mem(F, layer, un - 768); }
#endif
    } else {
        volatile LAS unsigned* MISC = (volatile LAS unsigned*)(F.lds + MISC_OFF);
        const int x0 = (int)(xb_xcc_id() & 7u);
        gu32* ctr0 = (gu32*)(F.ws + WS_CTL) + CW_QUEUE + 64 * (layer * 8 + 32 * rep);
        int qi = 0;
        for (int it = 0;; ++it) {
            if (F.tid == 0) {
                unsigned code = 0xffffffffu; int q = qi;
                for (; q < 8; ++q) { const int x = (x0 + q) & 7; const unsigned idx = __hip_atomic_fetch_add(ctr0 + 64 * x, 1u, __ATOMIC_RELAXED, __HIP_MEMORY_SCOPE_AGENT); if (idx < 96u + 32u) { code = ((unsigned)q << 8) | idx; break; } }
                MISC[12 + (it & 1)] = code;
            }
            asm volatile("s_waitcnt vmcnt(0) lgkmcnt(0)\n\ts_barrier" ::: "memory");
            const unsigned code = MISC[12 + (it & 1)];
            if (code == 0xffffffffu) break;
            qi = (int)(code >> 8); const int idx = (int)(code & 0xffu), x = (x0 + qi) & 7, b = x >> 2, j = x & 3;
            if (idx < 96) { const int sl = idx >> 5, qb = 31 - (idx & 31);
#ifndef DIS_MOBA
                if (kind == 1) { const int h = sl == 0 ? 8 + j : (sl == 1 ? 7 - j : j); unit_moba(F, layer, b, h, qb); }
                else
#endif
#ifndef DIS_DIFF
                { const int h = sl == 0 ? 4 + (j >> 1) : (sl == 1 ? 3 - (j >> 1) : (j >> 1)), mp = j & 1; unit_diff(F, layer, b, h, mp, qb); }
#else
                {}
#endif
            }
#ifndef DIS_MEM
            else unit_mem(F, layer, x * 32 + (idx - 96));
#endif
        }
    }
}
__device__ __forceinline__ float bf2f(unsigned short u) { return __uint_as_float(((unsigned)u) << 16); }
__device__ __forceinline__ void phase_finalize(Frame& F, const Args& A, int layer) {
    typedef unsigned short us8 __attribute__((ext_vector_type(8)));
    const int kind = layer % 3, gw = F.vcu * NWAVES + F.wave, NGW = F.G * NWAVES, lane = F.lane;
    bf16* gate = (bf16*)(F.ws + WS_GATE);
    const bf16* mix = (const bf16*)(F.ws + WS_MIX);
    const float* lse = (const float*)(F.ws + WS_LSE);
    const float lam = ((const float*)(F.ws + WS_MISC))[0], lam_scale = 1.0f - diff_lambda_init();
    for (int m = gw; m < MROWS; m += NGW) {
        float v[16];
        if (lane < 48) {
            if (kind == 2) {
                const int h = lane >> 3, dd = (lane & 7) * 16;
                const us8* p1 = (const us8*)(mix + (size_t)m * 1536 + h * 256 + dd); const us8* p2 = (const us8*)(mix + (size_t)m * 1536 + h * 256 + 128 + dd);
                const us8 a0 = p1[0], a1 = p1[1], b0 = p2[0], b1 = p2[1];
#pragma unroll
                for (int e = 0; e < 8; ++e) { v[e] = bf2f(a0[e]) - lam * bf2f(b0[e]); v[8 + e] = bf2f(a1[e]) - lam * bf2f(b1[e]); }
            } else {
                const us8* p1 = (const us8*)(mix + (size_t)m * MIXW + lane * 16); const us8 a0 = p1[0], a1 = p1[1];
#pragma unroll
                for (int e = 0; e < 8; ++e) { v[e] = bf2f(a0[e]); v[8 + e] = bf2f(a1[e]); }
            }
        } else {
#pragma unroll
            for (int e = 0; e < 16; ++e) v[e] = 0.f;
        }
        float sc = 1.0f;
        if (kind == 2) {
            float ss = 0.f;
#pragma unroll
            for (int e = 0; e < 16; ++e) ss += v[e] * v[e];
            ss += __shfl_xor(ss, 1); ss += __shfl_xor(ss, 2); ss += __shfl_xor(ss, 4);
            sc = lam_scale / sqrtf(ss * (1.0f / 128.0f) + SUBLN_EPS);
            if (lane < 48) { const float* sg = IN_SUBLN_G(A) + (lane & 7) * 16;
#pragma unroll
                for (int e = 0; e < 16; ++e) v[e] *= sg[e]; }
            else sc = 1.0f;
        } else if (kind == 0 && lane < 48) {
            const int hh = lane >> 2, j = hh & 3, g = hh >> 2;
            const float* lr = lse + (size_t)m * 12;
            const float l0 = lr[j], l1 = lr[4 + j], l2 = lr[8 + j], mx = fmaxf(fmaxf(l0, l1), l2);
            const float e0 = exp2f(l0 - mx), e1 = exp2f(l1 - mx), e2 = exp2f(l2 - mx);
            sc = (g == 0 ? e0 : (g == 1 ? e1 : e2)) / (e0 + e1 + e2);
        }
        if (lane >= 48) continue;
        us8* gp = (us8*)(gate + (size_t)m * DMODEL + lane * 16);
        const us8 g0 = gp[0], g1 = gp[1]; us8 y0, y1;
#pragma unroll
        for (int e = 0; e < 8; ++e) {
            const float ga = bf2f(g0[e]), gb = bf2f(g1[e]);
            const float sa = ga / (1.0f + exp2f(-ga * LOG2E)), sb = gb / (1.0f + exp2f(-gb * LOG2E));
            y0[e] = (unsigned short)f2bf(v[e] * sc * sa); y1[e] = (unsigned short)f2bf(v[8 + e] * sc * sb);
        }
        gp[0] = y0; gp[1] = y1;
    }
}
__device__ __forceinline__ void phase_final_norm(Frame& F, const Args& A) {
    const int gw = F.vcu * NWAVES + F.wave, NGW = F.G * NWAVES;
    const float* ssq = (const float*)(F.ws + WS_SSQ);
    for (int m = gw; m < MROWS; m += NGW) {
        GAS f32x4* xr = (GAS f32x4*)(A.out + (size_t)m * DMODEL) + F.lane;
        const float p = (F.lane < 16) ? ssq[(size_t)m * 16 + F.lane] : 0.f;
        const float rstd = 1.0f / sqrtf(wave_sum(p) * (1.0f / DMODEL) + RMS_EPS);
#pragma unroll
        for (int j = 0; j < 4; ++j) { const f32x4 g = *((const f32x4*)IN_FINAL_G(A) + F.lane + 64 * j); f32x4 v = xr[64 * j]; v = v * rstd * g; xr[64 * j] = v; }
#if PROBE_OUT
        if (m == 0 && F.lane == 0) { const float* pm = (const float*)(F.ws + WS_MISC); float pv = PROBE_OUT == 300 ? 8.f + floorf((float)(__builtin_amdgcn_s_memrealtime() - ((const unsigned long long*)(F.ws + WS_MISC + 1024))[0]) * 0.01f * 0.05f) - 60.f : PROBE_OUT >= 200 ? 8.f + floorf((float)(((const unsigned long long*)(F.ws + WS_MISC + 1024))[PROBE_OUT - 200] - ((const unsigned long long*)(F.ws + WS_MISC + 1024))[0]) * 0.01f * 0.02f) : PROBE_OUT >= 100 ? 8.f + floorf((float)(((const unsigned long long*)(F.ws + WS_MISC + 1024))[PROBE_OUT - 100 + 1] - ((const unsigned long long*)(F.ws + WS_MISC + 1024))[PROBE_OUT - 100]) * 0.01f * 0.2f) : PROBE_OUT >= 10 ? 8.f + floorf(pm[16 + PROBE_OUT - 10] * 0.1f) : PROBE_OUT == 1 ? 8.f + floorf(pm[4] * (1.0f / 200.0f)) : (PROBE_OUT == 2 ? floorf(pm[5] * 10.f) : pm[6] * 0.25f); A.out[0] = fminf(pv, 45.f); }
#endif
    }
}

__global__ void __launch_bounds__(NWAVES * 64, 2) trunk_fwd(Args args) {
    extern __shared__ __attribute__((aligned(16))) unsigned char lds[];
    Frame F;
    F.lds = (LAS unsigned char*)lds;
    volatile LAS unsigned* MISC = (volatile LAS unsigned*)(F.lds + MISC_OFF);
    F.tid = threadIdx.x; F.lane = F.tid & 63; F.wave = __builtin_amdgcn_readfirstlane(F.tid >> 6);
    F.G = gridDim.x; { const int bx = blockIdx.x; F.vcu = (F.G % 8 == 0) ? (bx % 8) * (F.G / 8) + bx / 8 : bx; }
    F.ws = args.ws;
    gu32* ctl = (gu32*)(F.ws + WS_CTL);
    for (int u = F.tid; u < (LDS_BYTES - LDSCTL_OFF) / 4; u += NWAVES * 64) ((LAS unsigned*)(F.lds + LDSCTL_OFF))[u] = 0u;
    __syncthreads();
    XcdBarrier bar; bar.bar = (unsigned*)(ctl + CW_BAR); bar.x = 0; bar.st = nullptr;
    if (!MK_PER_PHASE) bar = xcd_barrier_post((unsigned*)(ctl + CW_BAR), MISC + 8);
    const int lo = args.ph_lo, hi = args.ph_hi;
#define IN(k) (lo <= (k) && (k) < hi)
#if PROBE_OUT >= 100
#define PSTAMP_PH(k) do { if (blockIdx.x == 0 && threadIdx.x == 0) ((unsigned long long*)(F.ws + WS_MISC + 1024))[(k)] = __builtin_amdgcn_s_memrealtime(); } while (0)
#else
#define PSTAMP_PH(k) do {} while (0)
#endif
#define SEAM(k) do { if (IN(k) && IN((k) + 1)) xcd_barrier(bar); PSTAMP_PH((k) + 1); } while (0)

        PSTAMP_PH(0);
#ifndef DIS_P0
    if (IN(0)) { p0_prologue(F, args);
#if PROBE_DUP & 4
        __syncthreads(); p0_prologue(F, args);
#endif
    }
#endif
    SEAM(0);
#define FRESH_TID() do { int t_ = threadIdx.x; asm volatile("" : "+v"(t_)); F.tid = t_; F.lane = t_ & 63; F.wave = __builtin_amdgcn_readfirstlane(t_ >> 6); } while (0)
    for (int layer = 0; layer < DEPTH; ++layer) {
        const int pb = 1 + 4 * layer, kind = layer % 3;
#ifndef DIS_GIN
        if (IN(pb)) for (int rep_ = 0; rep_ < (((PROBE_DUP & 1) && ((PROBE_LAYERS >> layer) & 1)) ? 2 : 1); ++rep_) {
#ifndef DIS_INP
            { pg8::Gemm g{(const pg8::bf16_t*)(F.ws + WS_XB), (const pg8::bf16_t*)(F.ws + WS_WIN) + (size_t)layer * INW * DMODEL, MROWS, INW, DMODEL};
              pg8::StaticOrder S; S.init(MROWS, INW, F.G, (int)blockIdx.x);
              pg8::EpiIn E{F.ws, kind, layer};
              pg8::gemm_phase<pg8::EpiIn, pg8::StaticOrder, true, true>(F.lds + RING_OFF, g, S, E); }
#endif
#ifndef DIS_MEMKV
            if (layer == 0) {
              pg8::Gemm g{(const pg8::bf16_t*)(F.ws + WS_MEMN), (const pg8::bf16_t*)(F.ws + WS_WMEM), BATCH * NMEM, DEPTH * 512, DMODEL};
              pg8::TailOrder S{2, 8, F.G, (int)blockIdx.x};
              pg8::EpiPlain E{(pg8::bf16_t*)(F.ws + WS_MEMKV), DEPTH * 512};
              pg8::gemm_phase<pg8::EpiPlain, pg8::TailOrder, true, true>(F.lds + RING_OFF, g, S, E); }
#endif
            if (rep_ == 0) {
                FRESH_TID();
                const int c = (int)blockIdx.x;
                if (F.G == 256) { const int hi_c = (layer == 0) ? 240 : 256; if (c >= 128 && c < hi_c) convert_deferred(F, args, layer, (c - 128) * NWAVES + F.wave, (hi_c - 128) * NWAVES); }
                else convert_deferred(F, args, layer, c * NWAVES + F.wave, F.G * NWAVES);
            }
        }
#endif
        SEAM(pb);
#ifndef DIS_ATT
        if (IN(pb + 1)) for (int rep_ = 0; rep_ < (((PROBE_DUP & 2) && ((PROBE_LAYERS >> layer) & 1)) ? 2 : 1); ++rep_) { FRESH_TID();
#if PROBE_OUT >= 10
            const unsigned long long r0_ = __builtin_amdgcn_s_memrealtime();
#endif
            phase_attn(F, layer, rep_);
#if PROBE_OUT >= 10
            if (blockIdx.x == 0 && F.tid == 0) ((float*)(F.ws + WS_MISC))[16 + layer] = (float)(__builtin_amdgcn_s_memrealtime() - r0_) * 0.01f;
#endif
        }
#endif
        SEAM(pb + 1);
#ifndef DIS_FIN
        if (IN(pb + 2) && kind != 1) { FRESH_TID(); phase_finalize(F, args, layer); }
#endif
        if (kind != 1) SEAM(pb + 2);
#ifndef DIS_GOUT
        if (IN(pb + 3)) for (int rep_ = 0; rep_ < (((PROBE_DUP & 8) && layer == 0) ? 2 : 1); ++rep_) {
            pg8::Gemm g{(const pg8::bf16_t*)(F.ws + WS_GATE), (const pg8::bf16_t*)(F.ws + WS_WOUT) + (size_t)layer * DMODEL * DMODEL, MROWS, DMODEL, DMODEL};
            pg8::StaticOrder S; S.init(MROWS, DMODEL, F.G, (int)blockIdx.x);
            pg8::EpiOut E{layer == 0 ? IN_X(args) : args.out, args.out, (pg8::bf16_t*)(F.ws + WS_XB), (float*)(F.ws + WS_SSQ), layer + 1 < DEPTH ? 1 : 0};
            pg8::gemm_phase<pg8::EpiOut, pg8::StaticOrder, true, true>(F.lds + RING_OFF, g, S, E);
        }
#endif
        SEAM(pb + 3);
    }
    if (IN(NPHASES - 1)) { FRESH_TID(); phase_final_norm(F, args); }
#undef IN
#undef SEAM
}

extern "C" void kernel_launch(void* const* d_in, const int* in_sizes, int n_in, void* d_out, int out_size, void* d_ws, size_t ws_size, hipStream_t stream) {
    static int grid = 0;
    if (grid == 0) {
        if (n_in != 13 || out_size != MROWS * DMODEL || ws_size < WS_END) { fprintf(stderr, "kernel_launch: unexpected problem shape (n_in %d, out %d, ws %zu); nothing launched\n", n_in, out_size, ws_size); grid = -1; return; }
        int dev = 0, cus = 0, per_cu = 0;
        if (hipGetDevice(&dev) != hipSuccess || hipDeviceGetAttribute(&cus, hipDeviceAttributeMultiprocessorCount, dev) != hipSuccess) { grid = -1; return; }
        if (hipFuncSetAttribute((const void*)trunk_fwd, hipFuncAttributeMaxDynamicSharedMemorySize, LDS_BYTES) != hipSuccess) { fprintf(stderr, "kernel_launch: hipFuncSetAttribute failed\n"); grid = -1; return; }
        if (hipOccupancyMaxActiveBlocksPerMultiprocessor(&per_cu, (const void*)trunk_fwd, NWAVES * 64, LDS_BYTES) != hipSuccess || per_cu < 1) { fprintf(stderr, "kernel_launch: occupancy query says %d workgroups per CU\n", per_cu); per_cu = 1; }
        (void)hipGetLastError();
        grid = cus;
    }
    if (grid < 0) return;
    if (hipMemsetAsync((char*)d_ws + WS_CTL, 0, CTL_USED_BYTES, stream) != hipSuccess) { fprintf(stderr, "kernel_launch: hipMemsetAsync failed\n"); return; }
    Args a{};
    for (int i = 0; i < 13; ++i) a.in[i] = (const float*)d_in[i];
    a.out = (float*)d_out; a.ws = (unsigned char*)d_ws;
#if MK_PER_PHASE
    for (int p = 0; p < NPHASES; ++p) { a.ph_lo = p; a.ph_hi = p + 1; a.li = p; hipLaunchKernelGGL(trunk_fwd, dim3(grid), dim3(NWAVES * 64), LDS_BYTES, stream, a); }
#else
    a.ph_lo = 0; a.ph_hi = NPHASES; a.li = 0;
    hipLaunchKernelGGL(trunk_fwd, dim3(grid), dim3(NWAVES * 64), LDS_BYTES, stream, a);
#endif
    const hipError_t le = hipPeekAtLastError();
    if (le != hipSuccess) fprintf(stderr, "kernel_launch: launch failed: %s\n", hipGetErrorName(le));
}
```

```cpp
#include <hip/hip_runtime.h>
#include <hip/hip_bf16.h>
#include <cstdio>
#include <cstdint>
#include <cmath>

#ifndef MK_PER_PHASE
#define MK_PER_PHASE 0
#endif

#ifndef PROBE_WORK
#define PROBE_WORK 0
#endif
#ifndef PROBE_OUT
#define PROBE_OUT 0
#endif
#ifndef PROBE_LAYERS
#define PROBE_LAYERS 15
#endif
#ifndef PROBE_DUP
#define PROBE_DUP 0
#endif
constexpr int BATCH = 2, SEQ = 8192, DMODEL = 1024, DEPTH = 4, MROWS = BATCH * SEQ;
constexpr int MIXW = 768, MEMW = 256, NMEM = 256, INW = 3584;
constexpr float RMS_EPS = 1e-6f, SUBLN_EPS = 1e-5f;
constexpr float LOG2E = 1.4426950408889634f;
constexpr float QSCALE = 0.125f * LOG2E;
constexpr size_t MiB = 1u << 20;
constexpr size_t WS_CTL = 0, CTL_ZERO_BYTES = 1 * MiB;
constexpr size_t WS_WIN = 1 * MiB;
constexpr size_t WS_WOUT = 29 * MiB;
constexpr size_t WS_WMEM = 37 * MiB;
constexpr size_t WS_XB = 41 * MiB;
constexpr size_t WS_Q = 73 * MiB, WS_K = 97 * MiB, WS_V = 121 * MiB;
constexpr size_t WS_QM = 145 * MiB;
constexpr size_t WS_GATE = 153 * MiB;
constexpr size_t WS_MIX = 185 * MiB;
constexpr size_t WS_MO = 233 * MiB;
constexpr size_t WS_MEMN = 241 * MiB;
constexpr size_t WS_MEMKV = 242 * MiB;
constexpr size_t WS_LSE = 244 * MiB;
constexpr size_t WS_SSQ = 245 * MiB;
constexpr size_t WS_KPART = 246 * MiB;
constexpr size_t WS_MISC = 247 * MiB;
constexpr size_t WS_NRM = 247 * MiB + 4096;
constexpr size_t WS_END = 248 * MiB;
constexpr size_t CTL_USED_BYTES = 64 * 1024;
constexpr int CW_QUEUE = 8192;
constexpr int CW_BAR = 4096;
namespace pg8 {
#define PG8_LAS __attribute__((address_space(3)))
typedef unsigned short bf16_t;
typedef short bf16x8 __attribute__((ext_vector_type(8)));
typedef float f32x4 __attribute__((ext_vector_type(4)));
typedef unsigned u32x4 __attribute__((ext_vector_type(4)));
constexpr int BM = 256, BK = 64, HALF = 128, HTB = HALF * BK * 2  , STAGE_BYTES = 8 * HTB, NXCD = 8, WGM = 2;

__host__ __device__ __forceinline__ int lds_byte(int r, int c) { const int st = (r >> 4) * 2 + (c >> 5), rr = r & 15, cc = c & 31, ob = rr * 64 + cc * 2; return st * 1024 + (ob ^ (((ob >> 9) & 1) << 5)); }
__host__ __device__ __forceinline__ void stage_rc(int b, int& R, int& C) { const int st = b / 1024, sb = b % 1024, swz = sb ^ (((sb >> 9) & 1) << 5); R = (st >> 1) * 16 + swz / 64; C = (st & 1) * 32 + (swz % 64) / 2; }
__host__ __device__ __forceinline__ int perm32(int rho) { const int n = rho >> 4, i = rho & 15; return 8 * (i >> 2) + 4 * n + (i & 3); }

struct Unit { int pm, pn; };
struct Gemm { const bf16_t* A; const bf16_t* Bt; int M, N, K; };

struct StaticOrder {
    int nM, nN, nwg, G, c;
    __host__ __device__ void init(int M, int N, int G_, int c_) { nM = M / BM; nN = N / BM; nwg = nM * nN; G = G_; c = c_; }
    __host__ __device__ bool next(int i, Unit& u) const {
        const long L = (long)i * G + c; if (L >= nwg) return false;
        int wgid = (int)L; { const int q = nwg / NXCD, r = nwg % NXCD, xcd = wgid % NXCD, off = wgid / NXCD; wgid = (xcd < r ? xcd * (q + 1) : r * (q + 1) + (xcd - r) * q) + off; }
        const int nig = WGM * nN, gid = wgid / nig, fm = gid * WGM, gsz = (nM - fm) < WGM ? (nM - fm) : WGM;
        u.pm = fm + ((wgid % nig) % gsz); u.pn = (wgid % nig) / gsz; return true;
    }
    __device__ __forceinline__ void a_ready(const Unit&) const {}
    __device__ __forceinline__ void done(const Unit&) const {}
};

typedef float f32x2 __attribute__((ext_vector_type(2)));
typedef __bf16 bf16x2_t __attribute__((ext_vector_type(2)));
typedef unsigned u32x2 __attribute__((ext_vector_type(2)));
__device__ __forceinline__ unsigned cvt_pk_bf16(float lo, float hi) { f32x2 v = {lo, hi}; bf16x2_t b = __builtin_convertvector(v, bf16x2_t); return __builtin_bit_cast(unsigned, b); }

struct EpiIn {
    static constexpr bool PERM = true, AFTER_DRAIN = false;
    unsigned char* ws; int kind, layer;
    __device__ __forceinline__ void operator()(const f32x4 (&acc)[2][2][4][2], const Unit& u, int wr, int wc, int fr, int fq) const {
        const int pn = u.pn;
        size_t boff; int ldc, colt, sh = 0;
        static_assert(WS_K - WS_Q == WS_V - WS_K, "q | k | v equally spaced");
        if (pn < 9) { const int sec = pn / 3, g = pn - 3 * sec; boff = WS_Q + (size_t)sec * (WS_K - WS_Q); ldc = MIXW; colt = g * 256; if (kind == 0) sh = 2 * g; }
        else if (pn == 9) { boff = WS_QM; ldc = MEMW; colt = 0; }
        else { boff = WS_GATE; ldc = DMODEL; colt = (pn - 10) * 256; }
        bf16_t* base = (bf16_t*)(ws + boff);
        const float* ssq = (const float*)(ws + WS_SSQ); float* kpart = (float*)(ws + WS_KPART);
        const int col0 = colt + wc * 32 + 8 * fq;
        const bool want_ksum = (kind == 1) && (pn >= 3) && (pn < 6);
#pragma unroll
        for (int ai = 0; ai < 2; ++ai)
#pragma unroll
            for (int m = 0; m < 4; ++m) {
                const int row = u.pm * BM + ai * HALF + wr * 64 + m * 16 + fr;
                const f32x4 sp = *(const f32x4*)(ssq + (size_t)row * 16 + 4 * fq);
                float s = (sp[0] + sp[1]) + (sp[2] + sp[3]);
                s += __shfl_xor(s, 16); s += __shfl_xor(s, 32);
                const float rstd = 1.0f / sqrtf(s * (1.0f / DMODEL) + RMS_EPS);
                int orow = row;
                if (sh) { const int b = row >> 13, t = row & (SEQ - 1); orow = (b << 13) + ((t & ((1 << sh) - 1)) << (13 - sh)) + (t >> sh); }
                bf16_t* rowp = base + (size_t)orow * ldc + col0;
#pragma unroll
                for (int bj = 0; bj < 2; ++bj) {
                    const f32x4 v0 = acc[ai][bj][m][0] * rstd, v1 = acc[ai][bj][m][1] * rstd;
                    u32x4 w; w.x = cvt_pk_bf16(v0[0], v0[1]); w.y = cvt_pk_bf16(v0[2], v0[3]); w.z = cvt_pk_bf16(v1[0], v1[1]); w.w = cvt_pk_bf16(v1[2], v1[3]);
                    *(u32x4*)(rowp + bj * HALF) = w;
                }
                if (m & 1) asm volatile("" ::: "memory");
            }
        if (kind != 0 && pn < 6) {
            float rs[2][4];
#pragma unroll
            for (int ai = 0; ai < 2; ++ai)
#pragma unroll
                for (int m = 0; m < 4; ++m) {
                    const int row = u.pm * BM + ai * HALF + wr * 64 + m * 16 + fr;
                    const f32x4 sp = *(const f32x4*)(ssq + (size_t)row * 16 + 4 * fq);
                    float s = (sp[0] + sp[1]) + (sp[2] + sp[3]);
                    s += __shfl_xor(s, 16); s += __shfl_xor(s, 32);
                    rs[ai][m] = 1.0f / sqrtf(s * (1.0f / DMODEL) + RMS_EPS);
                }
#pragma unroll
            for (int bj = 0; bj < 2; ++bj) {
                float mx = 0.f;
#pragma unroll
                for (int ai = 0; ai < 2; ++ai)
#pragma unroll
                    for (int m = 0; m < 4; ++m) {
                        const f32x4 v0 = acc[ai][bj][m][0] * rs[ai][m], v1 = acc[ai][bj][m][1] * rs[ai][m];
                        float q = ((v0[0] * v0[0] + v0[1] * v0[1]) + (v0[2] * v0[2] + v0[3] * v0[3])) + ((v1[0] * v1[0] + v1[1] * v1[1]) + (v1[2] * v1[2] + v1[3] * v1[3]));
                        q += __shfl_xor(q, 16); q += __shfl_xor(q, 32);
                        mx = fmaxf(mx, q);
                    }
                mx = fmaxf(mx, __shfl_xor(mx, 1)); mx = fmaxf(mx, __shfl_xor(mx, 2)); mx = fmaxf(mx, __shfl_xor(mx, 4)); mx = fmaxf(mx, __shfl_xor(mx, 8));
                if (fr == 0 && fq == 0) atomicMax((unsigned*)(ws + WS_NRM) + layer * 96 + ((u.pm >> 5) * 2 + pn / 3) * 24 + (pn % 3) * 8 + bj * 4 + wc, __float_as_uint(mx));
            }
            if (want_ksum) {
#pragma unroll
                for (int bj = 0; bj < 2; ++bj)
#pragma unroll
                    for (int n = 0; n < 2; ++n) {
                        f32x4 v = (f32x4){0.f, 0.f, 0.f, 0.f};
#pragma unroll
                        for (int ai = 0; ai < 2; ++ai)
#pragma unroll
                            for (int m = 0; m < 4; ++m) v += acc[ai][bj][m][n] * rs[ai][m];
#pragma unroll
                        for (int e = 0; e < 4; ++e) { float x = v[e]; x += __shfl_xor(x, 1); x += __shfl_xor(x, 2); x += __shfl_xor(x, 4); x += __shfl_xor(x, 8); v[e] = x; }
                        if (fr == 0) *(f32x4*)(kpart + (size_t)(u.pm * 2 + wr) * MIXW + (pn - 3) * 256 + bj * HALF + wc * 32 + 8 * fq + 4 * n) = v;
                    }
            }
        }
    }
};
struct EpiPlain {
    static constexpr bool PERM = true, AFTER_DRAIN = false;
    bf16_t* O; int ldc;
    __device__ __forceinline__ void operator()(const f32x4 (&acc)[2][2][4][2], const Unit& u, int wr, int wc, int fr, int fq) const {
        const int col0 = u.pn * BM + wc * 32 + 8 * fq;
#pragma unroll
        for (int ai = 0; ai < 2; ++ai)
#pragma unroll
            for (int m = 0; m < 4; ++m) {
                bf16_t* rowp = O + (size_t)(u.pm * BM + ai * HALF + wr * 64 + m * 16 + fr) * ldc + col0;
#pragma unroll
                for (int bj = 0; bj < 2; ++bj) {
                    const f32x4 v0 = acc[ai][bj][m][0], v1 = acc[ai][bj][m][1];
                    u32x4 w; w.x = cvt_pk_bf16(v0[0], v0[1]); w.y = cvt_pk_bf16(v0[2], v0[3]); w.z = cvt_pk_bf16(v1[0], v1[1]); w.w = cvt_pk_bf16(v1[2], v1[3]);
                    *(u32x4*)(rowp + bj * HALF) = w;
                }
            }
    }
};
struct EpiOut {
    static constexpr bool PERM = false, AFTER_DRAIN = false;
    const float* xin; float* xout; bf16_t* xb; float* ssq; int want_xb;
    __device__ __forceinline__ void operator()(const f32x4 (&acc)[2][2][4][2], const Unit& u, int wr, int wc, int fr, int fq) const {
        const int col0 = u.pn * BM + wc * 32 + 4 * fq;
#pragma unroll
        for (int ai = 0; ai < 2; ++ai)
#pragma unroll
            for (int m = 0; m < 4; ++m) {
                const int row = u.pm * BM + ai * HALF + wr * 64 + m * 16 + fr;
                const size_t off = (size_t)row * DMODEL + col0;
                float s = 0.f;
#pragma unroll
                for (int bj = 0; bj < 2; ++bj)
#pragma unroll
                    for (int n = 0; n < 2; ++n) {
                        const size_t o = off + bj * HALF + n * 16;
                        const f32x4 v = *(const f32x4*)(xin + o) + acc[ai][bj][m][n];
                        *(f32x4*)(xout + o) = v;
                        if (want_xb) { u32x2 w; w.x = cvt_pk_bf16(v[0], v[1]); w.y = cvt_pk_bf16(v[2], v[3]); *(u32x2*)(xb + o) = w; }
                        s += (v[0] * v[0] + v[1] * v[1]) + (v[2] * v[2] + v[3] * v[3]);
                    }
                s += __shfl_xor(s, 16); s += __shfl_xor(s, 32);
                if (fq == 0) ssq[(size_t)row * 16 + u.pn * 4 + wc] = s;
            }
    }
};
struct TailOrder {
    int nM, nN, G, c;
    __device__ bool next(int i, Unit& u) const { const int nwg = nM * nN; int idx = c - (G - nwg); if (G < nwg) idx = c; idx += i * G; if (idx < 0 || idx >= nwg || (i > 0 && G >= nwg)) return false; u.pm = idx % nM; u.pn = idx / nM; return true; }
    __device__ __forceinline__ void a_ready(const Unit&) const {}
    __device__ __forceinline__ void done(const Unit&) const {}
};
template <class Epi, class Sched, bool ALIGN_EPI = false, bool SP2 = false>
__device__ __forceinline__ void gemm_phase(PG8_LAS unsigned char* lds, const Gemm g, const Sched& S, const Epi& E) {
    int tid_ = threadIdx.x; asm volatile("" : "+v"(tid_));
    const int tid = tid_, wid = __builtin_amdgcn_readfirstlane(tid >> 6), lane = tid & 63, wr = wid >> 2, wc = wid & 3, fr = lane & 15, fq = lane >> 4;
    const int K = g.K, nt = K / BK;
    unsigned voffA[2], voffB[2];
#pragma unroll
    for (int i = 0; i < 2; ++i) { int R, C; stage_rc(tid * 16 + i * 8192, R, C); const int Rb = Epi::PERM ? ((R & ~31) + perm32(R & 31)) : R;
        voffA[i] = (unsigned)(R * K + C) * 2u; voffB[i] = (unsigned)(Rb * K + C) * 2u; }
    const size_t kstep = (size_t)(BK * 2);
    const size_t hstep = (size_t)HALF * K * 2;
    const size_t tstep = 2 * hstep;
    const unsigned ldsw = (unsigned)wid * 1024u;
    const int aoff = lds_byte(wr * 64 + fr, fq * 8), boff = lds_byte(wc * 32 + fr, fq * 8);
#define PG8_SA(b, h) (((b) * 2 + (h)) * HTB)
#define PG8_SB(b, h) ((4 + (b) * 2 + (h)) * HTB)
#define PG8_STAGE(bufoff, gbase, voff) do { _Pragma("unroll") for (int _i = 0; _i < 2; ++_i) \
        __builtin_amdgcn_global_load_lds((const unsigned*)((const char*)(gbase) + (voff)[_i]), (PG8_LAS unsigned*)(lds + (bufoff) + ldsw + _i * 8192), 16, 0, 0); } while (0)
#define PG8_LDA(dst, b, h) do { _Pragma("unroll") for (int m = 0; m < 4; ++m) _Pragma("unroll") for (int k = 0; k < 2; ++k) dst[m][k] = *(const PG8_LAS bf16x8*)(lds + PG8_SA(b, h) + aoff + m * 2048 + k * 1024); } while (0)
#define PG8_LDB(dst, b, h) do { _Pragma("unroll") for (int n = 0; n < 2; ++n) _Pragma("unroll") for (int k = 0; k < 2; ++k) dst[n][k] = *(const PG8_LAS bf16x8*)(lds + PG8_SB(b, h) + boff + n * 2048 + k * 1024); } while (0)
#define PG8_MMA(ai, bj, At, Bt) do { __builtin_amdgcn_s_setprio(1); _Pragma("unroll") for (int m = 0; m < 4; ++m) _Pragma("unroll") for (int n = 0; n < 2; ++n) _Pragma("unroll") for (int k = 0; k < 2; ++k) \
        acc[ai][bj][m][n] = __builtin_amdgcn_mfma_f32_16x16x32_bf16(Bt[n][k], At[m][k], acc[ai][bj][m][n], 0, 0, 0); __builtin_amdgcn_s_setprio(0); } while (0)
#define PG8_WAIT_V(n) asm volatile("s_waitcnt vmcnt(" #n ")" ::: "memory")
#define PG8_WAIT_L(n) asm volatile("s_waitcnt lgkmcnt(" #n ")" ::: "memory")
#define PG8_BAR __builtin_amdgcn_s_barrier()
#define PG8_SCHED __builtin_amdgcn_sched_barrier(0)
    Unit cur, nxt; int ui = 0;
    if (!S.next(0, cur)) return;
    f32x4 acc[2][2][4][2];
#pragma unroll
    for (int a = 0; a < 2; ++a)
#pragma unroll
        for (int b = 0; b < 2; ++b)
#pragma unroll
            for (int m = 0; m < 4; ++m)
#pragma unroll
                for (int n = 0; n < 2; ++n) acc[a][b][m][n] = (f32x4){0.f, 0.f, 0.f, 0.f};
    bf16x8 At[4][2], B0[2][2], B1[2][2];
    const char* cA = (const char*)g.A + (size_t)cur.pm * tstep; const char* cB = (const char*)g.Bt + (size_t)cur.pn * tstep;
    S.a_ready(cur);
    if constexpr (SP2) {
        PG8_STAGE(PG8_SB(0, 0), cB, voffB); PG8_STAGE(PG8_SB(0, 1), cB + hstep, voffB); PG8_STAGE(PG8_SA(0, 0), cA, voffA); PG8_STAGE(PG8_SA(0, 1), cA + hstep, voffA);
        if (wr == 1) PG8_BAR;
        PG8_WAIT_V(2); PG8_BAR;
        PG8_STAGE(PG8_SB(1, 0), cB + kstep, voffB); PG8_STAGE(PG8_SA(1, 0), cA + kstep, voffA); PG8_STAGE(PG8_SB(1, 1), cB + hstep + kstep, voffB);
        PG8_WAIT_V(6); PG8_BAR;
    } else {
        PG8_STAGE(PG8_SB(0, 0), cB, voffB); PG8_STAGE(PG8_SA(0, 0), cA, voffA); PG8_STAGE(PG8_SB(0, 1), cB + hstep, voffB); PG8_STAGE(PG8_SA(0, 1), cA + hstep, voffA);
        if (wr == 1) PG8_BAR;
        PG8_WAIT_V(4); PG8_BAR;
        PG8_STAGE(PG8_SB(1, 0), cB + kstep, voffB); PG8_STAGE(PG8_SA(1, 0), cA + kstep, voffA); PG8_STAGE(PG8_SB(1, 1), cB + hstep + kstep, voffB);
        PG8_WAIT_V(6); PG8_BAR;
    }
    for (;;) {
        const bool has_next = S.next(ui + 1, nxt);
        const char* nA = has_next ? (const char*)g.A + (size_t)nxt.pm * tstep : cA; const char* nB = has_next ? (const char*)g.Bt + (size_t)nxt.pn * tstep : cB;
        for (int t = 0; t < nt; t += 2) {
            const bool last = (t == nt - 2);
            const char* a1 = cA + (size_t)(t + 1) * kstep;
            const char* a2 = last ? nA : cA + (size_t)(t + 2) * kstep; const char* b2 = last ? nB : cB + (size_t)(t + 2) * kstep;
            const char* a3 = a2 + kstep; const char* b3 = b2 + kstep;
            if (last && has_next) S.a_ready(nxt);
            if constexpr (SP2) {
            PG8_LDB(B0, 0, 0); PG8_LDB(B1, 0, 1); PG8_SCHED; PG8_LDA(At, 0, 0); PG8_STAGE(PG8_SA(1, 1), a1 + hstep, voffA);
            PG8_WAIT_V(8); PG8_WAIT_L(0); PG8_BAR; PG8_MMA(0, 0, At, B0); PG8_MMA(0, 1, At, B1); PG8_BAR; PG8_SCHED;
            PG8_LDA(At, 0, 1); PG8_STAGE(PG8_SB(0, 0), b2, voffB); PG8_STAGE(PG8_SB(0, 1), b2 + hstep, voffB); PG8_STAGE(PG8_SA(0, 0), a2, voffA);
            PG8_WAIT_V(8); PG8_WAIT_L(0); PG8_BAR; PG8_MMA(1, 0, At, B0); PG8_MMA(1, 1, At, B1); PG8_BAR; PG8_SCHED;
            PG8_LDB(B0, 1, 0); PG8_LDB(B1, 1, 1); PG8_SCHED; PG8_LDA(At, 1, 0); PG8_STAGE(PG8_SA(0, 1), a2 + hstep, voffA);
            PG8_WAIT_V(8); PG8_WAIT_L(0); PG8_BAR; PG8_MMA(0, 0, At, B0); PG8_MMA(0, 1, At, B1); PG8_BAR; PG8_SCHED;
            PG8_LDA(At, 1, 1); PG8_STAGE(PG8_SB(1, 0), b3, voffB); PG8_STAGE(PG8_SB(1, 1), b3 + hstep, voffB); PG8_STAGE(PG8_SA(1, 0), a3, voffA);
            PG8_WAIT_V(8); PG8_WAIT_L(0); PG8_BAR; PG8_MMA(1, 0, At, B0); PG8_MMA(1, 1, At, B1); PG8_BAR; PG8_SCHED;
            } else {
            PG8_LDB(B0, 0, 0); PG8_SCHED; PG8_LDA(At, 0, 0); PG8_STAGE(PG8_SA(1, 1), a1 + hstep, voffA);
            PG8_WAIT_L(8); PG8_BAR; PG8_WAIT_L(0); PG8_MMA(0, 0, At, B0); PG8_BAR; PG8_SCHED;
            PG8_LDB(B1, 0, 1); PG8_STAGE(PG8_SB(0, 0), b2, voffB);
            PG8_BAR; PG8_WAIT_L(0); PG8_MMA(0, 1, At, B1); PG8_BAR;
            PG8_LDA(At, 0, 1); PG8_STAGE(PG8_SA(0, 0), a2, voffA);
            PG8_BAR; PG8_WAIT_L(0); PG8_MMA(1, 0, At, B0); PG8_BAR; PG8_SCHED;
            PG8_STAGE(PG8_SB(0, 1), b2 + hstep, voffB);
            PG8_WAIT_V(6); PG8_BAR; PG8_MMA(1, 1, At, B1); PG8_BAR;
            PG8_LDB(B0, 1, 0); PG8_SCHED; PG8_LDA(At, 1, 0); PG8_STAGE(PG8_SA(0, 1), a2 + hstep, voffA);
            PG8_WAIT_L(8); PG8_BAR; PG8_WAIT_L(0); PG8_MMA(0, 0, At, B0); PG8_BAR; PG8_SCHED;
            PG8_LDB(B1, 1, 1); PG8_STAGE(PG8_SB(1, 0), b3, voffB);
            PG8_BAR; PG8_WAIT_L(0); PG8_MMA(0, 1, At, B1); PG8_BAR;
            PG8_LDA(At, 1, 1); PG8_STAGE(PG8_SA(1, 0), a3, voffA);
            PG8_BAR; PG8_WAIT_L(0); PG8_MMA(1, 0, At, B0); PG8_BAR; PG8_SCHED;
            PG8_STAGE(PG8_SB(1, 1), b3 + hstep, voffB);
            PG8_WAIT_V(6); PG8_BAR; PG8_MMA(1, 1, At, B1); PG8_BAR;
            }
        }
        if constexpr (ALIGN_EPI) { if (wr == 0) PG8_BAR; }
        if constexpr (!Epi::AFTER_DRAIN) { E(acc, cur, wr, wc, fr, fq); S.done(cur); }
        if (!has_next) break;
#pragma unroll
        for (int a = 0; a < 2; ++a)
#pragma unroll
            for (int b = 0; b < 2; ++b)
#pragma unroll
                for (int m = 0; m < 4; ++m)
#pragma unroll
                    for (int n = 0; n < 2; ++n) acc[a][b][m][n] = (f32x4){0.f, 0.f, 0.f, 0.f};
        cur = nxt; cA = nA; cB = nB; ++ui;
        if constexpr (ALIGN_EPI) { if (wr == 1) PG8_BAR; }
    }
    PG8_WAIT_V(0);
    if constexpr (!ALIGN_EPI) { if (wr == 0) PG8_BAR; }
    PG8_BAR;
    if constexpr (Epi::AFTER_DRAIN) { E.fused(acc, cur, wr, wc, fr, fq, lds, wid, lane); S.done(cur); }
#undef PG8_SA
#undef PG8_SB
#undef PG8_STAGE
#undef PG8_LDA
#undef PG8_LDB
#undef PG8_MMA
#undef PG8_WAIT_V
#undef PG8_WAIT_L
#undef PG8_BAR
#undef PG8_SCHED
}
}
namespace att {
#define LAS __attribute__((address_space(3)))
typedef unsigned short bf16_t;
typedef short bf16x8 __attribute__((ext_vector_type(8)));
typedef short s16x4 __attribute__((ext_vector_type(4)));
typedef short v4i16_t __attribute__((ext_vector_type(4)));
typedef float f32x16 __attribute__((ext_vector_type(16)));
typedef float f32x4 __attribute__((ext_vector_type(4)));
typedef float f32x2_t __attribute__((ext_vector_type(2)));
typedef __bf16 bf16x2_t __attribute__((ext_vector_type(2)));
typedef unsigned u32x4 __attribute__((ext_vector_type(4)));
typedef LAS char* lptr;
typedef LAS const char* lcptr;
constexpr int NW = 8;
constexpr int KSLOT = 8192, VSLOT = 16384;
#define ATT_PD 2
#if PROBE_WORK == 3
#define ATT_CNT64 4
#define ATT_CNT128 6
#else
#define ATT_CNT64 2
#define ATT_CNT128 3
#endif
constexpr int PD = ATT_PD, NKS = PD + 2, NVS = PD + 3;
constexpr int L_K = 0, L_V = NKS * KSLOT, L_WS = L_V + NVS * VSLOT, L_KM = L_WS + NW * 256, L_END = L_KM + 8192;
constexpr int L_OST = 0;
static_assert(NW * 8192 <= L_WS, "output stage inside the rings");
constexpr float NEG_INF = -INFINITY;

__device__ __forceinline__ int crow(int r, int hi) { return (r & 3) + 8 * (r >> 2) + 4 * hi; }
__device__ __forceinline__ unsigned cvtpk(float lo, float hi) { f32x2_t v = {lo, hi}; bf16x2_t b = __builtin_convertvector(v, bf16x2_t); return __builtin_bit_cast(unsigned, b); }
__device__ __forceinline__ float bf2f_lo(unsigned w) { return __uint_as_float(w << 16); }
__device__ __forceinline__ float bf2f_hi(unsigned w) { return __uint_as_float(w & 0xffff0000u); }
__device__ __forceinline__ void glds16(const void* gsrc, unsigned lds_dst) { unsigned keep;
    asm volatile("s_mov_b32 %0, m0\n\ts_mov_b32 m0, %2\n\ts_nop 0\n\tglobal_load_lds_dwordx4 %1, off\n\ts_mov_b32 m0, %0" : "=&s"(keep) : "v"(gsrc), "s"(lds_dst) : "memory"); }
#define ATT_WAIT_BAR() asm volatile("s_waitcnt vmcnt(0) lgkmcnt(0)\n\ts_barrier" ::: "memory")
#define ATT_STR2(x) #x
#define ATT_STR(x) ATT_STR2(x)
#define ATT_WAIT_BAR_N(N) asm volatile("s_waitcnt vmcnt(" ATT_STR(N) ") lgkmcnt(0)\n\ts_barrier" ::: "memory")
#define ATT_MFMA(a, b, c) __builtin_amdgcn_mfma_f32_32x32x16_bf16(a, b, c, 0, 0, 0)
__device__ __forceinline__ s16x4 vtr(lcptr p) { return __builtin_bit_cast(s16x4, __builtin_amdgcn_ds_read_tr16_b64_v4i16((LAS v4i16_t*)p)); }
__device__ __forceinline__ float swap_half(float v) { auto rr = __builtin_amdgcn_permlane32_swap(__float_as_uint(v), __float_as_uint(v), false, false); const int hi = (threadIdx.x >> 5) & 1; return __uint_as_float(hi ? rr[0] : rr[1]); }
__device__ __forceinline__ float rowmax(const f32x16& p0, const f32x16& p1) {
    float a = fmaxf(fmaxf(p0[0], p0[1]), p1[0]), b = fmaxf(fmaxf(p0[2], p0[3]), p1[1]); a = fmaxf(fmaxf(a, p1[2]), p1[3]);
#pragma unroll
    for (int r = 4; r < 16; r += 4) { a = fmaxf(fmaxf(a, p0[r]), p0[r + 1]); b = fmaxf(fmaxf(b, p0[r + 2]), p0[r + 3]); a = fmaxf(fmaxf(a, p1[r]), p1[r + 1]); b = fmaxf(fmaxf(b, p1[r + 2]), p1[r + 3]); }
    const float m = fmaxf(a, b);
    return fmaxf(m, swap_half(m));
}

struct BMNone {
    __device__ __forceinline__ bool active(int) const { return true; }
    __device__ __forceinline__ float cbase(int, float mref) const { return -mref; }
    __device__ __forceinline__ float cslope() const { return 0.f; }
    __device__ __forceinline__ void mask(int, f32x16&, f32x16&) const {}
};
struct BMBand {
    int qpos, qlo, W, hi; float slope2;
    __device__ __forceinline__ void init(int qpos_, int qlo_, int W_, float slope2_, int hi_) { qpos = qpos_; qlo = qlo_; W = W_; slope2 = slope2_; hi = hi_; }
    __device__ __forceinline__ bool active(int t) const { return (64 * t <= qlo + 31) && (64 * t + 63 >= qlo - W); }
    __device__ __forceinline__ float cbase(int t, float mref) const { return slope2 * (float)(64 * t + 4 * hi - qpos) - mref; }
    __device__ __forceinline__ float cslope() const { return slope2; }
    __device__ __forceinline__ void mask(int t, f32x16& p0, f32x16& p1) const {
        if ((64 * t + 63 > qlo) || (64 * t < qlo + 31 - W)) {
            const int d0 = qpos - 64 * t - 4 * hi;
#pragma unroll
            for (int r = 0; r < 16; ++r) { const int d = d0 - ((r & 3) + 8 * (r >> 2)); if (d < 0 || d > W) p0[r] = NEG_INF; const int e = d - 32; if (e < 0 || e > W) p1[r] = NEG_INF; }
        }
    }
};
struct BMMoba {
    BMBand band; unsigned sel; int qb;
    __device__ __forceinline__ bool active(int t) const { const int j = t >> 2; if (j == qb) return band.active(t); return __builtin_amdgcn_ballot_w64(((sel >> j) & 1u) != 0u) != 0ull; }
    __device__ __forceinline__ float cbase(int t, float mref) const { const int j = t >> 2; return band.cbase(t, (j == qb || ((sel >> j) & 1u)) ? mref : INFINITY); }
    __device__ __forceinline__ float cslope() const { return band.slope2; }
    __device__ __forceinline__ void mask(int t, f32x16& p0, f32x16& p1) const { const int j = t >> 2;
        if (j == qb) band.mask(t, p0, p1); }
};

constexpr float ATT_THR = 8.0f;
template <int DV, bool DO_QK, bool DO_PV, class BM>
__device__ __forceinline__ void att_block(const BM& bm, int tn, float mref, lcptr kq_, lcptr vq_, const bf16x8 (&qr)[4], f32x16& s0, f32x16& s1, f32x16& q0, f32x16& q1,
                                          u32x4 (&pan)[4], const u32x4 (&pao)[4], f32x16 (&o)[DV / 32], float& l_run) {
    constexpr int NPV = DO_PV ? DV / 8 : 0, NQK = DO_QK ? 8 : 0, NG = NPV + NQK;
    constexpr int KAH = 4, VAH = 3;
    constexpr int CG0 = NPV >= 8 ? NPV - 8 : 0;
    s16x4 lo[4], hh[4]; bf16x8 kfr[8];
    const bf16x8 pa_[4] = {__builtin_bit_cast(bf16x8, pao[0]), __builtin_bit_cast(bf16x8, pao[1]), __builtin_bit_cast(bf16x8, pao[2]), __builtin_bit_cast(bf16x8, pao[3])};
    float e0 = 0.f, e1 = 0.f;
    const float cb0 = DO_QK ? bm.cbase(tn, mref) : 0.f, csl = DO_QK ? bm.cslope() : 0.f, cb1 = cb0 + 32.f * csl;
#define ATT_VRD(f_) do { lo[(f_) & 3] = vtr(vq_ + ((f_) >> 2) * 4096 + ((f_) & 3) * 1024); hh[(f_) & 3] = vtr(vq_ + ((f_) >> 2) * 4096 + ((f_) & 3) * 1024 + 512); } while (0)
#define ATT_KRD(k_) do { kfr[k_] = *(const LAS bf16x8*)(kq_ + ((k_) >> 1) * 2048 + ((k_) & 1) * 512); } while (0)
#define ATT_PK(k) (bf16x8){lo[k][0], lo[k][1], lo[k][2], lo[k][3], hh[k][0], hh[k][1], hh[k][2], hh[k][3]}
#define ATT_EXP1(e_) do { if ((e_) < 16) { s0[(e_) & 15] = __builtin_amdgcn_exp2f(s0[(e_) & 15]); e0 += s0[(e_) & 15]; asm volatile("" : "+v"(e0)); } else { s1[(e_) & 15] = __builtin_amdgcn_exp2f(s1[(e_) & 15]); e1 += s1[(e_) & 15]; asm volatile("" : "+v"(e1)); } } while (0)
#define ATT_PACK1(p_) do { pan[(p_) >> 2][(p_) & 3] = ((p_) < 8) ? cvtpk(s0[(2 * (p_)) & 15], s0[(2 * (p_) + 1) & 15]) : cvtpk(s1[(2 * (p_)) & 15], s1[(2 * (p_) + 1) & 15]); } while (0)
#define ATT_CEL(c_) do { const float cf_ = (float)((((c_) & 15) & 3) + 8 * (((c_) & 15) >> 2)); if ((c_) < 16) q0[(c_) & 15] = __builtin_fmaf(csl, cf_, cb0); else q1[(c_) & 15] = __builtin_fmaf(csl, cf_, cb1); } while (0)
    if (DO_PV) {
#pragma unroll
        for (int f = 0; f < VAH; ++f) ATT_VRD(f);
    }
    if (DO_QK && NPV < KAH) {
#pragma unroll
        for (int k = 0; k < KAH - NPV; ++k) ATT_KRD(k);
    }
    if (DO_QK && NPV < 8) {
#pragma unroll
        for (int c = 0; c < 32; ++c) ATT_CEL(c);
    }
    __builtin_amdgcn_sched_barrier(0);
#pragma unroll
    for (int g = 0; g < NG; ++g) {
        if (g < NPV && g + VAH < NPV) ATT_VRD(g + VAH);
        if (DO_QK && g + KAH >= NPV && g + KAH - NPV < 8) ATT_KRD(g + KAH - NPV);
        if (g < NPV) o[g >> 2] = ATT_MFMA(pa_[g & 3], ATT_PK(g & 3), o[g >> 2]);
        else { const int k = g - NPV; if (k & 1) q1 = ATT_MFMA(kfr[k], qr[k >> 1], q1); else q0 = ATT_MFMA(kfr[k], qr[k >> 1], q0); }
        {
            const int e_lo = (32 * g) / NG, e_hi = (32 * (g + 1)) / NG;
#pragma unroll
            for (int e_ = 0; e_ < 32; ++e_) if (e_ >= e_lo && e_ < e_hi) ATT_EXP1(e_);
#pragma unroll
            for (int p_ = 0; p_ < 16; ++p_) if (2 * p_ + 1 < e_lo && 2 * p_ + 1 >= (g == 0 ? 0 : (32 * (g - 1)) / NG)) ATT_PACK1(p_);
        }
        if (DO_QK && NPV >= 8 && g >= CG0 && g < CG0 + 8) { ATT_CEL(4 * (g - CG0)); ATT_CEL(4 * (g - CG0) + 1); ATT_CEL(4 * (g - CG0) + 2); ATT_CEL(4 * (g - CG0) + 3); }
        __builtin_amdgcn_sched_barrier(0);
    }
    if (NG == 0) {
#pragma unroll
        for (int e_ = 0; e_ < 32; ++e_) ATT_EXP1(e_);
    }
#pragma unroll
    for (int p_ = 0; p_ < 16; ++p_) if (NG == 0 || 2 * p_ + 1 >= (32 * (NG - 1)) / NG) ATT_PACK1(p_);
    l_run += e0 + e1;
#undef ATT_VRD
#undef ATT_KRD
#undef ATT_PK
#undef ATT_EXP1
#undef ATT_PACK1
#undef ATT_CEL
}
template <int DV, class BM, bool PERWAVE = false>
__device__ __forceinline__ void flash_loop(lptr L, const bf16x8 (&qr)[4], const bf16_t* Kb, const bf16_t* Vb, int kp, int vp, int t_hi, int t_lo, const BM& bm,
                                           f32x16 (&o)[DV / 32], float& m_run, float& l_run) {
    int tid_ = threadIdx.x; asm volatile("" : "+v"(tid_));
    const int tid = tid_, lane = tid & 63, r32 = lane & 31, hi = lane >> 5;
    const int wid = __builtin_amdgcn_readfirstlane(tid >> 6);
    const unsigned lds0 = (unsigned)(uintptr_t)L;
    LAS float* wsf = (LAS float*)(L + L_WS) + wid * 64;
    const bf16_t* ksrc = Kb + (size_t)lane * kp + wid * 8;
    const bf16_t* vsrc = Vb + (size_t)(16 * (wid & 3) + (lane >> 2)) * vp + (wid >> 2) * 32 + (lane & 3) * 8;
    const unsigned kdst = lds0 + L_K + wid * 1024, vdst = lds0 + L_V + wid * 1024;
#define ATT_DMA(t, ks, vs) do { glds16(ksrc + (size_t)(t) * 64 * kp, (unsigned)__builtin_amdgcn_readfirstlane(kdst + (ks) * KSLOT)); \
        glds16(vsrc + (size_t)(t) * 64 * vp, (unsigned)__builtin_amdgcn_readfirstlane(vdst + (vs) * VSLOT)); \
        if (DV == 128) glds16(vsrc + (size_t)(t) * 64 * vp + 64, (unsigned)__builtin_amdgcn_readfirstlane(vdst + (vs) * VSLOT + 8192)); } while (0)
    const lcptr kp0 = (lcptr)L + L_K + hi * 1024 + r32 * 16;
    const lcptr vp0 = (lcptr)L + L_V + ((lane >> 4) & 1) * 32 + (lane & 3) * 8 + (4 * hi + ((lane & 15) >> 2)) * 64;
#define ATT_INC(x, N) ((x) + 1 == (N) ? 0 : (x) + 1)
#define ATT_WAIT_CNT() do { if (DV == 128) ATT_WAIT_BAR_N(ATT_CNT128); else ATT_WAIT_BAR_N(ATT_CNT64); } while (0)
#define ATT_DECIDE(t, q0, q1, pan) do { bm.mask(t, q0, q1); const float rm = rowmax(q0, q1); \
        if (__builtin_amdgcn_ballot_w64(rm > ATT_THR) != 0ull) { const float dl = fmaxf(rm, 0.f), f = __builtin_amdgcn_exp2f(-dl); \
            mref += dl; l_run *= f; \
            _Pragma("unroll") for (int r = 0; r < 16; ++r) { q0[r] -= dl; q1[r] -= dl; } \
            if (hi == 0) wsf[r32] = f; \
            _Pragma("unroll") for (int r = 0; r < 16; ++r) { const float fr_ = wsf[crow(r, hi)]; _Pragma("unroll") for (int d = 0; d < DV / 32; ++d) o[d][r] *= fr_; } \
            _Pragma("unroll") for (int w = 0; w < 4; ++w) _Pragma("unroll") for (int e = 0; e < 4; ++e) pan[w][e] = cvtpk(bf2f_lo(pan[w][e]) * f, bf2f_hi(pan[w][e]) * f); } } while (0)
    const int n = t_hi - t_lo + 1;
    float mref = 0.f;
    u32x4 PA[4] = {u32x4{}, u32x4{}, u32x4{}, u32x4{}}, PB[4] = {u32x4{}, u32x4{}, u32x4{}, u32x4{}};
    ATT_WAIT_BAR();
    int kd = 0, vd = 0;
#pragma unroll
    for (int j = 0; j <= PD; ++j) if (j < n) { ATT_DMA(t_hi - j, kd, vd); kd = ATT_INC(kd, NKS); vd = ATT_INC(vd, NVS); }
    if (n > PD) ATT_WAIT_CNT(); else ATT_WAIT_BAR();
    int jA = 0, jE = n;
    if constexpr (PERWAVE) { jA = n; jE = 0; for (int j = 0; j < n; ++j) if (bm.active(t_hi - j)) { if (j < jA) jA = j; jE = j + 1; } if (jE <= jA) { jA = 0; jE = 1; } }
    f32x16 A0, A1, B0, B1;
    int ks = 1, vs_prev = 0, vsn = 0, i = 0;
#define ATT_ADV() do { ks = ATT_INC(ks, NKS); vs_prev = vsn; vsn = ATT_INC(vsn, NVS); ++i; } while (0)
#define ATT_STEP_DMA() do { if (i + 1 + PD < n) { ATT_DMA(t_hi - i - 1 - PD, kd, vd); kd = ATT_INC(kd, NKS); vd = ATT_INC(vd, NVS); } } while (0)
#define ATT_STEP_END() do { if (i + 1 + PD < n) ATT_WAIT_CNT(); else ATT_WAIT_BAR(); ATT_ADV(); } while (0)
#define ATT_PROLOGUE_QK(tile_, kslot_) do { const float cb0 = bm.cbase(tile_, 0.f), csl = bm.cslope(), cb1 = cb0 + 32.f * csl; const lcptr kq_ = kp0 + (kslot_) * KSLOT; \
      _Pragma("unroll") for (int r = 0; r < 16; ++r) { const float cf = (float)((r & 3) + 8 * (r >> 2)); A0[r] = __builtin_fmaf(csl, cf, cb0); A1[r] = __builtin_fmaf(csl, cf, cb1); } \
      _Pragma("unroll") for (int d0 = 0; d0 < 4; ++d0) { const bf16x8 k0 = *(const LAS bf16x8*)(kq_ + d0 * 2048), k1 = *(const LAS bf16x8*)(kq_ + d0 * 2048 + 512); A0 = ATT_MFMA(k0, qr[d0], A0); A1 = ATT_MFMA(k1, qr[d0], A1); } \
      bm.mask(tile_, A0, A1); \
      const float rm = rowmax(A0, A1); mref = (rm == NEG_INF) ? 0.f : rm; \
      _Pragma("unroll") for (int r = 0; r < 16; ++r) { A0[r] -= mref; A1[r] -= mref; } } while (0)
    if (jA == 0) ATT_PROLOGUE_QK(t_hi, 0);
    else {
#pragma nounroll
        while (i + 1 < jA) { ATT_STEP_DMA(); ATT_STEP_END(); }
        ATT_STEP_DMA(); ATT_PROLOGUE_QK(t_hi - jA, ks); ATT_STEP_END();
    }
#define ATT_STEP(S0, S1, PS, Q0, Q1, PQ, DO_QK, DO_PV) do { const int tn = t_hi - i - 1; \
        ATT_STEP_DMA(); \
        att_block<DV, DO_QK, DO_PV>(bm, tn, mref, kp0 + ks * KSLOT, vp0 + vs_prev * VSLOT, qr, S0, S1, Q0, Q1, PS, PQ, o, l_run); \
        if (DO_QK) ATT_DECIDE(tn, Q0, Q1, PS); \
        ATT_STEP_END(); } while (0)
    float ldead = 0.f;
    bool last_in_A;
    if (jE - jA > 1) ATT_STEP(A0, A1, PA, B0, B1, PB, true, false); else ATT_STEP(A0, A1, PA, B0, B1, PB, false, false);
#pragma nounroll
    while (i + 2 < jE) { ATT_STEP(B0, B1, PB, A0, A1, PA, true, true); ATT_STEP(A0, A1, PA, B0, B1, PB, true, true); }
    if (i + 2 == jE) { ATT_STEP(B0, B1, PB, A0, A1, PA, true, true); ATT_STEP(A0, A1, PA, B0, B1, PB, false, true); last_in_A = true; }
    else if (i + 1 == jE) { ATT_STEP(B0, B1, PB, A0, A1, PA, false, true); last_in_A = false; }
    else last_in_A = true;
    if (jE < n) ATT_STEP_DMA();
    if (last_in_A) att_block<DV, false, true>(bm, 0, mref, kp0, vp0 + vs_prev * VSLOT, qr, B0, B1, B0, B1, PB, PA, o, ldead);
    else att_block<DV, false, true>(bm, 0, mref, kp0, vp0 + vs_prev * VSLOT, qr, A0, A1, A0, A1, PA, PB, o, ldead);
    if (jE < n) { ATT_STEP_END();
#pragma nounroll
        while (i < n) { ATT_STEP_DMA(); ATT_STEP_END(); } }
    ATT_WAIT_BAR();
    m_run = mref;
#undef ATT_STEP
#undef ATT_ADV
#undef ATT_STEP_DMA
#undef ATT_STEP_END
#undef ATT_PROLOGUE_QK
#undef ATT_DMA
#undef ATT_INC
#undef ATT_WAIT_CNT
#undef ATT_DECIDE
}

__device__ __forceinline__ float bf2f_(unsigned short u) { return __uint_as_float(((unsigned)u) << 16); }
__device__ __forceinline__ float silu_(float g) { return g * __builtin_amdgcn_rcpf(1.0f + __builtin_amdgcn_exp2f(-g * LOG2E)); }
template <int DV, bool GATED, class RowPtr>
__device__ __forceinline__ float finish_unit(lptr L, f32x16 (&o)[DV / 32], float m_run, float l_run, const RowPtr& rp) {
    int tid_ = threadIdx.x; asm volatile("" : "+v"(tid_));
    const int tid = tid_, lane = tid & 63, r32 = lane & 31, hi = lane >> 5;
    const int wid = __builtin_amdgcn_readfirstlane(tid >> 6);
    LAS float* wsf = (LAS float*)(L + L_WS) + wid * 64;
    const float l_tot = l_run + swap_half(l_run);
    if (hi == 0) wsf[32 + r32] = l_tot;
    LAS bf16_t* stg = (LAS bf16_t*)(L + L_OST + wid * 8192);
#pragma unroll
    for (int r = 0; r < 16; ++r) { const int orow = crow(r, hi); const float rl = __builtin_amdgcn_rcpf(wsf[32 + orow]);
#pragma unroll
        for (int d = 0; d < DV / 32; ++d) { const __hip_bfloat16 hv = __float2bfloat16(o[d][r] * rl); stg[orow * DV + d * 32 + r32] = __builtin_bit_cast(unsigned short, hv); } }
    constexpr int CPR = DV / 8;
#pragma unroll
    for (int it = 0; it < DV / 16; ++it) { const int idx = it * 64 + lane, row = idx / CPR, ch = idx % CPR;
        u32x4 v = *(const LAS u32x4*)((lcptr)stg + row * (DV * 2) + ch * 16);
        u32x4* gp = (u32x4*)(rp(row) + ch * 8);
        if (GATED) { const u32x4 g = *gp;
#pragma unroll
            for (int e = 0; e < 4; ++e) { const float o0 = bf2f_((unsigned short)(v[e] & 0xffffu)), o1 = bf2f_((unsigned short)(v[e] >> 16));
                const float g0 = bf2f_((unsigned short)(g[e] & 0xffffu)), g1 = bf2f_((unsigned short)(g[e] >> 16));
                v[e] = cvtpk(o0 * silu_(g0), o1 * silu_(g1)); } }
        *gp = v; }
    return m_run + __builtin_amdgcn_logf(l_tot);
}
__device__ __forceinline__ void load_q(bf16x8 (&qr)[4], const bf16_t* qrow, int hi) {
#pragma unroll
    for (int d0 = 0; d0 < 4; ++d0) qr[d0] = *(const bf16x8*)(qrow + d0 * 16 + hi * 8);
}
__device__ __forceinline__ float alibi2(int i, int n) { return exp2f(-8.0f * (float)(i + 1) / (float)n) * LOG2E; }
}
constexpr int RING_OFF = 0, RING_BYTES = 131072;
constexpr int ATT_BYTES = 144 * 1024;
constexpr int LDSCTL_OFF = ATT_BYTES, MISC_OFF = LDSCTL_OFF + 320;
constexpr int LDS_BYTES = 148480;
static_assert(att::L_END <= ATT_BYTES && RING_BYTES <= ATT_BYTES && MISC_OFF + 128 <= LDS_BYTES, "LDS map");
constexpr int NWAVES = 8;
constexpr int NPHASES = 2 + 4 * DEPTH;

#define GAS __attribute__((address_space(1)))
#define LAS __attribute__((address_space(3)))
typedef unsigned short bf16;
typedef unsigned v4u __attribute__((ext_vector_type(4)));
typedef float f32x4 __attribute__((ext_vector_type(4)));
typedef short bf16x8 __attribute__((ext_vector_type(8)));
typedef GAS unsigned gu32;
typedef GAS unsigned long long gu64;
#define RLX_AGENT __ATOMIC_RELAXED, __HIP_MEMORY_SCOPE_AGENT
#define LDS_WAIT() asm volatile("s_waitcnt lgkmcnt(0)" ::: "memory")
#define VM_WAIT() asm volatile("s_waitcnt vmcnt(0)" ::: "memory")
__device__ __forceinline__ unsigned long long rt() { return __builtin_amdgcn_s_memrealtime(); }
__device__ __forceinline__ unsigned f2bf(float f) { unsigned u = __builtin_bit_cast(unsigned, f); return (u + 0x7fffu + ((u >> 16) & 1u)) >> 16; }
__device__ __forceinline__ unsigned pk2(float lo, float hi) { return f2bf(lo) | (f2bf(hi) << 16); }
#define XB_TMO      128
#define XB_XCNT(j)  (256  + 64 * (j))
#define XB_XSUB(j)  (1280 + 64 * (j))
#define XB_XGEN(j)  (2304 + 64 * (j))
#define XB_TOP      3328
#define XB_TOPGEN   3392
#define XCD_BAR_WORDS 3456
#define XB_SPIN_CAP (1u << 18)

__device__ __forceinline__ unsigned xb_ld(unsigned* p)              { return __hip_atomic_load(p, __ATOMIC_RELAXED, __HIP_MEMORY_SCOPE_AGENT); }
__device__ __forceinline__ unsigned xb_add(unsigned* p, unsigned v) { return __hip_atomic_fetch_add(p, v, __ATOMIC_RELAXED, __HIP_MEMORY_SCOPE_AGENT); }
__device__ __forceinline__ unsigned xb_xcc_id() { return (unsigned)__builtin_amdgcn_s_getreg((3 << 11) | 20) & 0xFu; }
#define XB_SPIN(cond, bar) do { unsigned _sp = 0; while (cond) { __builtin_amdgcn_s_sleep(1); \
    if ((++_sp & 255u) == 0u) { if (xb_ld(&(bar)[XB_TMO])) break; if (_sp > XB_SPIN_CAP) { atomicAdd(&(bar)[XB_TMO], 1u); break; } } } } while (0)

struct XcdBarrier {
    unsigned* bar; unsigned x;
    volatile LAS unsigned* st;
};

__device__ __forceinline__ XcdBarrier xcd_barrier_post(unsigned* bar, volatile LAS unsigned* st) {
    XcdBarrier b; b.bar = bar; b.x = xb_xcc_id(); b.st = st;
    if (threadIdx.x == 0) (void)xb_add(&bar[XB_XCNT(b.x)], 1u);
    return b;
}
__device__ __forceinline__ void xcd_barrier_complete(unsigned* bar, unsigned x, unsigned& nloc, unsigned& nx) {
    const unsigned G = gridDim.x * gridDim.y * gridDim.z;
    unsigned sum, cnt, mine, sp = 0u;
    for (;;) {
        sum = 0u; cnt = 0u; mine = 0u;
#pragma unroll
        for (unsigned j = 0; j < 16; ++j) { const unsigned c = xb_ld(&bar[XB_XCNT(j)]); sum += c; cnt += (c > 0u) ? 1u : 0u; mine = (j == x) ? c : mine; }
        if (sum == G) break;
        __builtin_amdgcn_s_sleep(1);
        if ((++sp & 255u) == 0u) { if (xb_ld(&bar[XB_TMO])) break; if (sp > XB_SPIN_CAP) { atomicAdd(&bar[XB_TMO], 1u); break; } }
    }
    nloc = mine > 0u ? mine : 1u; nx = cnt > 0u ? cnt : 1u;
}

__device__ __forceinline__ void xcd_barrier(const XcdBarrier& b) {
    asm volatile("s_waitcnt vmcnt(0)" ::: "memory");
    __syncthreads();
    if (threadIdx.x == 0) {
        unsigned* bar = b.bar;
        __builtin_amdgcn_s_waitcnt(0);
        unsigned nloc = b.st[0], nx = b.st[1];
        if (nloc == 0u) { xcd_barrier_complete(bar, b.x, nloc, nx); b.st[0] = nloc; b.st[1] = nx; }
        const unsigned old = xb_add(&bar[XB_XSUB(b.x)], 1u);
        const unsigned gen = old / nloc;
        if (old + 1u == (gen + 1u) * nloc) {
            __builtin_amdgcn_fence(__ATOMIC_RELEASE, "agent");
            asm volatile("s_waitcnt vmcnt(0)" ::: "memory");
            const unsigned og = xb_add(&bar[XB_TOP], 1u);
            const unsigned tg = og / nx;
            if (og + 1u == (tg + 1u) * nx) xb_add(&bar[XB_TOPGEN], 1u);
            else XB_SPIN(xb_ld(&bar[XB_TOPGEN]) == tg, bar);
            __builtin_amdgcn_fence(__ATOMIC_ACQUIRE, "agent");
            xb_add(&bar[XB_XGEN(b.x)], 1u);
            asm volatile("s_waitcnt vmcnt(0)" ::: "memory");
        } else {
            XB_SPIN(xb_ld(&bar[XB_XGEN(b.x)]) == gen, bar);
            __builtin_amdgcn_fence(__ATOMIC_ACQUIRE, "agent");
            asm volatile("s_waitcnt vmcnt(0)" ::: "memory");
        }
    }
    __syncthreads();
}
struct Args { const float* in[13]; float* out; unsigned char* ws; int ph_lo, ph_hi, li, pad; };
struct Frame {
    LAS unsigned char* lds;
    int tid, lane, wave, vcu, G;
    unsigned char* ws;
};
#define IN_X(a) ((a).in[0])
#define IN_MEM(a) ((a).in[1])
#define IN_NORM_G(a) ((a).in[2])
#define IN_W_IN(a) ((a).in[3])
#define IN_W_OUT(a) ((a).in[4])
#define IN_MEM_NORM_G(a) ((a).in[5])
#define IN_W_MEM_KV(a) ((a).in[6])
#define IN_LQ1(a) ((a).in[7])
#define IN_LK1(a) ((a).in[8])
#define IN_LQ2(a) ((a).in[9])
#define IN_LK2(a) ((a).in[10])
#define IN_SUBLN_G(a) ((a).in[11])
#define IN_FINAL_G(a) ((a).in[12])
__device__ __forceinline__ float wave_sum(float v) {
#pragma unroll
    for (int o = 1; o < 64; o <<= 1) v += __shfl_xor(v, o);
    return v;
}
__device__ __forceinline__ void p0_transpose_item(const float* W, int K, int N, bf16* WT, int row_off, const float* gk, float cs, LAS float* scr, int item, int lane) {
    const int nblk = N / 32, kb = item / nblk, nb = item % nblk, k0 = 64 * kb, n0 = 32 * nb;
    const int kq = lane >> 3, n4 = (lane & 7) * 4;
#pragma unroll
    for (int i = 0; i < 8; ++i) { const int kk = 8 * i + kq; const float g = gk ? gk[k0 + kk] * cs : cs; const f32x4 w = *(const GAS f32x4*)(W + (size_t)(k0 + kk) * N + n0 + n4);
        LAS float* d = scr + kk * 33 + n4; d[0] = w.x * g; d[1] = w.y * g; d[2] = w.z * g; d[3] = w.w * g; }
    LDS_WAIT(); asm volatile("" ::: "memory");
    const int c = lane & 7;
#pragma unroll
    for (int j = 0; j < 4; ++j) { const int n = (lane >> 3) + 8 * j; const LAS float* s = scr + (8 * c) * 33 + n;
        v4u o; o.x = pk2(s[0 * 33], s[1 * 33]); o.y = pk2(s[2 * 33], s[3 * 33]); o.z = pk2(s[4 * 33], s[5 * 33]); o.w = pk2(s[6 * 33], s[7 * 33]);
        *(GAS v4u*)(WT + (size_t)(row_off + n0 + n) * K + k0 + 8 * c) = o; }
    LDS_WAIT(); asm volatile("" ::: "memory");
}
constexpr int I_IN = (DMODEL / 64) * (INW / 32), I_OUT = (DMODEL / 64) * (DMODEL / 32), I_MEM = (DMODEL / 64) * (512 / 32);
__device__ __forceinline__ void convert_item(Frame& F, const Args& A, int which, int l, int q, LAS float* scr) {
    if (which == 0) { const int nb = q % (INW / 32), n0 = nb * 32; const float cs = (n0 < MIXW || (n0 >= 3 * MIXW && n0 < 3 * MIXW + MEMW)) ? QSCALE : 1.0f;
        p0_transpose_item(IN_W_IN(A) + (size_t)l * DMODEL * INW, DMODEL, INW, (bf16*)(F.ws + WS_WIN) + (size_t)l * INW * DMODEL, 0, IN_NORM_G(A) + l * DMODEL, cs, scr, q, F.lane); }
    else if (which == 1) p0_transpose_item(IN_W_OUT(A) + (size_t)l * DMODEL * DMODEL, DMODEL, DMODEL, (bf16*)(F.ws + WS_WOUT) + (size_t)l * DMODEL * DMODEL, 0, nullptr, 1.0f, scr, q, F.lane);
    else p0_transpose_item(IN_W_MEM_KV(A) + (size_t)l * DMODEL * 512, DMODEL, 512, (bf16*)(F.ws + WS_WMEM), l * 512, IN_MEM_NORM_G(A) + l * DMODEL, 1.0f, scr, q, F.lane);
}
__device__ __forceinline__ void convert_deferred(Frame& F, const Args& A, int l, int worker, int nworkers) {
    LAS float* scr = (LAS float*)(F.lds + RING_OFF + F.wave * 16384);
    const int nitems = I_OUT + (l + 1 < DEPTH ? I_IN : 0);
    for (int it = worker; it < nitems; it += nworkers) { if (it < I_OUT) convert_item(F, A, 1, l, it, scr); else convert_item(F, A, 0, l + 1, it - I_OUT, scr); }
}
__device__ __forceinline__ void p0_prologue(Frame& F, const Args& A) {
    LAS float* scr = (LAS float*)(F.lds + RING_OFF + F.wave * 16384);
    const int gw = F.vcu * NWAVES + F.wave, NGW = F.G * NWAVES;
    constexpr int NITEMS = I_IN + DEPTH * I_MEM;
    for (int it = gw; it < NITEMS; it += NGW) { if (it < I_IN) convert_item(F, A, 0, 0, it, scr); else convert_item(F, A, 2, (it - I_IN) / I_MEM, (it - I_IN) % I_MEM, scr); }
    bf16* xb = (bf16*)(F.ws + WS_XB); float* ssq = (float*)(F.ws + WS_SSQ);
    for (int m = gw; m < MROWS; m += NGW) {
        const GAS f32x4* xr = (const GAS f32x4*)(IN_X(A) + (size_t)m * DMODEL) + F.lane;
        GAS unsigned long long* o8 = (GAS unsigned long long*)(xb + (size_t)m * DMODEL) + F.lane;
        float s = 0.f;
#pragma unroll
        for (int j = 0; j < 4; ++j) { const f32x4 v = xr[64 * j]; s += (v.x * v.x + v.y * v.y) + (v.z * v.z + v.w * v.w);
            o8[64 * j] = (unsigned long long)pk2(v.x, v.y) | ((unsigned long long)pk2(v.z, v.w) << 32); }
        s = wave_sum(s);
        if (F.lane < 16) ssq[(size_t)m * 16 + F.lane] = (F.lane == 0) ? s : 0.f;
    }
    bf16* memn = (bf16*)(F.ws + WS_MEMN);
    for (int m = gw; m < BATCH * NMEM; m += NGW) {
        const GAS f32x4* xr = (const GAS f32x4*)(IN_MEM(A) + (size_t)m * DMODEL) + F.lane;
        GAS unsigned long long* o8 = (GAS unsigned long long*)(memn + (size_t)m * DMODEL) + F.lane;
        f32x4 v[4]; float s = 0.f;
#pragma unroll
        for (int j = 0; j < 4; ++j) { v[j] = xr[64 * j]; s += (v[j].x * v[j].x + v[j].y * v[j].y) + (v[j].z * v[j].z + v[j].w * v[j].w); }
        const float rstd = 1.0f / sqrtf(wave_sum(s) * (1.0f / DMODEL) + RMS_EPS);
#pragma unroll
        for (int j = 0; j < 4; ++j) o8[64 * j] = (unsigned long long)pk2(v[j].x * rstd, v[j].y * rstd) | ((unsigned long long)pk2(v[j].z * rstd, v[j].w * rstd) << 32);
    }
    if (gw == 1) { float* nz = (float*)(F.ws + WS_NRM); for (int i = F.lane; i < DEPTH * 96; i += 64) nz[i] = 0.f; }
    if (gw == 0) {
        const float a = wave_sum(IN_LQ1(A)[F.lane] * IN_LK1(A)[F.lane]), b = wave_sum(IN_LQ2(A)[F.lane] * IN_LK2(A)[F.lane]);
        const float lam_init = 0.8f - 0.6f * expf(-0.3f * 2.0f);
        if (F.lane == 0) ((float*)(F.ws + WS_MISC))[0] = expf(a) - expf(b) + lam_init;
    }
}
__device__ __forceinline__ float diff_lambda_init() { return 0.8f - 0.6f * expf(-0.3f * 2.0f); }

__device__ __forceinline__ void unit_mem(Frame& F, int layer, int un) {
    using namespace att;
    const int hm = un & 3, rb = un >> 2;
    const int r32 = F.lane & 31, hi = F.lane >> 5;
    const int row0 = rb * 256 + F.wave * 32, b = rb >> 5;
    const bf16_t* qm = (const bf16_t*)(F.ws + WS_QM);
    const bf16_t* kv = (const bf16_t*)(F.ws + WS_MEMKV) + (size_t)(b * NMEM) * 2048 + layer * 512 + hm * 64;
    bf16x8 qr[4]; load_q(qr, qm + (size_t)(row0 + r32) * MEMW + hm * 64, hi);
    f32x16 o[2]; o[0] = f32x16{}; o[1] = f32x16{}; float m_run = NEG_INF, l_run = 0.f;
    BMNone bm;
    flash_loop<64>((lptr)(F.lds + RING_OFF), qr, kv, kv + 256, 2048, 2048, 3, 0, bm, o, m_run, l_run);
    bf16_t* yg = (bf16_t*)(F.ws + WS_GATE) + (size_t)row0 * DMODEL + MIXW + hm * 64;
    finish_unit<64, true>((lptr)(F.lds + RING_OFF), o, m_run, l_run, [=](int i) { return yg + (size_t)i * DMODEL; });
}
__device__ __forceinline__ void unit_dsw(Frame& F, int un) {
    using namespace att;
    const int x = un & 31, hh = (un >> 5) % 12, b = un / 384;
    const int g = hh >> 2, sh = 2 * g, dil = 1 << sh, U = SEQ >> sh, nb = U >> 8;
    const int res = x / nb, ub = x % nb;
    const int r32 = F.lane & 31, hi = F.lane >> 5;
    const size_t seq0 = (size_t)b * SEQ + (size_t)res * U;
    const int qlo = ub * 256 + F.wave * 32, qpos = qlo + r32;
    const bf16_t* Q = (const bf16_t*)(F.ws + WS_Q) + seq0 * MIXW + hh * 64;
    const bf16_t* K = (const bf16_t*)(F.ws + WS_K) + seq0 * MIXW + hh * 64;
    const bf16_t* V = (const bf16_t*)(F.ws + WS_V) + seq0 * MIXW + hh * 64;
    bf16x8 qr[4]; load_q(qr, Q + (size_t)qpos * MIXW, hi);
    f32x16 o[2]; o[0] = f32x16{}; o[1] = f32x16{}; float m_run = NEG_INF, l_run = 0.f;
    BMBand bm; bm.init(qpos, qlo, 128, alibi2(hh, 12) * (float)dil, hi);
    const int t_hi = ub * 4 + 3, t_lo = (ub * 4 - 2) > 0 ? (ub * 4 - 2) : 0;
    flash_loop<64, att::BMBand, true>((lptr)(F.lds + RING_OFF), qr, K, V, MIXW, MIXW, t_hi, t_lo, bm, o, m_run, l_run);
    bf16_t* mix = (bf16_t*)(F.ws + WS_MIX) + ((size_t)b * SEQ) * MIXW + hh * 64;
    const float l2 = finish_unit<64, false>((lptr)(F.lds + RING_OFF), o, m_run, l_run, [=](int i) { return mix + (size_t)(((qlo + i) << sh) + res) * MIXW; });
    if (hi == 0) ((float*)(F.ws + WS_LSE))[((size_t)b * SEQ + ((size_t)qpos << sh) + res) * 12 + hh] = l2;
}
__device__ __forceinline__ int skip_first_tile(Frame& F, int layer, int b, int stream, float slope2, int q_first) {
    const float* nr = (const float*)(F.ws + WS_NRM) + layer * 96 + b * 48 + 2 * stream;
    const float qn2 = nr[0] + nr[1], kn2 = nr[24] + nr[25];
    const float S = sqrtf(qn2 * kn2) * 1.02f + 0.5f;
    const float dskip = (160.0f + 2.0f * S) / slope2 + 1.0f;
    const float kminf = (float)q_first - dskip;
    return kminf <= 0.f ? 0 : (((int)kminf) >> 6);
}
__device__ __forceinline__ void unit_moba(Frame& F, int layer, int b, int h, int qb) {
    using namespace att;
    const int r32 = F.lane & 31, hi = F.lane >> 5;
    const lptr L = (lptr)(F.lds + RING_OFF);
    const size_t seq0 = (size_t)b * SEQ;
    const int qlo = qb * 256 + F.wave * 32, qpos = qlo + r32;
    const bf16_t* Q = (const bf16_t*)(F.ws + WS_Q) + seq0 * MIXW + h * 64;
    const bf16_t* K = (const bf16_t*)(F.ws + WS_K) + seq0 * MIXW + h * 64;
    const bf16_t* V = (const bf16_t*)(F.ws + WS_V) + seq0 * MIXW + h * 64;
    bf16x8 qr[4]; load_q(qr, Q + (size_t)qpos * MIXW, hi);
    unsigned sel = (qb >= 3) ? 7u : ((1u << qb) - 1u);
    if (qb > 3) {
        { const int j = F.tid >> 4, d4 = (F.tid & 15) * 4; const float* kp_ = (const float*)(F.ws + WS_KPART) + (size_t)((b * 32 + j) * 2) * MIXW + h * 64 + d4;
          const f32x4 a = *(const f32x4*)kp_, c = *(const f32x4*)(kp_ + MIXW);
          *(LAS f32x4*)(L + L_KM + (j * 64 + d4) * 4) = (a + c) * (1.0f / 256.0f); }
        asm volatile("s_waitcnt lgkmcnt(0)\n\ts_barrier" ::: "memory");
        float qf[32];
#pragma unroll
        for (int d0 = 0; d0 < 4; ++d0)
#pragma unroll
            for (int e = 0; e < 8; ++e) qf[d0 * 8 + e] = __uint_as_float(((unsigned)(unsigned short)qr[d0][e]) << 16);
        float v1 = NEG_INF, v2 = NEG_INF, v3 = NEG_INF; int i1 = 0, i2 = 0, i3 = 0;
        for (int j = 0; j < qb; ++j) {
            const LAS f32x4* km = (const LAS f32x4*)(L + L_KM + (j * 64 + 8 * hi) * 4);
            float gsum = 0.f;
#pragma unroll
            for (int d0 = 0; d0 < 4; ++d0) { const f32x4 k0 = km[d0 * 4], k1 = km[d0 * 4 + 1];
                gsum += qf[d0 * 8 + 0] * k0[0] + qf[d0 * 8 + 1] * k0[1] + qf[d0 * 8 + 2] * k0[2] + qf[d0 * 8 + 3] * k0[3] + qf[d0 * 8 + 4] * k1[0] + qf[d0 * 8 + 5] * k1[1] + qf[d0 * 8 + 6] * k1[2] + qf[d0 * 8 + 7] * k1[3]; }
            const float gt = gsum + swap_half(gsum);
            if (gt > v1) { v3 = v2; i3 = i2; v2 = v1; i2 = i1; v1 = gt; i1 = j; }
            else if (gt > v2) { v3 = v2; i3 = i2; v2 = gt; i2 = j; }
            else if (gt > v3) { v3 = gt; i3 = j; }
        }
        sel = (1u << i1) | (1u << i2) | (1u << i3);
    }
    f32x16 o[2]; o[0] = f32x16{}; o[1] = f32x16{}; float m_run = NEG_INF, l_run = 0.f;
    BMMoba bm; bm.band.init(qpos, qlo, 1 << 20, alibi2(h, 12), hi); bm.sel = sel; bm.qb = qb;
    flash_loop<64>(L, qr, K, V, MIXW, MIXW, qb * 4 + 3, skip_first_tile(F, layer, b, h, alibi2(h, 12), qb * 256), bm, o, m_run, l_run);
    bf16_t* yg = (bf16_t*)(F.ws + WS_GATE) + (seq0 + qlo) * DMODEL + h * 64;
    finish_unit<64, true>(L, o, m_run, l_run, [=](int i) { return yg + (size_t)i * DMODEL; });
}
__device__ __forceinline__ void unit_diff(Frame& F, int layer, int b, int h, int mp, int qb) {
    using namespace att;
    const int r32 = F.lane & 31, hi = F.lane >> 5;
    const lptr L = (lptr)(F.lds + RING_OFF);
    const size_t seq0 = (size_t)b * SEQ;
    const int qlo = qb * 256 + F.wave * 32, qpos = qlo + r32;
    const bf16_t* Q = (const bf16_t*)(F.ws + WS_Q) + seq0 * MIXW + (h * 2 + mp) * 64;
    const bf16_t* K = (const bf16_t*)(F.ws + WS_K) + seq0 * MIXW + (h * 2 + mp) * 64;
    const bf16_t* V = (const bf16_t*)(F.ws + WS_V) + seq0 * MIXW + h * 128;
    bf16x8 qr[4]; load_q(qr, Q + (size_t)qpos * MIXW, hi);
    f32x16 o[4]; o[0] = f32x16{}; o[1] = f32x16{}; o[2] = f32x16{}; o[3] = f32x16{}; float m_run = NEG_INF, l_run = 0.f;
    BMBand bm; bm.init(qpos, qlo, 1 << 20, alibi2(h, 6), hi);
#if PROBE_OUT
    const int tl_ = skip_first_tile(F, layer, b, h * 2 + mp, alibi2(h, 6), qb * 256);
    const unsigned long long c0_ = __builtin_amdgcn_s_memtime(), r0_ = __builtin_amdgcn_s_memrealtime();
    flash_loop<128>(L, qr, K, V, MIXW, MIXW, qb * 4 + 3, tl_, bm, o, m_run, l_run);
    const unsigned long long c1_ = __builtin_amdgcn_s_memtime(), r1_ = __builtin_amdgcn_s_memrealtime();
    if (b == 0 && h == 5 && mp == 0 && qb == 31 && F.tid == 0) {
        const float steps = (float)(qb * 4 + 3 - tl_ + 2);
        float* pm = (float*)(F.ws + WS_MISC);
        pm[4] = (float)(c1_ - c0_) / steps;
        pm[5] = (float)(c1_ - c0_) / (float)(r1_ - r0_) * 0.1f;
        pm[6] = steps;
    }
#else
    flash_loop<128>(L, qr, K, V, MIXW, MIXW, qb * 4 + 3, skip_first_tile(F, layer, b, h * 2 + mp, alibi2(h, 6), qb * 256), bm, o, m_run, l_run);
#endif
    bf16_t* od = (bf16_t*)(F.ws + WS_MIX) + (seq0 + qlo) * 1536 + (h * 2 + mp) * 128;
    finish_unit<128, false>(L, o, m_run, l_run, [=](int i) { return od + (size_t)i * 1536; });
}
__device__ __forceinline__ void phase_attn(Frame& F, int layer, int rep) {
    const int kind = layer % 3, G = F.G, v = F.vcu;
    if (kind == 0) {
#ifndef DIS_DSW
        for (int un = v; un < 768 + 256; un += G) { if (un < 768) unit_dsw(F, un); else unit_mem(F, layer, un - 768); }
#endif
    } else {
        volatile LAS unsigned* MISC = (volatile LAS unsigned*)(F.lds + MISC_OFF);
        const int x0 = (int)(xb_xcc_id() & 7u);
        gu32* ctr0 = (gu32*)(F.ws + WS_CTL) + CW_QUEUE + 64 * (layer * 8 + 32 * rep);
        int qi = 0;
        for (int it = 0;; ++it) {
            if (F.tid == 0) {
                unsigned code = 0xffffffffu; int q = qi;
                for (; q < 8; ++q) { const int x = (x0 + q) & 7; const unsigned idx = __hip_atomic_fetch_add(ctr0 + 64 * x, 1u, __ATOMIC_RELAXED, __HIP_MEMORY_SCOPE_AGENT); if (idx < 96u + 32u) { code = ((unsigned)q << 8) | idx; break; } }
                MISC[12 + (it & 1)] = code;
            }
            asm volatile("s_waitcnt vmcnt(0) lgkmcnt(0)\n\ts_barrier" ::: "memory");
            const unsigned code = MISC[12 + (it & 1)];
            if (code == 0xffffffffu) break;
            qi = (int)(code >> 8); const int idx = (int)(code & 0xffu), x = (x0 + qi) & 7, b = x >> 2, j = x & 3;
            if (idx < 96) { const int sl = idx >> 5, qb = 31 - (idx & 31);
#ifndef DIS_MOBA
                if (kind == 1) { const int h = sl == 0 ? 8 + j : (sl == 1 ? 7 - j : j); unit_moba(F, layer, b, h, qb); }
                else
#endif
#ifndef DIS_DIFF
                { const int h = sl == 0 ? 4 + (j >> 1) : (sl == 1 ? 3 - (j >> 1) : (j >> 1)), mp = j & 1; unit_diff(F, layer, b, h, mp, qb); }
#else
                {}
#endif
            }
#ifndef DIS_MEM
            else unit_mem(F, layer, x * 32 + (idx - 96));
#endif
        }
    }
}
__device__ __forceinline__ float bf2f(unsigned short u) { return __uint_as_float(((unsigned)u) << 16); }
__device__ __forceinline__ void phase_finalize(Frame& F, const Args& A, int layer) {
    typedef unsigned short us8 __attribute__((ext_vector_type(8)));
    const int kind = layer % 3, gw = F.vcu * NWAVES + F.wave, NGW = F.G * NWAVES, lane = F.lane;
    bf16* gate = (bf16*)(F.ws + WS_GATE);
    const bf16* mix = (const bf16*)(F.ws + WS_MIX);
    const float* lse = (const float*)(F.ws + WS_LSE);
    const float lam = ((const float*)(F.ws + WS_MISC))[0], lam_scale = 1.0f - diff_lambda_init();
    for (int m = gw; m < MROWS; m += NGW) {
        float v[16];
        if (lane < 48) {
            if (kind == 2) {
                const int h = lane >> 3, dd = (lane & 7) * 16;
                const us8* p1 = (const us8*)(mix + (size_t)m * 1536 + h * 256 + dd); const us8* p2 = (const us8*)(mix + (size_t)m * 1536 + h * 256 + 128 + dd);
                const us8 a0 = p1[0], a1 = p1[1], b0 = p2[0], b1 = p2[1];
#pragma unroll
                for (int e = 0; e < 8; ++e) { v[e] = bf2f(a0[e]) - lam * bf2f(b0[e]); v[8 + e] = bf2f(a1[e]) - lam * bf2f(b1[e]); }
            } else {
                const us8* p1 = (const us8*)(mix + (size_t)m * MIXW + lane * 16); const us8 a0 = p1[0], a1 = p1[1];
#pragma unroll
                for (int e = 0; e < 8; ++e) { v[e] = bf2f(a0[e]); v[8 + e] = bf2f(a1[e]); }
            }
        } else {
#pragma unroll
            for (int e = 0; e < 16; ++e) v[e] = 0.f;
        }
        float sc = 1.0f;
        if (kind == 2) {
            float ss = 0.f;
#pragma unroll
            for (int e = 0; e < 16; ++e) ss += v[e] * v[e];
            ss += __shfl_xor(ss, 1); ss += __shfl_xor(ss, 2); ss += __shfl_xor(ss, 4);
            sc = lam_scale / sqrtf(ss * (1.0f / 128.0f) + SUBLN_EPS);
            if (lane < 48) { const float* sg = IN_SUBLN_G(A) + (lane & 7) * 16;
#pragma unroll
                for (int e = 0; e < 16; ++e) v[e] *= sg[e]; }
            else sc = 1.0f;
        } else if (kind == 0 && lane < 48) {
            const int hh = lane >> 2, j = hh & 3, g = hh >> 2;
            const float* lr = lse + (size_t)m * 12;
            const float l0 = lr[j], l1 = lr[4 + j], l2 = lr[8 + j], mx = fmaxf(fmaxf(l0, l1), l2);
            const float e0 = exp2f(l0 - mx), e1 = exp2f(l1 - mx), e2 = exp2f(l2 - mx);
            sc = (g == 0 ? e0 : (g == 1 ? e1 : e2)) / (e0 + e1 + e2);
        }
        if (lane >= 48) continue;
        us8* gp = (us8*)(gate + (size_t)m * DMODEL + lane * 16);
        const us8 g0 = gp[0], g1 = gp[1]; us8 y0, y1;
#pragma unroll
        for (int e = 0; e < 8; ++e) {
            const float ga = bf2f(g0[e]), gb = bf2f(g1[e]);
            const float sa = ga / (1.0f + exp2f(-ga * LOG2E)), sb = gb / (1.0f + exp2f(-gb * LOG2E));
            y0[e] = (unsigned short)f2bf(v[e] * sc * sa); y1[e] = (unsigned short)f2bf(v[8 + e] * sc * sb);
        }
        gp[0] = y0; gp[1] = y1;
    }
}
__device__ __forceinline__ void phase_final_norm(Frame& F, const Args& A) {
    const int gw = F.vcu * NWAVES + F.wave, NGW = F.G * NWAVES;
    const float* ssq = (const float*)(F.ws + WS_SSQ);
    for (int m = gw; m < MROWS; m += NGW) {
        GAS f32x4* xr = (GAS f32x4*)(A.out + (size_t)m * DMODEL) + F.lane;
        const float p = (F.lane < 16) ? ssq[(size_t)m * 16 + F.lane] : 0.f;
        const float rstd = 1.0f / sqrtf(wave_sum(p) * (1.0f / DMODEL) + RMS_EPS);
#pragma unroll
        for (int j = 0; j < 4; ++j) { const f32x4 g = *((const f32x4*)IN_FINAL_G(A) + F.lane + 64 * j); f32x4 v = xr[64 * j]; v = v * rstd * g; xr[64 * j] = v; }
#if PROBE_OUT
        if (m == 0 && F.lane == 0) { const float* pm = (const float*)(F.ws + WS_MISC); float pv = PROBE_OUT == 300 ? 8.f + floorf((float)(__builtin_amdgcn_s_memrealtime() - ((const unsigned long long*)(F.ws + WS_MISC + 1024))[0]) * 0.01f * 0.05f) - 60.f : PROBE_OUT >= 200 ? 8.f + floorf((float)(((const unsigned long long*)(F.ws + WS_MISC + 1024))[PROBE_OUT - 200] - ((const unsigned long long*)(F.ws + WS_MISC + 1024))[0]) * 0.01f * 0.02f) : PROBE_OUT >= 100 ? 8.f + floorf((float)(((const unsigned long long*)(F.ws + WS_MISC + 1024))[PROBE_OUT - 100 + 1] - ((const unsigned long long*)(F.ws + WS_MISC + 1024))[PROBE_OUT - 100]) * 0.01f * 0.2f) : PROBE_OUT >= 10 ? 8.f + floorf(pm[16 + PROBE_OUT - 10] * 0.1f) : PROBE_OUT == 1 ? 8.f + floorf(pm[4] * (1.0f / 200.0f)) : (PROBE_OUT == 2 ? floorf(pm[5] * 10.f) : pm[6] * 0.25f); A.out[0] = fminf(pv, 45.f); }
#endif
    }
}

__global__ void __launch_bounds__(NWAVES * 64, 2) trunk_fwd(Args args) {
    extern __shared__ __attribute__((aligned(16))) unsigned char lds[];
    Frame F;
    F.lds = (LAS unsigned char*)lds;
    volatile LAS unsigned* MISC = (volatile LAS unsigned*)(F.lds + MISC_OFF);
    F.tid = threadIdx.x; F.lane = F.tid & 63; F.wave = __builtin_amdgcn_readfirstlane(F.tid >> 6);
    F.G = gridDim.x; { const int bx = blockIdx.x; F.vcu = (F.G % 8 == 0) ? (bx % 8) * (F.G / 8) + bx / 8 : bx; }
    F.ws = args.ws;
    gu32* ctl = (gu32*)(F.ws + WS_CTL);
    for (int u = F.tid; u < (LDS_BYTES - LDSCTL_OFF) / 4; u += NWAVES * 64) ((LAS unsigned*)(F.lds + LDSCTL_OFF))[u] = 0u;
    __syncthreads();
    XcdBarrier bar; bar.bar = (unsigned*)(ctl + CW_BAR); bar.x = 0; bar.st = nullptr;
    if (!MK_PER_PHASE) bar = xcd_barrier_post((unsigned*)(ctl + CW_BAR), MISC + 8);
    const int lo = args.ph_lo, hi = args.ph_hi;
#define IN(k) (lo <= (k) && (k) < hi)
#if PROBE_OUT >= 100
#define PSTAMP_PH(k) do { if (blockIdx.x == 0 && threadIdx.x == 0) ((unsigned long long*)(F.ws + WS_MISC + 1024))[(k)] = __builtin_amdgcn_s_memrealtime(); } while (0)
#else
#define PSTAMP_PH(k) do {} while (0)
#endif
#define SEAM(k) do { if (IN(k) && IN((k) + 1)) xcd_barrier(bar); PSTAMP_PH((k) + 1); } while (0)

        PSTAMP_PH(0);
#ifndef DIS_P0
    if (IN(0)) { p0_prologue(F, args);
#if PROBE_DUP & 4
        __syncthreads(); p0_prologue(F, args);
#endif
    }
#endif
    SEAM(0);
#define FRESH_TID() do { int t_ = threadIdx.x; asm volatile("" : "+v"(t_)); F.tid = t_; F.lane = t_ & 63; F.wave = __builtin_amdgcn_readfirstlane(t_ >> 6); } while (0)
    for (int layer = 0; layer < DEPTH; ++layer) {
        const int pb = 1 + 4 * layer, kind = layer % 3;
#ifndef DIS_GIN
        if (IN(pb)) for (int rep_ = 0; rep_ < (((PROBE_DUP & 1) && ((PROBE_LAYERS >> layer) & 1)) ? 2 : 1); ++rep_) {
#ifndef DIS_INP
            { pg8::Gemm g{(const pg8::bf16_t*)(F.ws + WS_XB), (const pg8::bf16_t*)(F.ws + WS_WIN) + (size_t)layer * INW * DMODEL, MROWS, INW, DMODEL};
              pg8::StaticOrder S; S.init(MROWS, INW, F.G, (int)blockIdx.x);
              pg8::EpiIn E{F.ws, kind, layer};
              pg8::gemm_phase<pg8::EpiIn, pg8::StaticOrder, true, true>(F.lds + RING_OFF, g, S, E); }
#endif
#ifndef DIS_MEMKV
            if (layer == 0) {
              pg8::Gemm g{(const pg8::bf16_t*)(F.ws + WS_MEMN), (const pg8::bf16_t*)(F.ws + WS_WMEM), BATCH * NMEM, DEPTH * 512, DMODEL};
              pg8::TailOrder S{2, 8, F.G, (int)blockIdx.x};
              pg8::EpiPlain E{(pg8::bf16_t*)(F.ws + WS_MEMKV), DEPTH * 512};
              pg8::gemm_phase<pg8::EpiPlain, pg8::TailOrder, true, true>(F.lds + RING_OFF, g, S, E); }
#endif
            if (rep_ == 0) {
                FRESH_TID();
                const int c = (int)blockIdx.x;
                if (F.G == 256) { const int hi_c = (layer == 0) ? 240 : 256; if (c >= 128 && c < hi_c) convert_deferred(F, args, layer, (c - 128) * NWAVES + F.wave, (hi_c - 128) * NWAVES); }
                else convert_deferred(F, args, layer, c * NWAVES + F.wave, F.G * NWAVES);
            }
        }
#endif
        SEAM(pb);
#ifndef DIS_ATT
        if (IN(pb + 1)) for (int rep_ = 0; rep_ < (((PROBE_DUP & 2) && ((PROBE_LAYERS >> layer) & 1)) ? 2 : 1); ++rep_) { FRESH_TID();
#if PROBE_OUT >= 10
            const unsigned long long r0_ = __builtin_amdgcn_s_memrealtime();
#endif
            phase_attn(F, layer, rep_);
#if PROBE_OUT >= 10
            if (blockIdx.x == 0 && F.tid == 0) ((float*)(F.ws + WS_MISC))[16 + layer] = (float)(__builtin_amdgcn_s_memrealtime() - r0_) * 0.01f;
#endif
        }
#endif
        SEAM(pb + 1);
#ifndef DIS_FIN
        if (IN(pb + 2) && kind != 1) { FRESH_TID(); phase_finalize(F, args, layer); }
#endif
        if (kind != 1) SEAM(pb + 2);
#ifndef DIS_GOUT
        if (IN(pb + 3)) for (int rep_ = 0; rep_ < (((PROBE_DUP & 8) && layer == 0) ? 2 : 1); ++rep_) {
            pg8::Gemm g{(const pg8::bf16_t*)(F.ws + WS_GATE), (const pg8::bf16_t*)(F.ws + WS_WOUT) + (size_t)layer * DMODEL * DMODEL, MROWS, DMODEL, DMODEL};
            pg8::StaticOrder S; S.init(MROWS, DMODEL, F.G, (int)blockIdx.x);
            pg8::EpiOut E{layer == 0 ? IN_X(args) : args.out, args.out, (pg8::bf16_t*)(F.ws + WS_XB), (float*)(F.ws + WS_SSQ), layer + 1 < DEPTH ? 1 : 0};
            pg8::gemm_phase<pg8::EpiOut, pg8::StaticOrder, true, true>(F.lds + RING_OFF, g, S, E);
        }
#endif
        SEAM(pb + 3);
    }
    if (IN(NPHASES - 1)) { FRESH_TID(); phase_final_norm(F, args); }
#undef IN
#undef SEAM
}

extern "C" void kernel_launch(void* const* d_in, const int* in_sizes, int n_in, void* d_out, int out_size, void* d_ws, size_t ws_size, hipStream_t stream) {
    static int grid = 0;
    if (grid == 0) {
        if (n_in != 13 || out_size != MROWS * DMODEL || ws_size < WS_END) { fprintf(stderr, "kernel_launch: unexpected problem shape (n_in %d, out %d, ws %zu); nothing launched\n", n_in, out_size, ws_size); grid = -1; return; }
        int dev = 0, cus = 0, per_cu = 0;
        if (hipGetDevice(&dev) != hipSuccess || hipDeviceGetAttribute(&cus, hipDeviceAttributeMultiprocessorCount, dev) != hipSuccess) { grid = -1; return; }
        if (hipFuncSetAttribute((const void*)trunk_fwd, hipFuncAttributeMaxDynamicSharedMemorySize, LDS_BYTES) != hipSuccess) { fprintf(stderr, "kernel_launch: hipFuncSetAttribute failed\n"); grid = -1; return; }
        if (hipOccupancyMaxActiveBlocksPerMultiprocessor(&per_cu, (const void*)trunk_fwd, NWAVES * 64, LDS_BYTES) != hipSuccess || per_cu < 1) { fprintf(stderr, "kernel_launch: occupancy query says %d workgroups per CU\n", per_cu); per_cu = 1; }
        (void)hipGetLastError();
        grid = cus;
    }
    if (grid < 0) return;
    if (hipMemsetAsync((char*)d_ws + WS_CTL, 0, CTL_USED_BYTES, stream) != hipSuccess) { fprintf(stderr, "kernel_launch: hipMemsetAsync failed\n"); return; }
    Args a{};
    for (int i = 0; i < 13; ++i) a.in[i] = (const float*)d_in[i];
    a.out = (float*)d_out; a.ws = (unsigned char*)d_ws;
#if MK_PER_PHASE
    for (int p = 0; p < NPHASES; ++p) { a.ph_lo = p; a.ph_hi = p + 1; a.li = p; hipLaunchKernelGGL(trunk_fwd, dim3(grid), dim3(NWAVES * 64), LDS_BYTES, stream, a); }
#else
    a.ph_lo = 0; a.ph_hi = NPHASES; a.li = 0;
    hipLaunchKernelGGL(trunk_fwd, dim3(grid), dim3(NWAVES * 64), LDS_BYTES, stream, a);
#endif
    const hipError_t le = hipPeekAtLastError();
    if (le != hipSuccess) fprintf(stderr, "kernel_launch: launch failed: %s\n", hipGetErrorName(le));
}
```

```cpp
#include <hip/hip_runtime.h>
#include <hip/hip_bf16.h>
#include <cstdio>
#include <cstdint>
#include <cmath>

#ifndef MK_PER_PHASE
#define MK_PER_PHASE 0
#endif

#ifndef PROBE_WORK
#define PROBE_WORK 0
#endif
#ifndef PROBE_OUT
#define PROBE_OUT 0
#endif
#ifndef PROBE_LAYERS
#define PROBE_LAYERS 15
#endif
#ifndef PROBE_DUP
#define PROBE_DUP 0
#endif
constexpr int BATCH = 2, SEQ = 8192, DMODEL = 1024, DEPTH = 4, MROWS = BATCH * SEQ;
constexpr int MIXW = 768, MEMW = 256, NMEM = 256, INW = 3584;
constexpr float RMS_EPS = 1e-6f, SUBLN_EPS = 1e-5f;
constexpr float LOG2E = 1.4426950408889634f;
constexpr float QSCALE = 0.125f * LOG2E;
constexpr size_t MiB = 1u << 20;
constexpr size_t WS_CTL = 0, CTL_ZERO_BYTES = 1 * MiB;
constexpr size_t WS_WIN = 1 * MiB;
constexpr size_t WS_WOUT = 29 * MiB;
constexpr size_t WS_WMEM = 37 * MiB;
constexpr size_t WS_XB = 41 * MiB;
constexpr size_t WS_Q = 73 * MiB, WS_K = 97 * MiB, WS_V = 121 * MiB;
constexpr size_t WS_QM = 145 * MiB;
constexpr size_t WS_GATE = 153 * MiB;
constexpr size_t WS_MIX = 185 * MiB;
constexpr size_t WS_MO = 233 * MiB;
constexpr size_t WS_MEMN = 241 * MiB;
constexpr size_t WS_MEMKV = 242 * MiB;
constexpr size_t WS_LSE = 244 * MiB;
constexpr size_t WS_SSQ = 245 * MiB;
constexpr size_t WS_KPART = 246 * MiB;
constexpr size_t WS_MISC = 247 * MiB;
constexpr size_t WS_NRM = 247 * MiB + 4096;
constexpr size_t WS_END = 248 * MiB;
constexpr size_t CTL_USED_BYTES = 64 * 1024;
constexpr int CW_QUEUE = 8192;
constexpr int CW_BAR = 4096;
namespace pg8 {
#define PG8_LAS __attribute__((address_space(3)))
typedef unsigned short bf16_t;
typedef short bf16x8 __attribute__((ext_vector_type(8)));
typedef float f32x4 __attribute__((ext_vector_type(4)));
typedef unsigned u32x4 __attribute__((ext_vector_type(4)));
constexpr int BM = 256, BK = 64, HALF = 128, HTB = HALF * BK * 2  , STAGE_BYTES = 8 * HTB, NXCD = 8, WGM = 2;

__host__ __device__ __forceinline__ int lds_byte(int r, int c) { const int st = (r >> 4) * 2 + (c >> 5), rr = r & 15, cc = c & 31, ob = rr * 64 + cc * 2; return st * 1024 + (ob ^ (((ob >> 9) & 1) << 5)); }
__host__ __device__ __forceinline__ void stage_rc(int b, int& R, int& C) { const int st = b / 1024, sb = b % 1024, swz = sb ^ (((sb >> 9) & 1) << 5); R = (st >> 1) * 16 + swz / 64; C = (st & 1) * 32 + (swz % 64) / 2; }
__host__ __device__ __forceinline__ int perm32(int rho) { const int n = rho >> 4, i = rho & 15; return 8 * (i >> 2) + 4 * n + (i & 3); }

struct Unit { int pm, pn; };
struct Gemm { const bf16_t* A; const bf16_t* Bt; int M, N, K; };

struct StaticOrder {
    int nM, nN, nwg, G, c;
    __host__ __device__ void init(int M, int N, int G_, int c_) { nM = M / BM; nN = N / BM; nwg = nM * nN; G = G_; c = c_; }
    __host__ __device__ bool next(int i, Unit& u) const {
        const long L = (long)i * G + c; if (L >= nwg) return false;
        int wgid = (int)L; { const int q = nwg / NXCD, r = nwg % NXCD, xcd = wgid % NXCD, off = wgid / NXCD; wgid = (xcd < r ? xcd * (q + 1) : r * (q + 1) + (xcd - r) * q) + off; }
        const int nig = WGM * nN, gid = wgid / nig, fm = gid * WGM, gsz = (nM - fm) < WGM ? (nM - fm) : WGM;
        u.pm = fm + ((wgid % nig) % gsz); u.pn = (wgid % nig) / gsz; return true;
    }
    __device__ __forceinline__ void a_ready(const Unit&) const {}
    __device__ __forceinline__ void done(const Unit&) const {}
};

typedef float f32x2 __attribute__((ext_vector_type(2)));
typedef __bf16 bf16x2_t __attribute__((ext_vector_type(2)));
typedef unsigned u32x2 __attribute__((ext_vector_type(2)));
__device__ __forceinline__ unsigned cvt_pk_bf16(float lo, float hi) { f32x2 v = {lo, hi}; bf16x2_t b = __builtin_convertvector(v, bf16x2_t); return __builtin_bit_cast(unsigned, b); }

struct EpiIn {
    static constexpr bool PERM = true, AFTER_DRAIN = false;
    unsigned char* ws; int kind, layer;
    __device__ __forceinline__ void operator()(const f32x4 (&acc)[2][2][4][2], const Unit& u, int wr, int wc, int fr, int fq) const {
        const int pn = u.pn;
        size_t boff; int ldc, colt, sh = 0;
        static_assert(WS_K - WS_Q == WS_V - WS_K, "q | k | v equally spaced");
        if (pn < 9) { const int sec = pn / 3, g = pn - 3 * sec; boff = WS_Q + (size_t)sec * (WS_K - WS_Q); ldc = MIXW; colt = g * 256; if (kind == 0) sh = 2 * g; }
        else if (pn == 9) { boff = WS_QM; ldc = MEMW; colt = 0; }
        else { boff = WS_GATE; ldc = DMODEL; colt = (pn - 10) * 256; }
        bf16_t* base = (bf16_t*)(ws + boff);
        const float* ssq = (const float*)(ws + WS_SSQ); float* kpart = (float*)(ws + WS_KPART);
        const int col0 = colt + wc * 32 + 8 * fq;
        const bool want_ksum = (kind == 1) && (pn >= 3) && (pn < 6);
#pragma unroll
        for (int ai = 0; ai < 2; ++ai)
#pragma unroll
            for (int m = 0; m < 4; ++m) {
                const int row = u.pm * BM + ai * HALF + wr * 64 + m * 16 + fr;
                const f32x4 sp = *(const f32x4*)(ssq + (size_t)row * 16 + 4 * fq);
                float s = (sp[0] + sp[1]) + (sp[2] + sp[3]);
                s += __shfl_xor(s, 16); s += __shfl_xor(s, 32);
                const float rstd = 1.0f / sqrtf(s * (1.0f / DMODEL) + RMS_EPS);
                int orow = row;
                if (sh) { const int b = row >> 13, t = row & (SEQ - 1); orow = (b << 13) + ((t & ((1 << sh) - 1)) << (13 - sh)) + (t >> sh); }
                bf16_t* rowp = base + (size_t)orow * ldc + col0;
#pragma unroll
                for (int bj = 0; bj < 2; ++bj) {
                    const f32x4 v0 = acc[ai][bj][m][0] * rstd, v1 = acc[ai][bj][m][1] * rstd;
                    u32x4 w; w.x = cvt_pk_bf16(v0[0], v0[1]); w.y = cvt_pk_bf16(v0[2], v0[3]); w.z = cvt_pk_bf16(v1[0], v1[1]); w.w = cvt_pk_bf16(v1[2], v1[3]);
                    *(u32x4*)(rowp + bj * HALF) = w;
                }
                if (m & 1) asm volatile("" ::: "memory");
            }
        if (kind != 0 && pn < 6) {
            float rs[2][4];
#pragma unroll
            for (int ai = 0; ai < 2; ++ai)
#pragma unroll
                for (int m = 0; m < 4; ++m) {
                    const int row = u.pm * BM + ai * HALF + wr * 64 + m * 16 + fr;
                    const f32x4 sp = *(const f32x4*)(ssq + (size_t)row * 16 + 4 * fq);
                    float s = (sp[0] + sp[1]) + (sp[2] + sp[3]);
                    s += __shfl_xor(s, 16); s += __shfl_xor(s, 32);
                    rs[ai][m] = 1.0f / sqrtf(s * (1.0f / DMODEL) + RMS_EPS);
                }
#pragma unroll
            for (int bj = 0; bj < 2; ++bj) {
                float mx = 0.f;
#pragma unroll
                for (int ai = 0; ai < 2; ++ai)
#pragma unroll
                    for (int m = 0; m < 4; ++m) {
                        const f32x4 v0 = acc[ai][bj][m][0] * rs[ai][m], v1 = acc[ai][bj][m][1] * rs[ai][m];
                        float q = ((v0[0] * v0[0] + v0[1] * v0[1]) + (v0[2] * v0[2] + v0[3] * v0[3])) + ((v1[0] * v1[0] + v1[1] * v1[1]) + (v1[2] * v1[2] + v1[3] * v1[3]));
                        q += __shfl_xor(q, 16); q += __shfl_xor(q, 32);
                        mx = fmaxf(mx, q);
                    }
                mx = fmaxf(mx, __shfl_xor(mx, 1)); mx = fmaxf(mx, __shfl_xor(mx, 2)); mx = fmaxf(mx, __shfl_xor(mx, 4)); mx = fmaxf(mx, __shfl_xor(mx, 8));
                if (fr == 0 && fq == 0) atomicMax((unsigned*)(ws + WS_NRM) + layer * 96 + ((u.pm >> 5) * 2 + pn / 3) * 24 + (pn % 3) * 8 + bj * 4 + wc, __float_as_uint(mx));
            }
            if (want_ksum) {
#pragma unroll
                for (int bj = 0; bj < 2; ++bj)
#pragma unroll
                    for (int n = 0; n < 2; ++n) {
                        f32x4 v = (f32x4){0.f, 0.f, 0.f, 0.f};
#pragma unroll
                        for (int ai = 0; ai < 2; ++ai)
#pragma unroll
                            for (int m = 0; m < 4; ++m) v += acc[ai][bj][m][n] * rs[ai][m];
#pragma unroll
                        for (int e = 0; e < 4; ++e) { float x = v[e]; x += __shfl_xor(x, 1); x += __shfl_xor(x, 2); x += __shfl_xor(x, 4); x += __shfl_xor(x, 8); v[e] = x; }
                        if (fr == 0) *(f32x4*)(kpart + (size_t)(u.pm * 2 + wr) * MIXW + (pn - 3) * 256 + bj * HALF + wc * 32 + 8 * fq + 4 * n) = v;
                    }
            }
        }
    }
};
struct EpiPlain {
    static constexpr bool PERM = true, AFTER_DRAIN = false;
    bf16_t* O; int ldc;
    __device__ __forceinline__ void operator()(const f32x4 (&acc)[2][2][4][2], const Unit& u, int wr, int wc, int fr, int fq) const {
        const int col0 = u.pn * BM + wc * 32 + 8 * fq;
#pragma unroll
        for (int ai = 0; ai < 2; ++ai)
#pragma unroll
            for (int m = 0; m < 4; ++m) {
                bf16_t* rowp = O + (size_t)(u.pm * BM + ai * HALF + wr * 64 + m * 16 + fr) * ldc + col0;
#pragma unroll
                for (int bj = 0; bj < 2; ++bj) {
                    const f32x4 v0 = acc[ai][bj][m][0], v1 = acc[ai][bj][m][1];
                    u32x4 w; w.x = cvt_pk_bf16(v0[0], v0[1]); w.y = cvt_pk_bf16(v0[2], v0[3]); w.z = cvt_pk_bf16(v1[0], v1[1]); w.w = cvt_pk_bf16(v1[2], v1[3]);
                    *(u32x4*)(rowp + bj * HALF) = w;
                }
            }
    }
};
struct EpiOut {
    static constexpr bool PERM = false, AFTER_DRAIN = false;
    const float* xin; float* xout; bf16_t* xb; float* ssq; int first, last;
    __device__ __forceinline__ void operator()(const f32x4 (&acc)[2][2][4][2], const Unit& u, int wr, int wc, int fr, int fq) const {
        const int col0 = u.pn * BM + wc * 32 + 4 * fq;
#pragma unroll
        for (int ai = 0; ai < 2; ++ai)
#pragma unroll
            for (int m = 0; m < 4; ++m) {
                const int row = u.pm * BM + ai * HALF + wr * 64 + m * 16 + fr;
                const size_t off = (size_t)row * DMODEL + col0;
                float s = 0.f;
#pragma unroll
                for (int bj = 0; bj < 2; ++bj)
#pragma unroll
                    for (int n = 0; n < 2; ++n) {
                        const size_t o = off + bj * HALF + n * 16;
                        f32x4 xo;
                        if (first) xo = *(const f32x4*)(xin + o);
                        else { const u32x2 w = *(const u32x2*)(xb + o); xo = (f32x4){__uint_as_float(w.x << 16), __uint_as_float(w.x & 0xffff0000u), __uint_as_float(w.y << 16), __uint_as_float(w.y & 0xffff0000u)}; }
                        const f32x4 v = xo + acc[ai][bj][m][n];
                        if (last) *(f32x4*)(xout + o) = v;
                        else { u32x2 w; w.x = cvt_pk_bf16(v[0], v[1]); w.y = cvt_pk_bf16(v[2], v[3]); *(u32x2*)(xb + o) = w; }
                        s += (v[0] * v[0] + v[1] * v[1]) + (v[2] * v[2] + v[3] * v[3]);
                    }
                s += __shfl_xor(s, 16); s += __shfl_xor(s, 32);
                if (fq == 0) ssq[(size_t)row * 16 + u.pn * 4 + wc] = s;
            }
    }
};
struct TailOrder {
    int nM, nN, G, c;
    __device__ bool next(int i, Unit& u) const { const int nwg = nM * nN; int idx = c - (G - nwg); if (G < nwg) idx = c; idx += i * G; if (idx < 0 || idx >= nwg || (i > 0 && G >= nwg)) return false; u.pm = idx % nM; u.pn = idx / nM; return true; }
    __device__ __forceinline__ void a_ready(const Unit&) const {}
    __device__ __forceinline__ void done(const Unit&) const {}
};
template <class Epi, class Sched, bool ALIGN_EPI = false, bool SP2 = false>
__device__ __forceinline__ void gemm_phase(PG8_LAS unsigned char* lds, const Gemm g, const Sched& S, const Epi& E) {
    int tid_ = threadIdx.x; asm volatile("" : "+v"(tid_));
    const int tid = tid_, wid = __builtin_amdgcn_readfirstlane(tid >> 6), lane = tid & 63, wr = wid >> 2, wc = wid & 3, fr = lane & 15, fq = lane >> 4;
    const int K = g.K, nt = K / BK;
    unsigned voffA[2], voffB[2];
#pragma unroll
    for (int i = 0; i < 2; ++i) { int R, C; stage_rc(tid * 16 + i * 8192, R, C); const int Rb = Epi::PERM ? ((R & ~31) + perm32(R & 31)) : R;
        voffA[i] = (unsigned)(R * K + C) * 2u; voffB[i] = (unsigned)(Rb * K + C) * 2u; }
    const size_t kstep = (size_t)(BK * 2);
    const size_t hstep = (size_t)HALF * K * 2;
    const size_t tstep = 2 * hstep;
    const unsigned ldsw = (unsigned)wid * 1024u;
    const int aoff = lds_byte(wr * 64 + fr, fq * 8), boff = lds_byte(wc * 32 + fr, fq * 8);
#define PG8_SA(b, h) (((b) * 2 + (h)) * HTB)
#define PG8_SB(b, h) ((4 + (b) * 2 + (h)) * HTB)
#define PG8_STAGE(bufoff, gbase, voff) do { _Pragma("unroll") for (int _i = 0; _i < 2; ++_i) \
        __builtin_amdgcn_global_load_lds((const unsigned*)((const char*)(gbase) + (voff)[_i]), (PG8_LAS unsigned*)(lds + (bufoff) + ldsw + _i * 8192), 16, 0, 0); } while (0)
#define PG8_LDA(dst, b, h) do { _Pragma("unroll") for (int m = 0; m < 4; ++m) _Pragma("unroll") for (int k = 0; k < 2; ++k) dst[m][k] = *(const PG8_LAS bf16x8*)(lds + PG8_SA(b, h) + aoff + m * 2048 + k * 1024); } while (0)
#define PG8_LDB(dst, b, h) do { _Pragma("unroll") for (int n = 0; n < 2; ++n) _Pragma("unroll") for (int k = 0; k < 2; ++k) dst[n][k] = *(const PG8_LAS bf16x8*)(lds + PG8_SB(b, h) + boff + n * 2048 + k * 1024); } while (0)
#define PG8_MMA(ai, bj, At, Bt) do { __builtin_amdgcn_s_setprio(1); _Pragma("unroll") for (int m = 0; m < 4; ++m) _Pragma("unroll") for (int n = 0; n < 2; ++n) _Pragma("unroll") for (int k = 0; k < 2; ++k) \
        acc[ai][bj][m][n] = __builtin_amdgcn_mfma_f32_16x16x32_bf16(Bt[n][k], At[m][k], acc[ai][bj][m][n], 0, 0, 0); __builtin_amdgcn_s_setprio(0); } while (0)
#define PG8_WAIT_V(n) asm volatile("s_waitcnt vmcnt(" #n ")" ::: "memory")
#define PG8_WAIT_L(n) asm volatile("s_waitcnt lgkmcnt(" #n ")" ::: "memory")
#define PG8_BAR __builtin_amdgcn_s_barrier()
#define PG8_SCHED __builtin_amdgcn_sched_barrier(0)
    Unit cur, nxt; int ui = 0;
    if (!S.next(0, cur)) return;
    f32x4 acc[2][2][4][2];
#pragma unroll
    for (int a = 0; a < 2; ++a)
#pragma unroll
        for (int b = 0; b < 2; ++b)
#pragma unroll
            for (int m = 0; m < 4; ++m)
#pragma unroll
                for (int n = 0; n < 2; ++n) acc[a][b][m][n] = (f32x4){0.f, 0.f, 0.f, 0.f};
    bf16x8 At[4][2], B0[2][2], B1[2][2];
    const char* cA = (const char*)g.A + (size_t)cur.pm * tstep; const char* cB = (const char*)g.Bt + (size_t)cur.pn * tstep;
    S.a_ready(cur);
    if constexpr (SP2) {
        PG8_STAGE(PG8_SB(0, 0), cB, voffB); PG8_STAGE(PG8_SB(0, 1), cB + hstep, voffB); PG8_STAGE(PG8_SA(0, 0), cA, voffA); PG8_STAGE(PG8_SA(0, 1), cA + hstep, voffA);
        if (wr == 1) PG8_BAR;
        PG8_WAIT_V(2); PG8_BAR;
        PG8_STAGE(PG8_SB(1, 0), cB + kstep, voffB); PG8_STAGE(PG8_SA(1, 0), cA + kstep, voffA); PG8_STAGE(PG8_SB(1, 1), cB + hstep + kstep, voffB);
        PG8_WAIT_V(6); PG8_BAR;
    } else {
        PG8_STAGE(PG8_SB(0, 0), cB, voffB); PG8_STAGE(PG8_SA(0, 0), cA, voffA); PG8_STAGE(PG8_SB(0, 1), cB + hstep, voffB); PG8_STAGE(PG8_SA(0, 1), cA + hstep, voffA);
        if (wr == 1) PG8_BAR;
        PG8_WAIT_V(4); PG8_BAR;
        PG8_STAGE(PG8_SB(1, 0), cB + kstep, voffB); PG8_STAGE(PG8_SA(1, 0), cA + kstep, voffA); PG8_STAGE(PG8_SB(1, 1), cB + hstep + kstep, voffB);
        PG8_WAIT_V(6); PG8_BAR;
    }
    for (;;) {
        const bool has_next = S.next(ui + 1, nxt);
        const char* nA = has_next ? (const char*)g.A + (size_t)nxt.pm * tstep : cA; const char* nB = has_next ? (const char*)g.Bt + (size_t)nxt.pn * tstep : cB;
        for (int t = 0; t < nt; t += 2) {
            const bool last = (t == nt - 2);
            const char* a1 = cA + (size_t)(t + 1) * kstep;
            const char* a2 = last ? nA : cA + (size_t)(t + 2) * kstep; const char* b2 = last ? nB : cB + (size_t)(t + 2) * kstep;
            const char* a3 = a2 + kstep; const char* b3 = b2 + kstep;
            if (last && has_next) S.a_ready(nxt);
            if constexpr (SP2) {
            PG8_LDB(B0, 0, 0); PG8_LDB(B1, 0, 1); PG8_SCHED; PG8_LDA(At, 0, 0); PG8_STAGE(PG8_SA(1, 1), a1 + hstep, voffA);
            PG8_WAIT_V(8); PG8_WAIT_L(0); PG8_BAR; PG8_MMA(0, 0, At, B0); PG8_MMA(0, 1, At, B1); PG8_BAR; PG8_SCHED;
            PG8_LDA(At, 0, 1); PG8_STAGE(PG8_SB(0, 0), b2, voffB); PG8_STAGE(PG8_SB(0, 1), b2 + hstep, voffB); PG8_STAGE(PG8_SA(0, 0), a2, voffA);
            PG8_WAIT_V(8); PG8_WAIT_L(0); PG8_BAR; PG8_MMA(1, 0, At, B0); PG8_MMA(1, 1, At, B1); PG8_BAR; PG8_SCHED;
            PG8_LDB(B0, 1, 0); PG8_LDB(B1, 1, 1); PG8_SCHED; PG8_LDA(At, 1, 0); PG8_STAGE(PG8_SA(0, 1), a2 + hstep, voffA);
            PG8_WAIT_V(8); PG8_WAIT_L(0); PG8_BAR; PG8_MMA(0, 0, At, B0); PG8_MMA(0, 1, At, B1); PG8_BAR; PG8_SCHED;
            PG8_LDA(At, 1, 1); PG8_STAGE(PG8_SB(1, 0), b3, voffB); PG8_STAGE(PG8_SB(1, 1), b3 + hstep, voffB); PG8_STAGE(PG8_SA(1, 0), a3, voffA);
            PG8_WAIT_V(8); PG8_WAIT_L(0); PG8_BAR; PG8_MMA(1, 0, At, B0); PG8_MMA(1, 1, At, B1); PG8_BAR; PG8_SCHED;
            } else {
            PG8_LDB(B0, 0, 0); PG8_SCHED; PG8_LDA(At, 0, 0); PG8_STAGE(PG8_SA(1, 1), a1 + hstep, voffA);
            PG8_WAIT_L(8); PG8_BAR; PG8_WAIT_L(0); PG8_MMA(0, 0, At, B0); PG8_BAR; PG8_SCHED;
            PG8_LDB(B1, 0, 1); PG8_STAGE(PG8_SB(0, 0), b2, voffB);
            PG8_BAR; PG8_WAIT_L(0); PG8_MMA(0, 1, At, B1); PG8_BAR;
            PG8_LDA(At, 0, 1); PG8_STAGE(PG8_SA(0, 0), a2, voffA);
            PG8_BAR; PG8_WAIT_L(0); PG8_MMA(1, 0, At, B0); PG8_BAR; PG8_SCHED;
            PG8_STAGE(PG8_SB(0, 1), b2 + hstep, voffB);
            PG8_WAIT_V(6); PG8_BAR; PG8_MMA(1, 1, At, B1); PG8_BAR;
            PG8_LDB(B0, 1, 0); PG8_SCHED; PG8_LDA(At, 1, 0); PG8_STAGE(PG8_SA(0, 1), a2 + hstep, voffA);
            PG8_WAIT_L(8); PG8_BAR; PG8_WAIT_L(0); PG8_MMA(0, 0, At, B0); PG8_BAR; PG8_SCHED;
            PG8_LDB(B1, 1, 1); PG8_STAGE(PG8_SB(1, 0), b3, voffB);
            PG8_BAR; PG8_WAIT_L(0); PG8_MMA(0, 1, At, B1); PG8_BAR;
            PG8_LDA(At, 1, 1); PG8_STAGE(PG8_SA(1, 0), a3, voffA);
            PG8_BAR; PG8_WAIT_L(0); PG8_MMA(1, 0, At, B0); PG8_BAR; PG8_SCHED;
            PG8_STAGE(PG8_SB(1, 1), b3 + hstep, voffB);
            PG8_WAIT_V(6); PG8_BAR; PG8_MMA(1, 1, At, B1); PG8_BAR;
            }
        }
        if constexpr (ALIGN_EPI) { if (wr == 0) PG8_BAR; }
        if constexpr (!Epi::AFTER_DRAIN) { E(acc, cur, wr, wc, fr, fq); S.done(cur); }
        if (!has_next) break;
#pragma unroll
        for (int a = 0; a < 2; ++a)
#pragma unroll
            for (int b = 0; b < 2; ++b)
#pragma unroll
                for (int m = 0; m < 4; ++m)
#pragma unroll
                    for (int n = 0; n < 2; ++n) acc[a][b][m][n] = (f32x4){0.f, 0.f, 0.f, 0.f};
        cur = nxt; cA = nA; cB = nB; ++ui;
        if constexpr (ALIGN_EPI) { if (wr == 1) PG8_BAR; }
    }
    PG8_WAIT_V(0);
    if constexpr (!ALIGN_EPI) { if (wr == 0) PG8_BAR; }
    PG8_BAR;
    if constexpr (Epi::AFTER_DRAIN) { E.fused(acc, cur, wr, wc, fr, fq, lds, wid, lane); S.done(cur); }
#undef PG8_SA
#undef PG8_SB
#undef PG8_STAGE
#undef PG8_LDA
#undef PG8_LDB
#undef PG8_MMA
#undef PG8_WAIT_V
#undef PG8_WAIT_L
#undef PG8_BAR
#undef PG8_SCHED
}
}
namespace att {
#define LAS __attribute__((address_space(3)))
typedef unsigned short bf16_t;
typedef short bf16x8 __attribute__((ext_vector_type(8)));
typedef short s16x4 __attribute__((ext_vector_type(4)));
typedef short v4i16_t __attribute__((ext_vector_type(4)));
typedef float f32x16 __attribute__((ext_vector_type(16)));
typedef float f32x4 __attribute__((ext_vector_type(4)));
typedef float f32x2_t __attribute__((ext_vector_type(2)));
typedef __bf16 bf16x2_t __attribute__((ext_vector_type(2)));
typedef unsigned u32x4 __attribute__((ext_vector_type(4)));
typedef LAS char* lptr;
typedef LAS const char* lcptr;
constexpr int NW = 8;
constexpr int KSLOT = 8192, VSLOT = 16384;
#define ATT_PD 2
#if PROBE_WORK == 3
#define ATT_CNT64 4
#define ATT_CNT128 6
#else
#define ATT_CNT64 2
#define ATT_CNT128 3
#endif
constexpr int PD = ATT_PD, NKS = PD + 2, NVS = PD + 3;
constexpr int L_K = 0, L_V = NKS * KSLOT, L_WS = L_V + NVS * VSLOT, L_KM = L_WS + NW * 256, L_END = L_KM + 8192;
constexpr int L_OST = 0;
static_assert(NW * 8192 <= L_WS, "output stage inside the rings");
constexpr float NEG_INF = -INFINITY;

__device__ __forceinline__ int crow(int r, int hi) { return (r & 3) + 8 * (r >> 2) + 4 * hi; }
__device__ __forceinline__ unsigned cvtpk(float lo, float hi) { f32x2_t v = {lo, hi}; bf16x2_t b = __builtin_convertvector(v, bf16x2_t); return __builtin_bit_cast(unsigned, b); }
__device__ __forceinline__ float bf2f_lo(unsigned w) { return __uint_as_float(w << 16); }
__device__ __forceinline__ float bf2f_hi(unsigned w) { return __uint_as_float(w & 0xffff0000u); }
__device__ __forceinline__ void glds16(const void* gsrc, unsigned lds_dst) { unsigned keep;
    asm volatile("s_mov_b32 %0, m0\n\ts_mov_b32 m0, %2\n\ts_nop 0\n\tglobal_load_lds_dwordx4 %1, off\n\ts_mov_b32 m0, %0" : "=&s"(keep) : "v"(gsrc), "s"(lds_dst) : "memory"); }
#define ATT_WAIT_BAR() asm volatile("s_waitcnt vmcnt(0) lgkmcnt(0)\n\ts_barrier" ::: "memory")
#define ATT_STR2(x) #x
#define ATT_STR(x) ATT_STR2(x)
#define ATT_WAIT_BAR_N(N) asm volatile("s_waitcnt vmcnt(" ATT_STR(N) ") lgkmcnt(0)\n\ts_barrier" ::: "memory")
#define ATT_MFMA(a, b, c) __builtin_amdgcn_mfma_f32_32x32x16_bf16(a, b, c, 0, 0, 0)
__device__ __forceinline__ s16x4 vtr(lcptr p) { return __builtin_bit_cast(s16x4, __builtin_amdgcn_ds_read_tr16_b64_v4i16((LAS v4i16_t*)p)); }
__device__ __forceinline__ float swap_half(float v) { auto rr = __builtin_amdgcn_permlane32_swap(__float_as_uint(v), __float_as_uint(v), false, false); const int hi = (threadIdx.x >> 5) & 1; return __uint_as_float(hi ? rr[0] : rr[1]); }
__device__ __forceinline__ float rowmax(const f32x16& p0, const f32x16& p1) {
    float a = fmaxf(fmaxf(p0[0], p0[1]), p1[0]), b = fmaxf(fmaxf(p0[2], p0[3]), p1[1]); a = fmaxf(fmaxf(a, p1[2]), p1[3]);
#pragma unroll
    for (int r = 4; r < 16; r += 4) { a = fmaxf(fmaxf(a, p0[r]), p0[r + 1]); b = fmaxf(fmaxf(b, p0[r + 2]), p0[r + 3]); a = fmaxf(fmaxf(a, p1[r]), p1[r + 1]); b = fmaxf(fmaxf(b, p1[r + 2]), p1[r + 3]); }
    const float m = fmaxf(a, b);
    return fmaxf(m, swap_half(m));
}

struct BMNone {
    __device__ __forceinline__ bool active(int) const { return true; }
    __device__ __forceinline__ float cbase(int, float mref) const { return -mref; }
    __device__ __forceinline__ float cslope() const { return 0.f; }
    __device__ __forceinline__ void mask(int, f32x16&, f32x16&) const {}
};
struct BMBand {
    int qpos, qlo, W, hi; float slope2;
    __device__ __forceinline__ void init(int qpos_, int qlo_, int W_, float slope2_, int hi_) { qpos = qpos_; qlo = qlo_; W = W_; slope2 = slope2_; hi = hi_; }
    __device__ __forceinline__ bool active(int t) const { return (64 * t <= qlo + 31) && (64 * t + 63 >= qlo - W); }
    __device__ __forceinline__ float cbase(int t, float mref) const { return slope2 * (float)(64 * t + 4 * hi - qpos) - mref; }
    __device__ __forceinline__ float cslope() const { return slope2; }
    __device__ __forceinline__ void mask(int t, f32x16& p0, f32x16& p1) const {
        if ((64 * t + 63 > qlo) || (64 * t < qlo + 31 - W)) {
            const int d0 = qpos - 64 * t - 4 * hi;
#pragma unroll
            for (int r = 0; r < 16; ++r) { const int d = d0 - ((r & 3) + 8 * (r >> 2)); if (d < 0 || d > W) p0[r] = NEG_INF; const int e = d - 32; if (e < 0 || e > W) p1[r] = NEG_INF; }
        }
    }
};
struct BMMoba {
    BMBand band; unsigned sel; int qb;
    __device__ __forceinline__ bool active(int t) const { const int j = t >> 2; if (j == qb) return band.active(t); return __builtin_amdgcn_ballot_w64(((sel >> j) & 1u) != 0u) != 0ull; }
    __device__ __forceinline__ float cbase(int t, float mref) const { const int j = t >> 2; return band.cbase(t, (j == qb || ((sel >> j) & 1u)) ? mref : INFINITY); }
    __device__ __forceinline__ float cslope() const { return band.slope2; }
    __device__ __forceinline__ void mask(int t, f32x16& p0, f32x16& p1) const { const int j = t >> 2;
        if (j == qb) band.mask(t, p0, p1); }
};

constexpr float ATT_THR = 8.0f;
template <int DV, bool DO_QK, bool DO_PV, class BM>
__device__ __forceinline__ void att_block(const BM& bm, int tn, float mref, lcptr kq_, lcptr vq_, const bf16x8 (&qr)[4], f32x16& s0, f32x16& s1, f32x16& q0, f32x16& q1,
                                          u32x4 (&pan)[4], const u32x4 (&pao)[4], f32x16 (&o)[DV / 32], float& l_run) {
    constexpr int NPV = DO_PV ? DV / 8 : 0, NQK = DO_QK ? 8 : 0, NG = NPV + NQK;
    constexpr int KAH = 4, VAH = 3;
    constexpr int CG0 = NPV >= 8 ? NPV - 8 : 0;
    s16x4 lo[4], hh[4]; bf16x8 kfr[8];
    const bf16x8 pa_[4] = {__builtin_bit_cast(bf16x8, pao[0]), __builtin_bit_cast(bf16x8, pao[1]), __builtin_bit_cast(bf16x8, pao[2]), __builtin_bit_cast(bf16x8, pao[3])};
    float e0 = 0.f, e1 = 0.f;
    const float cb0 = DO_QK ? bm.cbase(tn, mref) : 0.f, csl = DO_QK ? bm.cslope() : 0.f, cb1 = cb0 + 32.f * csl;
#define ATT_VRD(f_) do { lo[(f_) & 3] = vtr(vq_ + ((f_) >> 2) * 4096 + ((f_) & 3) * 1024); hh[(f_) & 3] = vtr(vq_ + ((f_) >> 2) * 4096 + ((f_) & 3) * 1024 + 512); } while (0)
#define ATT_KRD(k_) do { kfr[k_] = *(const LAS bf16x8*)(kq_ + ((k_) >> 1) * 2048 + ((k_) & 1) * 512); } while (0)
#define ATT_PK(k) (bf16x8){lo[k][0], lo[k][1], lo[k][2], lo[k][3], hh[k][0], hh[k][1], hh[k][2], hh[k][3]}
#define ATT_EXP1(e_) do { if ((e_) < 16) { s0[(e_) & 15] = __builtin_amdgcn_exp2f(s0[(e_) & 15]); e0 += s0[(e_) & 15]; asm volatile("" : "+v"(e0)); } else { s1[(e_) & 15] = __builtin_amdgcn_exp2f(s1[(e_) & 15]); e1 += s1[(e_) & 15]; asm volatile("" : "+v"(e1)); } } while (0)
#define ATT_PACK1(p_) do { pan[(p_) >> 2][(p_) & 3] = ((p_) < 8) ? cvtpk(s0[(2 * (p_)) & 15], s0[(2 * (p_) + 1) & 15]) : cvtpk(s1[(2 * (p_)) & 15], s1[(2 * (p_) + 1) & 15]); } while (0)
#define ATT_CEL(c_) do { const float cf_ = (float)((((c_) & 15) & 3) + 8 * (((c_) & 15) >> 2)); if ((c_) < 16) q0[(c_) & 15] = __builtin_fmaf(csl, cf_, cb0); else q1[(c_) & 15] = __builtin_fmaf(csl, cf_, cb1); } while (0)
    if (DO_PV) {
#pragma unroll
        for (int f = 0; f < VAH; ++f) ATT_VRD(f);
    }
    if (DO_QK && NPV < KAH) {
#pragma unroll
        for (int k = 0; k < KAH - NPV; ++k) ATT_KRD(k);
    }
    if (DO_QK && NPV < 8) {
#pragma unroll
        for (int c = 0; c < 32; ++c) ATT_CEL(c);
    }
    __builtin_amdgcn_sched_barrier(0);
#pragma unroll
    for (int g = 0; g < NG; ++g) {
        if (g < NPV && g + VAH < NPV) ATT_VRD(g + VAH);
        if (DO_QK && g + KAH >= NPV && g + KAH - NPV < 8) ATT_KRD(g + KAH - NPV);
        if (g < NPV) o[g >> 2] = ATT_MFMA(pa_[g & 3], ATT_PK(g & 3), o[g >> 2]);
        else { const int k = g - NPV; if (k & 1) q1 = ATT_MFMA(kfr[k], qr[k >> 1], q1); else q0 = ATT_MFMA(kfr[k], qr[k >> 1], q0); }
        {
            const int e_lo = (32 * g) / NG, e_hi = (32 * (g + 1)) / NG;
#pragma unroll
            for (int e_ = 0; e_ < 32; ++e_) if (e_ >= e_lo && e_ < e_hi) ATT_EXP1(e_);
#pragma unroll
            for (int p_ = 0; p_ < 16; ++p_) if (2 * p_ + 1 < e_lo && 2 * p_ + 1 >= (g == 0 ? 0 : (32 * (g - 1)) / NG)) ATT_PACK1(p_);
        }
        if (DO_QK && NPV >= 8 && g >= CG0 && g < CG0 + 8) { ATT_CEL(4 * (g - CG0)); ATT_CEL(4 * (g - CG0) + 1); ATT_CEL(4 * (g - CG0) + 2); ATT_CEL(4 * (g - CG0) + 3); }
        __builtin_amdgcn_sched_barrier(0);
    }
    if (NG == 0) {
#pragma unroll
        for (int e_ = 0; e_ < 32; ++e_) ATT_EXP1(e_);
    }
#pragma unroll
    for (int p_ = 0; p_ < 16; ++p_) if (NG == 0 || 2 * p_ + 1 >= (32 * (NG - 1)) / NG) ATT_PACK1(p_);
    l_run += e0 + e1;
#undef ATT_VRD
#undef ATT_KRD
#undef ATT_PK
#undef ATT_EXP1
#undef ATT_PACK1
#undef ATT_CEL
}
template <int DV, class BM, bool PERWAVE = false>
__device__ __forceinline__ void flash_loop(lptr L, const bf16x8 (&qr)[4], const bf16_t* Kb, const bf16_t* Vb, int kp, int vp, int t_hi, int t_lo, const BM& bm,
                                           f32x16 (&o)[DV / 32], float& m_run, float& l_run) {
    int tid_ = threadIdx.x; asm volatile("" : "+v"(tid_));
    const int tid = tid_, lane = tid & 63, r32 = lane & 31, hi = lane >> 5;
    const int wid = __builtin_amdgcn_readfirstlane(tid >> 6);
    const unsigned lds0 = (unsigned)(uintptr_t)L;
    LAS float* wsf = (LAS float*)(L + L_WS) + wid * 64;
    const bf16_t* ksrc = Kb + (size_t)lane * kp + wid * 8;
    const bf16_t* vsrc = Vb + (size_t)(16 * (wid & 3) + (lane >> 2)) * vp + (wid >> 2) * 32 + (lane & 3) * 8;
    const unsigned kdst = lds0 + L_K + wid * 1024, vdst = lds0 + L_V + wid * 1024;
#define ATT_DMA(t, ks, vs) do { glds16(ksrc + (size_t)(t) * 64 * kp, (unsigned)__builtin_amdgcn_readfirstlane(kdst + (ks) * KSLOT)); \
        glds16(vsrc + (size_t)(t) * 64 * vp, (unsigned)__builtin_amdgcn_readfirstlane(vdst + (vs) * VSLOT)); \
        if (DV == 128) glds16(vsrc + (size_t)(t) * 64 * vp + 64, (unsigned)__builtin_amdgcn_readfirstlane(vdst + (vs) * VSLOT + 8192)); } while (0)
    const lcptr kp0 = (lcptr)L + L_K + hi * 1024 + r32 * 16;
    const lcptr vp0 = (lcptr)L + L_V + ((lane >> 4) & 1) * 32 + (lane & 3) * 8 + (4 * hi + ((lane & 15) >> 2)) * 64;
#define ATT_INC(x, N) ((x) + 1 == (N) ? 0 : (x) + 1)
#define ATT_WAIT_CNT() do { if (DV == 128) ATT_WAIT_BAR_N(ATT_CNT128); else ATT_WAIT_BAR_N(ATT_CNT64); } while (0)
#define ATT_DECIDE(t, q0, q1, pan) do { bm.mask(t, q0, q1); const float rm = rowmax(q0, q1); \
        if (__builtin_amdgcn_ballot_w64(rm > ATT_THR) != 0ull) { const float dl = fmaxf(rm, 0.f), f = __builtin_amdgcn_exp2f(-dl); \
            mref += dl; l_run *= f; \
            _Pragma("unroll") for (int r = 0; r < 16; ++r) { q0[r] -= dl; q1[r] -= dl; } \
            if (hi == 0) wsf[r32] = f; \
            _Pragma("unroll") for (int r = 0; r < 16; ++r) { const float fr_ = wsf[crow(r, hi)]; _Pragma("unroll") for (int d = 0; d < DV / 32; ++d) o[d][r] *= fr_; } \
            _Pragma("unroll") for (int w = 0; w < 4; ++w) _Pragma("unroll") for (int e = 0; e < 4; ++e) pan[w][e] = cvtpk(bf2f_lo(pan[w][e]) * f, bf2f_hi(pan[w][e]) * f); } } while (0)
    const int n = t_hi - t_lo + 1;
    float mref = 0.f;
    u32x4 PA[4] = {u32x4{}, u32x4{}, u32x4{}, u32x4{}}, PB[4] = {u32x4{}, u32x4{}, u32x4{}, u32x4{}};
    ATT_WAIT_BAR();
    int kd = 0, vd = 0;
#pragma unroll
    for (int j = 0; j <= PD; ++j) if (j < n) { ATT_DMA(t_hi - j, kd, vd); kd = ATT_INC(kd, NKS); vd = ATT_INC(vd, NVS); }
    if (n > PD) ATT_WAIT_CNT(); else ATT_WAIT_BAR();
    int jA = 0, jE = n;
    if constexpr (PERWAVE) { jA = n; jE = 0; for (int j = 0; j < n; ++j) if (bm.active(t_hi - j)) { if (j < jA) jA = j; jE = j + 1; } if (jE <= jA) { jA = 0; jE = 1; } }
    f32x16 A0, A1, B0, B1;
    int ks = 1, vs_prev = 0, vsn = 0, i = 0;
#define ATT_ADV() do { ks = ATT_INC(ks, NKS); vs_prev = vsn; vsn = ATT_INC(vsn, NVS); ++i; } while (0)
#define ATT_STEP_DMA() do { if (i + 1 + PD < n) { ATT_DMA(t_hi - i - 1 - PD, kd, vd); kd = ATT_INC(kd, NKS); vd = ATT_INC(vd, NVS); } } while (0)
#define ATT_STEP_END() do { if (i + 1 + PD < n) ATT_WAIT_CNT(); else ATT_WAIT_BAR(); ATT_ADV(); } while (0)
#define ATT_PROLOGUE_QK(tile_, kslot_) do { const float cb0 = bm.cbase(tile_, 0.f), csl = bm.cslope(), cb1 = cb0 + 32.f * csl; const lcptr kq_ = kp0 + (kslot_) * KSLOT; \
      _Pragma("unroll") for (int r = 0; r < 16; ++r) { const float cf = (float)((r & 3) + 8 * (r >> 2)); A0[r] = __builtin_fmaf(csl, cf, cb0); A1[r] = __builtin_fmaf(csl, cf, cb1); } \
      _Pragma("unroll") for (int d0 = 0; d0 < 4; ++d0) { const bf16x8 k0 = *(const LAS bf16x8*)(kq_ + d0 * 2048), k1 = *(const LAS bf16x8*)(kq_ + d0 * 2048 + 512); A0 = ATT_MFMA(k0, qr[d0], A0); A1 = ATT_MFMA(k1, qr[d0], A1); } \
      bm.mask(tile_, A0, A1); \
      const float rm = rowmax(A0, A1); mref = (rm == NEG_INF) ? 0.f : rm; \
      _Pragma("unroll") for (int r = 0; r < 16; ++r) { A0[r] -= mref; A1[r] -= mref; } } while (0)
    if (jA == 0) ATT_PROLOGUE_QK(t_hi, 0);
    else {
#pragma nounroll
        while (i + 1 < jA) { ATT_STEP_DMA(); ATT_STEP_END(); }
        ATT_STEP_DMA(); ATT_PROLOGUE_QK(t_hi - jA, ks); ATT_STEP_END();
    }
#define ATT_STEP(S0, S1, PS, Q0, Q1, PQ, DO_QK, DO_PV) do { const int tn = t_hi - i - 1; \
        ATT_STEP_DMA(); \
        att_block<DV, DO_QK, DO_PV>(bm, tn, mref, kp0 + ks * KSLOT, vp0 + vs_prev * VSLOT, qr, S0, S1, Q0, Q1, PS, PQ, o, l_run); \
        if (DO_QK) ATT_DECIDE(tn, Q0, Q1, PS); \
        ATT_STEP_END(); } while (0)
    float ldead = 0.f;
    bool last_in_A;
    if (jE - jA > 1) ATT_STEP(A0, A1, PA, B0, B1, PB, true, false); else ATT_STEP(A0, A1, PA, B0, B1, PB, false, false);
#pragma nounroll
    while (i + 2 < jE) { ATT_STEP(B0, B1, PB, A0, A1, PA, true, true); ATT_STEP(A0, A1, PA, B0, B1, PB, true, true); }
    if (i + 2 == jE) { ATT_STEP(B0, B1, PB, A0, A1, PA, true, true); ATT_STEP(A0, A1, PA, B0, B1, PB, false, true); last_in_A = true; }
    else if (i + 1 == jE) { ATT_STEP(B0, B1, PB, A0, A1, PA, false, true); last_in_A = false; }
    else last_in_A = true;
    if (jE < n) ATT_STEP_DMA();
    if (last_in_A) att_block<DV, false, true>(bm, 0, mref, kp0, vp0 + vs_prev * VSLOT, qr, B0, B1, B0, B1, PB, PA, o, ldead);
    else att_block<DV, false, true>(bm, 0, mref, kp0, vp0 + vs_prev * VSLOT, qr, A0, A1, A0, A1, PA, PB, o, ldead);
    if (jE < n) { ATT_STEP_END();
#pragma nounroll
        while (i < n) { ATT_STEP_DMA(); ATT_STEP_END(); } }
    ATT_WAIT_BAR();
    m_run = mref;
#undef ATT_STEP
#undef ATT_ADV
#undef ATT_STEP_DMA
#undef ATT_STEP_END
#undef ATT_PROLOGUE_QK
#undef ATT_DMA
#undef ATT_INC
#undef ATT_WAIT_CNT
#undef ATT_DECIDE
}

__device__ __forceinline__ float bf2f_(unsigned short u) { return __uint_as_float(((unsigned)u) << 16); }
__device__ __forceinline__ float silu_(float g) { return g * __builtin_amdgcn_rcpf(1.0f + __builtin_amdgcn_exp2f(-g * LOG2E)); }
template <int DV, bool GATED, class RowPtr>
__device__ __forceinline__ float finish_unit(lptr L, f32x16 (&o)[DV / 32], float m_run, float l_run, const RowPtr& rp) {
    int tid_ = threadIdx.x; asm volatile("" : "+v"(tid_));
    const int tid = tid_, lane = tid & 63, r32 = lane & 31, hi = lane >> 5;
    const int wid = __builtin_amdgcn_readfirstlane(tid >> 6);
    LAS float* wsf = (LAS float*)(L + L_WS) + wid * 64;
    const float l_tot = l_run + swap_half(l_run);
    if (hi == 0) wsf[32 + r32] = l_tot;
    LAS bf16_t* stg = (LAS bf16_t*)(L + L_OST + wid * 8192);
#pragma unroll
    for (int r = 0; r < 16; ++r) { const int orow = crow(r, hi); const float rl = __builtin_amdgcn_rcpf(wsf[32 + orow]);
#pragma unroll
        for (int d = 0; d < DV / 32; ++d) { const __hip_bfloat16 hv = __float2bfloat16(o[d][r] * rl); stg[orow * DV + d * 32 + r32] = __builtin_bit_cast(unsigned short, hv); } }
    constexpr int CPR = DV / 8;
#pragma unroll
    for (int it = 0; it < DV / 16; ++it) { const int idx = it * 64 + lane, row = idx / CPR, ch = idx % CPR;
        u32x4 v = *(const LAS u32x4*)((lcptr)stg + row * (DV * 2) + ch * 16);
        u32x4* gp = (u32x4*)(rp(row) + ch * 8);
        if (GATED) { const u32x4 g = *gp;
#pragma unroll
            for (int e = 0; e < 4; ++e) { const float o0 = bf2f_((unsigned short)(v[e] & 0xffffu)), o1 = bf2f_((unsigned short)(v[e] >> 16));
                const float g0 = bf2f_((unsigned short)(g[e] & 0xffffu)), g1 = bf2f_((unsigned short)(g[e] >> 16));
                v[e] = cvtpk(o0 * silu_(g0), o1 * silu_(g1)); } }
        *gp = v; }
    return m_run + __builtin_amdgcn_logf(l_tot);
}
__device__ __forceinline__ void load_q(bf16x8 (&qr)[4], const bf16_t* qrow, int hi) {
#pragma unroll
    for (int d0 = 0; d0 < 4; ++d0) qr[d0] = *(const bf16x8*)(qrow + d0 * 16 + hi * 8);
}
__device__ __forceinline__ float alibi2(int i, int n) { return exp2f(-8.0f * (float)(i + 1) / (float)n) * LOG2E; }
}
constexpr int RING_OFF = 0, RING_BYTES = 131072;
constexpr int ATT_BYTES = 144 * 1024;
constexpr int LDSCTL_OFF = ATT_BYTES, MISC_OFF = LDSCTL_OFF + 320;
constexpr int LDS_BYTES = 148480;
static_assert(att::L_END <= ATT_BYTES && RING_BYTES <= ATT_BYTES && MISC_OFF + 128 <= LDS_BYTES, "LDS map");
constexpr int NWAVES = 8;
constexpr int NPHASES = 2 + 4 * DEPTH;

#define GAS __attribute__((address_space(1)))
#define LAS __attribute__((address_space(3)))
typedef unsigned short bf16;
typedef unsigned v4u __attribute__((ext_vector_type(4)));
typedef float f32x4 __attribute__((ext_vector_type(4)));
typedef short bf16x8 __attribute__((ext_vector_type(8)));
typedef GAS unsigned gu32;
typedef GAS unsigned long long gu64;
#define RLX_AGENT __ATOMIC_RELAXED, __HIP_MEMORY_SCOPE_AGENT
#define LDS_WAIT() asm volatile("s_waitcnt lgkmcnt(0)" ::: "memory")
#define VM_WAIT() asm volatile("s_waitcnt vmcnt(0)" ::: "memory")
__device__ __forceinline__ unsigned long long rt() { return __builtin_amdgcn_s_memrealtime(); }
__device__ __forceinline__ unsigned f2bf(float f) { unsigned u = __builtin_bit_cast(unsigned, f); return (u + 0x7fffu + ((u >> 16) & 1u)) >> 16; }
__device__ __forceinline__ unsigned pk2(float lo, float hi) { return f2bf(lo) | (f2bf(hi) << 16); }
#define XB_TMO      128
#define XB_XCNT(j)  (256  + 64 * (j))
#define XB_XSUB(j)  (1280 + 64 * (j))
#define XB_XGEN(j)  (2304 + 64 * (j))
#define XB_TOP      3328
#define XB_TOPGEN   3392
#define XCD_BAR_WORDS 3456
#define XB_SPIN_CAP (1u << 18)

__device__ __forceinline__ unsigned xb_ld(unsigned* p)              { return __hip_atomic_load(p, __ATOMIC_RELAXED, __HIP_MEMORY_SCOPE_AGENT); }
__device__ __forceinline__ unsigned xb_add(unsigned* p, unsigned v) { return __hip_atomic_fetch_add(p, v, __ATOMIC_RELAXED, __HIP_MEMORY_SCOPE_AGENT); }
__device__ __forceinline__ unsigned xb_xcc_id() { return (unsigned)__builtin_amdgcn_s_getreg((3 << 11) | 20) & 0xFu; }
#define XB_SPIN(cond, bar) do { unsigned _sp = 0; while (cond) { __builtin_amdgcn_s_sleep(1); \
    if ((++_sp & 255u) == 0u) { if (xb_ld(&(bar)[XB_TMO])) break; if (_sp > XB_SPIN_CAP) { atomicAdd(&(bar)[XB_TMO], 1u); break; } } } } while (0)

struct XcdBarrier {
    unsigned* bar; unsigned x;
    volatile LAS unsigned* st;
};

__device__ __forceinline__ XcdBarrier xcd_barrier_post(unsigned* bar, volatile LAS unsigned* st) {
    XcdBarrier b; b.bar = bar; b.x = xb_xcc_id(); b.st = st;
    if (threadIdx.x == 0) (void)xb_add(&bar[XB_XCNT(b.x)], 1u);
    return b;
}
__device__ __forceinline__ void xcd_barrier_complete(unsigned* bar, unsigned x, unsigned& nloc, unsigned& nx) {
    const unsigned G = gridDim.x * gridDim.y * gridDim.z;
    unsigned sum, cnt, mine, sp = 0u;
    for (;;) {
        sum = 0u; cnt = 0u; mine = 0u;
#pragma unroll
        for (unsigned j = 0; j < 16; ++j) { const unsigned c = xb_ld(&bar[XB_XCNT(j)]); sum += c; cnt += (c > 0u) ? 1u : 0u; mine = (j == x) ? c : mine; }
        if (sum == G) break;
        __builtin_amdgcn_s_sleep(1);
        if ((++sp & 255u) == 0u) { if (xb_ld(&bar[XB_TMO])) break; if (sp > XB_SPIN_CAP) { atomicAdd(&bar[XB_TMO], 1u); break; } }
    }
    nloc = mine > 0u ? mine : 1u; nx = cnt > 0u ? cnt : 1u;
}

__device__ __forceinline__ void xcd_barrier(const XcdBarrier& b) {
    asm volatile("s_waitcnt vmcnt(0)" ::: "memory");
    __syncthreads();
    if (threadIdx.x == 0) {
        unsigned* bar = b.bar;
        __builtin_amdgcn_s_waitcnt(0);
        unsigned nloc = b.st[0], nx = b.st[1];
        if (nloc == 0u) { xcd_barrier_complete(bar, b.x, nloc, nx); b.st[0] = nloc; b.st[1] = nx; }
        const unsigned old = xb_add(&bar[XB_XSUB(b.x)], 1u);
        const unsigned gen = old / nloc;
        if (old + 1u == (gen + 1u) * nloc) {
            __builtin_amdgcn_fence(__ATOMIC_RELEASE, "agent");
            asm volatile("s_waitcnt vmcnt(0)" ::: "memory");
            const unsigned og = xb_add(&bar[XB_TOP], 1u);
            const unsigned tg = og / nx;
            if (og + 1u == (tg + 1u) * nx) xb_add(&bar[XB_TOPGEN], 1u);
            else XB_SPIN(xb_ld(&bar[XB_TOPGEN]) == tg, bar);
            __builtin_amdgcn_fence(__ATOMIC_ACQUIRE, "agent");
            xb_add(&bar[XB_XGEN(b.x)], 1u);
            asm volatile("s_waitcnt vmcnt(0)" ::: "memory");
        } else {
            XB_SPIN(xb_ld(&bar[XB_XGEN(b.x)]) == gen, bar);
            __builtin_amdgcn_fence(__ATOMIC_ACQUIRE, "agent");
            asm volatile("s_waitcnt vmcnt(0)" ::: "memory");
        }
    }
    __syncthreads();
}
struct Args { const float* in[13]; float* out; unsigned char* ws; int ph_lo, ph_hi, li, pad; };
struct Frame {
    LAS unsigned char* lds;
    int tid, lane, wave, vcu, G;
    unsigned char* ws;
};
#define IN_X(a) ((a).in[0])
#define IN_MEM(a) ((a).in[1])
#define IN_NORM_G(a) ((a).in[2])
#define IN_W_IN(a) ((a).in[3])
#define IN_W_OUT(a) ((a).in[4])
#define IN_MEM_NORM_G(a) ((a).in[5])
#define IN_W_MEM_KV(a) ((a).in[6])
#define IN_LQ1(a) ((a).in[7])
#define IN_LK1(a) ((a).in[8])
#define IN_LQ2(a) ((a).in[9])
#define IN_LK2(a) ((a).in[10])
#define IN_SUBLN_G(a) ((a).in[11])
#define IN_FINAL_G(a) ((a).in[12])
__device__ __forceinline__ float wave_sum(float v) {
#pragma unroll
    for (int o = 1; o < 64; o <<= 1) v += __shfl_xor(v, o);
    return v;
}
__device__ __forceinline__ void p0_transpose_item(const float* W, int K, int N, bf16* WT, int row_off, const float* gk, float cs, LAS float* scr, int item, int lane) {
    const int nblk = N / 32, kb = item / nblk, nb = item % nblk, k0 = 64 * kb, n0 = 32 * nb;
    const int kq = lane >> 3, n4 = (lane & 7) * 4;
#pragma unroll
    for (int i = 0; i < 8; ++i) { const int kk = 8 * i + kq; const float g = gk ? gk[k0 + kk] * cs : cs; const f32x4 w = *(const GAS f32x4*)(W + (size_t)(k0 + kk) * N + n0 + n4);
        LAS float* d = scr + kk * 33 + n4; d[0] = w.x * g; d[1] = w.y * g; d[2] = w.z * g; d[3] = w.w * g; }
    LDS_WAIT(); asm volatile("" ::: "memory");
    const int c = lane & 7;
#pragma unroll
    for (int j = 0; j < 4; ++j) { const int n = (lane >> 3) + 8 * j; const LAS float* s = scr + (8 * c) * 33 + n;
        v4u o; o.x = pk2(s[0 * 33], s[1 * 33]); o.y = pk2(s[2 * 33], s[3 * 33]); o.z = pk2(s[4 * 33], s[5 * 33]); o.w = pk2(s[6 * 33], s[7 * 33]);
        *(GAS v4u*)(WT + (size_t)(row_off + n0 + n) * K + k0 + 8 * c) = o; }
    LDS_WAIT(); asm volatile("" ::: "memory");
}
constexpr int I_IN = (DMODEL / 64) * (INW / 32), I_OUT = (DMODEL / 64) * (DMODEL / 32), I_MEM = (DMODEL / 64) * (512 / 32);
__device__ __forceinline__ void convert_item(Frame& F, const Args& A, int which, int l, int q, LAS float* scr) {
    if (which == 0) { const int nb = q % (INW / 32), n0 = nb * 32; const float cs = (n0 < MIXW || (n0 >= 3 * MIXW && n0 < 3 * MIXW + MEMW)) ? QSCALE : 1.0f;
        p0_transpose_item(IN_W_IN(A) + (size_t)l * DMODEL * INW, DMODEL, INW, (bf16*)(F.ws + WS_WIN) + (size_t)l * INW * DMODEL, 0, IN_NORM_G(A) + l * DMODEL, cs, scr, q, F.lane); }
    else if (which == 1) p0_transpose_item(IN_W_OUT(A) + (size_t)l * DMODEL * DMODEL, DMODEL, DMODEL, (bf16*)(F.ws + WS_WOUT) + (size_t)l * DMODEL * DMODEL, 0, nullptr, 1.0f, scr, q, F.lane);
    else p0_transpose_item(IN_W_MEM_KV(A) + (size_t)l * DMODEL * 512, DMODEL, 512, (bf16*)(F.ws + WS_WMEM), l * 512, IN_MEM_NORM_G(A) + l * DMODEL, 1.0f, scr, q, F.lane);
}
__device__ __forceinline__ void convert_deferred(Frame& F, const Args& A, int l, int worker, int nworkers) {
    LAS float* scr = (LAS float*)(F.lds + RING_OFF + F.wave * 16384);
    const int nitems = I_OUT + (l + 1 < DEPTH ? I_IN : 0);
    for (int it = worker; it < nitems; it += nworkers) { if (it < I_OUT) convert_item(F, A, 1, l, it, scr); else convert_item(F, A, 0, l + 1, it - I_OUT, scr); }
}
__device__ __forceinline__ void p0_prologue(Frame& F, const Args& A) {
    LAS float* scr = (LAS float*)(F.lds + RING_OFF + F.wave * 16384);
    const int gw = F.vcu * NWAVES + F.wave, NGW = F.G * NWAVES;
    constexpr int NITEMS = I_IN + DEPTH * I_MEM;
    for (int it = gw; it < NITEMS; it += NGW) { if (it < I_IN) convert_item(F, A, 0, 0, it, scr); else convert_item(F, A, 2, (it - I_IN) / I_MEM, (it - I_IN) % I_MEM, scr); }
    bf16* xb = (bf16*)(F.ws + WS_XB); float* ssq = (float*)(F.ws + WS_SSQ);
    for (int m = gw; m < MROWS; m += NGW) {
        const GAS f32x4* xr = (const GAS f32x4*)(IN_X(A) + (size_t)m * DMODEL) + F.lane;
        GAS unsigned long long* o8 = (GAS unsigned long long*)(xb + (size_t)m * DMODEL) + F.lane;
        float s = 0.f;
#pragma unroll
        for (int j = 0; j < 4; ++j) { const f32x4 v = xr[64 * j]; s += (v.x * v.x + v.y * v.y) + (v.z * v.z + v.w * v.w);
            o8[64 * j] = (unsigned long long)pk2(v.x, v.y) | ((unsigned long long)pk2(v.z, v.w) << 32); }
        s = wave_sum(s);
        if (F.lane < 16) ssq[(size_t)m * 16 + F.lane] = (F.lane == 0) ? s : 0.f;
    }
    bf16* memn = (bf16*)(F.ws + WS_MEMN);
    for (int m = gw; m < BATCH * NMEM; m += NGW) {
        const GAS f32x4* xr = (const GAS f32x4*)(IN_MEM(A) + (size_t)m * DMODEL) + F.lane;
        GAS unsigned long long* o8 = (GAS unsigned long long*)(memn + (size_t)m * DMODEL) + F.lane;
        f32x4 v[4]; float s = 0.f;
#pragma unroll
        for (int j = 0; j < 4; ++j) { v[j] = xr[64 * j]; s += (v[j].x * v[j].x + v[j].y * v[j].y) + (v[j].z * v[j].z + v[j].w * v[j].w); }
        const float rstd = 1.0f / sqrtf(wave_sum(s) * (1.0f / DMODEL) + RMS_EPS);
#pragma unroll
        for (int j = 0; j < 4; ++j) o8[64 * j] = (unsigned long long)pk2(v[j].x * rstd, v[j].y * rstd) | ((unsigned long long)pk2(v[j].z * rstd, v[j].w * rstd) << 32);
    }
    if (gw == 1) { float* nz = (float*)(F.ws + WS_NRM); for (int i = F.lane; i < DEPTH * 96; i += 64) nz[i] = 0.f; }
    if (gw == 0) {
        const float a = wave_sum(IN_LQ1(A)[F.lane] * IN_LK1(A)[F.lane]), b = wave_sum(IN_LQ2(A)[F.lane] * IN_LK2(A)[F.lane]);
        const float lam_init = 0.8f - 0.6f * expf(-0.3f * 2.0f);
        if (F.lane == 0) ((float*)(F.ws + WS_MISC))[0] = expf(a) - expf(b) + lam_init;
    }
}
__device__ __forceinline__ float diff_lambda_init() { return 0.8f - 0.6f * expf(-0.3f * 2.0f); }

__device__ __forceinline__ void unit_mem(Frame& F, int layer, int un) {
    using namespace att;
    const int hm = un & 3, rb = un >> 2;
    const int r32 = F.lane & 31, hi = F.lane >> 5;
    const int row0 = rb * 256 + F.wave * 32, b = rb >> 5;
    const bf16_t* qm = (const bf16_t*)(F.ws + WS_QM);
    const bf16_t* kv = (const bf16_t*)(F.ws + WS_MEMKV) + (size_t)(b * NMEM) * 2048 + layer * 512 + hm * 64;
    bf16x8 qr[4]; load_q(qr, qm + (size_t)(row0 + r32) * MEMW + hm * 64, hi);
    f32x16 o[2]; o[0] = f32x16{}; o[1] = f32x16{}; float m_run = NEG_INF, l_run = 0.f;
    BMNone bm;
    flash_loop<64>((lptr)(F.lds + RING_OFF), qr, kv, kv + 256, 2048, 2048, 3, 0, bm, o, m_run, l_run);
    bf16_t* yg = (bf16_t*)(F.ws + WS_GATE) + (size_t)row0 * DMODEL + MIXW + hm * 64;
    finish_unit<64, true>((lptr)(F.lds + RING_OFF), o, m_run, l_run, [=](int i) { return yg + (size_t)i * DMODEL; });
}
__device__ __forceinline__ void unit_dsw(Frame& F, int un) {
    using namespace att;
    const int x = un & 31, hh = (un >> 5) % 12, b = un / 384;
    const int g = hh >> 2, sh = 2 * g, dil = 1 << sh, U = SEQ >> sh, nb = U >> 8;
    const int res = x / nb, ub = x % nb;
    const int r32 = F.lane & 31, hi = F.lane >> 5;
    const size_t seq0 = (size_t)b * SEQ + (size_t)res * U;
    const int qlo = ub * 256 + F.wave * 32, qpos = qlo + r32;
    const bf16_t* Q = (const bf16_t*)(F.ws + WS_Q) + seq0 * MIXW + hh * 64;
    const bf16_t* K = (const bf16_t*)(F.ws + WS_K) + seq0 * MIXW + hh * 64;
    const bf16_t* V = (const bf16_t*)(F.ws + WS_V) + seq0 * MIXW + hh * 64;
    bf16x8 qr[4]; load_q(qr, Q + (size_t)qpos * MIXW, hi);
    f32x16 o[2]; o[0] = f32x16{}; o[1] = f32x16{}; float m_run = NEG_INF, l_run = 0.f;
    BMBand bm; bm.init(qpos, qlo, 128, alibi2(hh, 12) * (float)dil, hi);
    const int t_hi = ub * 4 + 3, t_lo = (ub * 4 - 2) > 0 ? (ub * 4 - 2) : 0;
    flash_loop<64, att::BMBand, true>((lptr)(F.lds + RING_OFF), qr, K, V, MIXW, MIXW, t_hi, t_lo, bm, o, m_run, l_run);
    bf16_t* mix = (bf16_t*)(F.ws + WS_MIX) + ((size_t)b * SEQ) * MIXW + hh * 64;
    const float l2 = finish_unit<64, false>((lptr)(F.lds + RING_OFF), o, m_run, l_run, [=](int i) { return mix + (size_t)(((qlo + i) << sh) + res) * MIXW; });
    if (hi == 0) ((float*)(F.ws + WS_LSE))[((size_t)b * SEQ + ((size_t)qpos << sh) + res) * 12 + hh] = l2;
}
__device__ __forceinline__ int skip_first_tile(Frame& F, int layer, int b, int stream, float slope2, int q_first) {
    const float* nr = (const float*)(F.ws + WS_NRM) + layer * 96 + b * 48 + 2 * stream;
    const float qn2 = nr[0] + nr[1], kn2 = nr[24] + nr[25];
    const float S = sqrtf(qn2 * kn2) * 1.02f + 0.5f;
    const float dskip = (160.0f + 2.0f * S) / slope2 + 1.0f;
    const float kminf = (float)q_first - dskip;
    return kminf <= 0.f ? 0 : (((int)kminf) >> 6);
}
__device__ __forceinline__ void unit_moba(Frame& F, int layer, int b, int h, int qb) {
    using namespace att;
    const int r32 = F.lane & 31, hi = F.lane >> 5;
    const lptr L = (lptr)(F.lds + RING_OFF);
    const size_t seq0 = (size_t)b * SEQ;
    const int qlo = qb * 256 + F.wave * 32, qpos = qlo + r32;
    const bf16_t* Q = (const bf16_t*)(F.ws + WS_Q) + seq0 * MIXW + h * 64;
    const bf16_t* K = (const bf16_t*)(F.ws + WS_K) + seq0 * MIXW + h * 64;
    const bf16_t* V = (const bf16_t*)(F.ws + WS_V) + seq0 * MIXW + h * 64;
    bf16x8 qr[4]; load_q(qr, Q + (size_t)qpos * MIXW, hi);
    unsigned sel = (qb >= 3) ? 7u : ((1u << qb) - 1u);
    if (qb > 3) {
        { const int j = F.tid >> 4, d4 = (F.tid & 15) * 4; const float* kp_ = (const float*)(F.ws + WS_KPART) + (size_t)((b * 32 + j) * 2) * MIXW + h * 64 + d4;
          const f32x4 a = *(const f32x4*)kp_, c = *(const f32x4*)(kp_ + MIXW);
          *(LAS f32x4*)(L + L_KM + (j * 64 + d4) * 4) = (a + c) * (1.0f / 256.0f); }
        asm volatile("s_waitcnt lgkmcnt(0)\n\ts_barrier" ::: "memory");
        float qf[32];
#pragma unroll
        for (int d0 = 0; d0 < 4; ++d0)
#pragma unroll
            for (int e = 0; e < 8; ++e) qf[d0 * 8 + e] = __uint_as_float(((unsigned)(unsigned short)qr[d0][e]) << 16);
        float v1 = NEG_INF, v2 = NEG_INF, v3 = NEG_INF; int i1 = 0, i2 = 0, i3 = 0;
        for (int j = 0; j < qb; ++j) {
            const LAS f32x4* km = (const LAS f32x4*)(L + L_KM + (j * 64 + 8 * hi) * 4);
            float gsum = 0.f;
#pragma unroll
            for (int d0 = 0; d0 < 4; ++d0) { const f32x4 k0 = km[d0 * 4], k1 = km[d0 * 4 + 1];
                gsum += qf[d0 * 8 + 0] * k0[0] + qf[d0 * 8 + 1] * k0[1] + qf[d0 * 8 + 2] * k0[2] + qf[d0 * 8 + 3] * k0[3] + qf[d0 * 8 + 4] * k1[0] + qf[d0 * 8 + 5] * k1[1] + qf[d0 * 8 + 6] * k1[2] + qf[d0 * 8 + 7] * k1[3]; }
            const float gt = gsum + swap_half(gsum);
            if (gt > v1) { v3 = v2; i3 = i2; v2 = v1; i2 = i1; v1 = gt; i1 = j; }
            else if (gt > v2) { v3 = v2; i3 = i2; v2 = gt; i2 = j; }
            else if (gt > v3) { v3 = gt; i3 = j; }
        }
        sel = (1u << i1) | (1u << i2) | (1u << i3);
    }
    f32x16 o[2]; o[0] = f32x16{}; o[1] = f32x16{}; float m_run = NEG_INF, l_run = 0.f;
    BMMoba bm; bm.band.init(qpos, qlo, 1 << 20, alibi2(h, 12), hi); bm.sel = sel; bm.qb = qb;
    flash_loop<64>(L, qr, K, V, MIXW, MIXW, qb * 4 + 3, skip_first_tile(F, layer, b, h, alibi2(h, 12), qb * 256), bm, o, m_run, l_run);
    bf16_t* yg = (bf16_t*)(F.ws + WS_GATE) + (seq0 + qlo) * DMODEL + h * 64;
    finish_unit<64, true>(L, o, m_run, l_run, [=](int i) { return yg + (size_t)i * DMODEL; });
}
__device__ __forceinline__ void unit_diff(Frame& F, int layer, int b, int h, int mp, int qb) {
    using namespace att;
    const int r32 = F.lane & 31, hi = F.lane >> 5;
    const lptr L = (lptr)(F.lds + RING_OFF);
    const size_t seq0 = (size_t)b * SEQ;
    const int qlo = qb * 256 + F.wave * 32, qpos = qlo + r32;
    const bf16_t* Q = (const bf16_t*)(F.ws + WS_Q) + seq0 * MIXW + (h * 2 + mp) * 64;
    const bf16_t* K = (const bf16_t*)(F.ws + WS_K) + seq0 * MIXW + (h * 2 + mp) * 64;
    const bf16_t* V = (const bf16_t*)(F.ws + WS_V) + seq0 * MIXW + h * 128;
    bf16x8 qr[4]; load_q(qr, Q + (size_t)qpos * MIXW, hi);
    f32x16 o[4]; o[0] = f32x16{}; o[1] = f32x16{}; o[2] = f32x16{}; o[3] = f32x16{}; float m_run = NEG_INF, l_run = 0.f;
    BMBand bm; bm.init(qpos, qlo, 1 << 20, alibi2(h, 6), hi);
#if PROBE_OUT
    const int tl_ = skip_first_tile(F, layer, b, h * 2 + mp, alibi2(h, 6), qb * 256);
    const unsigned long long c0_ = __builtin_amdgcn_s_memtime(), r0_ = __builtin_amdgcn_s_memrealtime();
    flash_loop<128>(L, qr, K, V, MIXW, MIXW, qb * 4 + 3, tl_, bm, o, m_run, l_run);
    const unsigned long long c1_ = __builtin_amdgcn_s_memtime(), r1_ = __builtin_amdgcn_s_memrealtime();
    if (b == 0 && h == 5 && mp == 0 && qb == 31 && F.tid == 0) {
        const float steps = (float)(qb * 4 + 3 - tl_ + 2);
        float* pm = (float*)(F.ws + WS_MISC);
        pm[4] = (float)(c1_ - c0_) / steps;
        pm[5] = (float)(c1_ - c0_) / (float)(r1_ - r0_) * 0.1f;
        pm[6] = steps;
    }
#else
    flash_loop<128>(L, qr, K, V, MIXW, MIXW, qb * 4 + 3, skip_first_tile(F, layer, b, h * 2 + mp, alibi2(h, 6), qb * 256), bm, o, m_run, l_run);
#endif
    bf16_t* od = (bf16_t*)(F.ws + WS_MIX) + (seq0 + qlo) * 1536 + (h * 2 + mp) * 128;
    finish_unit<128, false>(L, o, m_run, l_run, [=](int i) { return od + (size_t)i * 1536; });
}
__device__ __forceinline__ void phase_attn(Frame& F, int layer, int rep) {
    const int kind = layer % 3, G = F.G, v = F.vcu;
    if (kind == 0) {
#ifndef DIS_DSW
        for (int un = v; un < 768 + 256; un += G) { if (un < 768) unit_dsw(F, un); else unit_mem(F, layer, un - 768); }
#endif
    } else {
        volatile LAS unsigned* MISC = (volatile LAS unsigned*)(F.lds + MISC_OFF);
        const int x0 = (int)(xb_xcc_id() & 7u);
        gu32* ctr0 = (gu32*)(F.ws + WS_CTL) + CW_QUEUE + 64 * (layer * 8 + 32 * rep);
        int qi = 0;
        for (int it = 0;; ++it) {
            if (F.tid == 0) {
                unsigned code = 0xffffffffu; int q = qi;
                for (; q < 8; ++q) { const int x = (x0 + q) & 7; const unsigned idx = __hip_atomic_fetch_add(ctr0 + 64 * x, 1u, __ATOMIC_RELAXED, __HIP_MEMORY_SCOPE_AGENT); if (idx < 96u + 32u) { code = ((unsigned)q << 8) | idx; break; } }
                MISC[12 + (it & 1)] = code;
            }
            asm volatile("s_waitcnt vmcnt(0) lgkmcnt(0)\n\ts_barrier" ::: "memory");
            const unsigned code = MISC[12 + (it & 1)];
            if (code == 0xffffffffu) break;
            qi = (int)(code >> 8); const int idx = (int)(code & 0xffu), x = (x0 + qi) & 7, b = x >> 2, j = x & 3;
            if (idx < 96) { const int sl = idx >> 5, qb = 31 - (idx & 31);
#ifndef DIS_MOBA
                if (kind == 1) { const int h = sl == 0 ? 8 + j : (sl == 1 ? 7 - j : j); unit_moba(F, layer, b, h, qb); }
                else
#endif
#ifndef DIS_DIFF
                { const int h = sl == 0 ? 4 + (j >> 1) : (sl == 1 ? 3 - (j >> 1) : (j >> 1)), mp = j & 1; unit_diff(F, layer, b, h, mp, qb); }
#else
                {}
#endif
            }
#ifndef DIS_MEM
            else unit_mem(F, layer, x * 32 + (idx - 96));
#endif
        }
    }
}
__device__ __forceinline__ float bf2f(unsigned short u) { return __uint_as_float(((unsigned)u) << 16); }
__device__ __forceinline__ void phase_finalize(Frame& F, const Args& A, int layer) {
    typedef unsigned short us8 __attribute__((ext_vector_type(8)));
    const int kind = layer % 3, gw = F.vcu * NWAVES + F.wave, NGW = F.G * NWAVES, lane = F.lane;
    bf16* gate = (bf16*)(F.ws + WS_GATE);
    const bf16* mix = (const bf16*)(F.ws + WS_MIX);
    const float* lse = (const float*)(F.ws + WS_LSE);
    const float lam = ((const float*)(F.ws + WS_MISC))[0], lam_scale = 1.0f - diff_lambda_init();
    for (int m = gw; m < MROWS; m += NGW) {
        float v[16];
        if (lane < 48) {
            if (kind == 2) {
                const int h = lane >> 3, dd = (lane & 7) * 16;
                const us8* p1 = (const us8*)(mix + (size_t)m * 1536 + h * 256 + dd); const us8* p2 = (const us8*)(mix + (size_t)m * 1536 + h * 256 + 128 + dd);
                const us8 a0 = p1[0], a1 = p1[1], b0 = p2[0], b1 = p2[1];
#pragma unroll
                for (int e = 0; e < 8; ++e) { v[e] = bf2f(a0[e]) - lam * bf2f(b0[e]); v[8 + e] = bf2f(a1[e]) - lam * bf2f(b1[e]); }
            } else {
                const us8* p1 = (const us8*)(mix + (size_t)m * MIXW + lane * 16); const us8 a0 = p1[0], a1 = p1[1];
#pragma unroll
                for (int e = 0; e < 8; ++e) { v[e] = bf2f(a0[e]); v[8 + e] = bf2f(a1[e]); }
            }
        } else {
#pragma unroll
            for (int e = 0; e < 16; ++e) v[e] = 0.f;
        }
        float sc = 1.0f;
        if (kind == 2) {
            float ss = 0.f;
#pragma unroll
            for (int e = 0; e < 16; ++e) ss += v[e] * v[e];
            ss += __shfl_xor(ss, 1); ss += __shfl_xor(ss, 2); ss += __shfl_xor(ss, 4);
            sc = lam_scale / sqrtf(ss * (1.0f / 128.0f) + SUBLN_EPS);
            if (lane < 48) { const float* sg = IN_SUBLN_G(A) + (lane & 7) * 16;
#pragma unroll
                for (int e = 0; e < 16; ++e) v[e] *= sg[e]; }
            else sc = 1.0f;
        } else if (kind == 0 && lane < 48) {
            const int hh = lane >> 2, j = hh & 3, g = hh >> 2;
            const float* lr = lse + (size_t)m * 12;
            const float l0 = lr[j], l1 = lr[4 + j], l2 = lr[8 + j], mx = fmaxf(fmaxf(l0, l1), l2);
            const float e0 = exp2f(l0 - mx), e1 = exp2f(l1 - mx), e2 = exp2f(l2 - mx);
            sc = (g == 0 ? e0 : (g == 1 ? e1 : e2)) / (e0 + e1 + e2);
        }
        if (lane >= 48) continue;
        us8* gp = (us8*)(gate + (size_t)m * DMODEL + lane * 16);
        const us8 g0 = gp[0], g1 = gp[1]; us8 y0, y1;
#pragma unroll
        for (int e = 0; e < 8; ++e) {
            const float ga = bf2f(g0[e]), gb = bf2f(g1[e]);
            const float sa = ga / (1.0f + exp2f(-ga * LOG2E)), sb = gb / (1.0f + exp2f(-gb * LOG2E));
            y0[e] = (unsigned short)f2bf(v[e] * sc * sa); y1[e] = (unsigned short)f2bf(v[8 + e] * sc * sb);
        }
        gp[0] = y0; gp[1] = y1;
    }
}
__device__ __forceinline__ void phase_final_norm(Frame& F, const Args& A) {
    const int gw = F.vcu * NWAVES + F.wave, NGW = F.G * NWAVES;
    const float* ssq = (const float*)(F.ws + WS_SSQ);
    for (int m = gw; m < MROWS; m += NGW) {
        GAS f32x4* xr = (GAS f32x4*)(A.out + (size_t)m * DMODEL) + F.lane;
        const float p = (F.lane < 16) ? ssq[(size_t)m * 16 + F.lane] : 0.f;
        const float rstd = 1.0f / sqrtf(wave_sum(p) * (1.0f / DMODEL) + RMS_EPS);
#pragma unroll
        for (int j = 0; j < 4; ++j) { const f32x4 g = *((const f32x4*)IN_FINAL_G(A) + F.lane + 64 * j); f32x4 v = xr[64 * j]; v = v * rstd * g; xr[64 * j] = v; }
#if PROBE_OUT
        if (m == 0 && F.lane == 0) { const float* pm = (const float*)(F.ws + WS_MISC); float pv = PROBE_OUT == 300 ? 8.f + floorf((float)(__builtin_amdgcn_s_memrealtime() - ((const unsigned long long*)(F.ws + WS_MISC + 1024))[0]) * 0.01f * 0.05f) - 60.f : PROBE_OUT >= 200 ? 8.f + floorf((float)(((const unsigned long long*)(F.ws + WS_MISC + 1024))[PROBE_OUT - 200] - ((const unsigned long long*)(F.ws + WS_MISC + 1024))[0]) * 0.01f * 0.02f) : PROBE_OUT >= 100 ? 8.f + floorf((float)(((const unsigned long long*)(F.ws + WS_MISC + 1024))[PROBE_OUT - 100 + 1] - ((const unsigned long long*)(F.ws + WS_MISC + 1024))[PROBE_OUT - 100]) * 0.01f * 0.2f) : PROBE_OUT >= 10 ? 8.f + floorf(pm[16 + PROBE_OUT - 10] * 0.1f) : PROBE_OUT == 1 ? 8.f + floorf(pm[4] * (1.0f / 200.0f)) : (PROBE_OUT == 2 ? floorf(pm[5] * 10.f) : pm[6] * 0.25f); A.out[0] = fminf(pv, 45.f); }
#endif
    }
}

__global__ void __launch_bounds__(NWAVES * 64, 2) trunk_fwd(Args args) {
    extern __shared__ __attribute__((aligned(16))) unsigned char lds[];
    Frame F;
    F.lds = (LAS unsigned char*)lds;
    volatile LAS unsigned* MISC = (volatile LAS unsigned*)(F.lds + MISC_OFF);
    F.tid = threadIdx.x; F.lane = F.tid & 63; F.wave = __builtin_amdgcn_readfirstlane(F.tid >> 6);
    F.G = gridDim.x; { const int bx = blockIdx.x; F.vcu = (F.G % 8 == 0) ? (bx % 8) * (F.G / 8) + bx / 8 : bx; }
    F.ws = args.ws;
    gu32* ctl = (gu32*)(F.ws + WS_CTL);
    for (int u = F.tid; u < (LDS_BYTES - LDSCTL_OFF) / 4; u += NWAVES * 64) ((LAS unsigned*)(F.lds + LDSCTL_OFF))[u] = 0u;
    __syncthreads();
    XcdBarrier bar; bar.bar = (unsigned*)(ctl + CW_BAR); bar.x = 0; bar.st = nullptr;
    if (!MK_PER_PHASE) bar = xcd_barrier_post((unsigned*)(ctl + CW_BAR), MISC + 8);
    const int lo = args.ph_lo, hi = args.ph_hi;
#define IN(k) (lo <= (k) && (k) < hi)
#if PROBE_OUT >= 100
#define PSTAMP_PH(k) do { if (blockIdx.x == 0 && threadIdx.x == 0) ((unsigned long long*)(F.ws + WS_MISC + 1024))[(k)] = __builtin_amdgcn_s_memrealtime(); } while (0)
#else
#define PSTAMP_PH(k) do {} while (0)
#endif
#define SEAM(k) do { if (IN(k) && IN((k) + 1)) xcd_barrier(bar); PSTAMP_PH((k) + 1); } while (0)

        PSTAMP_PH(0);
#ifndef DIS_P0
    if (IN(0)) { p0_prologue(F, args);
#if PROBE_DUP & 4
        __syncthreads(); p0_prologue(F, args);
#endif
    }
#endif
    SEAM(0);
#define FRESH_TID() do { int t_ = threadIdx.x; asm volatile("" : "+v"(t_)); F.tid = t_; F.lane = t_ & 63; F.wave = __builtin_amdgcn_readfirstlane(t_ >> 6); } while (0)
    for (int layer = 0; layer < DEPTH; ++layer) {
        const int pb = 1 + 4 * layer, kind = layer % 3;
#ifndef DIS_GIN
        if (IN(pb)) for (int rep_ = 0; rep_ < (((PROBE_DUP & 1) && ((PROBE_LAYERS >> layer) & 1)) ? 2 : 1); ++rep_) {
#ifndef DIS_INP
            { pg8::Gemm g{(const pg8::bf16_t*)(F.ws + WS_XB), (const pg8::bf16_t*)(F.ws + WS_WIN) + (size_t)layer * INW * DMODEL, MROWS, INW, DMODEL};
              pg8::StaticOrder S; S.init(MROWS, INW, F.G, (int)blockIdx.x);
              pg8::EpiIn E{F.ws, kind, layer};
              pg8::gemm_phase<pg8::EpiIn, pg8::StaticOrder, true, true>(F.lds + RING_OFF, g, S, E); }
#endif
#ifndef DIS_MEMKV
            if (layer == 0) {
              pg8::Gemm g{(const pg8::bf16_t*)(F.ws + WS_MEMN), (const pg8::bf16_t*)(F.ws + WS_WMEM), BATCH * NMEM, DEPTH * 512, DMODEL};
              pg8::TailOrder S{2, 8, F.G, (int)blockIdx.x};
              pg8::EpiPlain E{(pg8::bf16_t*)(F.ws + WS_MEMKV), DEPTH * 512};
              pg8::gemm_phase<pg8::EpiPlain, pg8::TailOrder, true, true>(F.lds + RING_OFF, g, S, E); }
#endif
            if (rep_ == 0) {
                FRESH_TID();
                const int c = (int)blockIdx.x;
                if (F.G == 256) { const int hi_c = (layer == 0) ? 240 : 256; if (c >= 128 && c < hi_c) convert_deferred(F, args, layer, (c - 128) * NWAVES + F.wave, (hi_c - 128) * NWAVES); }
                else convert_deferred(F, args, layer, c * NWAVES + F.wave, F.G * NWAVES);
            }
        }
#endif
        SEAM(pb);
#ifndef DIS_ATT
        if (IN(pb + 1)) for (int rep_ = 0; rep_ < (((PROBE_DUP & 2) && ((PROBE_LAYERS >> layer) & 1)) ? 2 : 1); ++rep_) { FRESH_TID();
#if PROBE_OUT >= 10
            const unsigned long long r0_ = __builtin_amdgcn_s_memrealtime();
#endif
            phase_attn(F, layer, rep_);
#if PROBE_OUT >= 10
            if (blockIdx.x == 0 && F.tid == 0) ((float*)(F.ws + WS_MISC))[16 + layer] = (float)(__builtin_amdgcn_s_memrealtime() - r0_) * 0.01f;
#endif
        }
#endif
        SEAM(pb + 1);
#ifndef DIS_FIN
        if (IN(pb + 2) && kind != 1) { FRESH_TID(); phase_finalize(F, args, layer); }
#endif
        if (kind != 1) SEAM(pb + 2);
#ifndef DIS_GOUT
        if (IN(pb + 3)) for (int rep_ = 0; rep_ < (((PROBE_DUP & 8) && layer == 0) ? 2 : 1); ++rep_) {
            pg8::Gemm g{(const pg8::bf16_t*)(F.ws + WS_GATE), (const pg8::bf16_t*)(F.ws + WS_WOUT) + (size_t)layer * DMODEL * DMODEL, MROWS, DMODEL, DMODEL};
            pg8::StaticOrder S; S.init(MROWS, DMODEL, F.G, (int)blockIdx.x);
            pg8::EpiOut E{IN_X(args), args.out, (pg8::bf16_t*)(F.ws + WS_XB), (float*)(F.ws + WS_SSQ), layer == 0 ? 1 : 0, layer + 1 < DEPTH ? 0 : 1};
            pg8::gemm_phase<pg8::EpiOut, pg8::StaticOrder, true, true>(F.lds + RING_OFF, g, S, E);
        }
#endif
        SEAM(pb + 3);
    }
    if (IN(NPHASES - 1)) { FRESH_TID(); phase_final_norm(F, args); }
#undef IN
#undef SEAM
}

extern "C" void kernel_launch(void* const* d_in, const int* in_sizes, int n_in, void* d_out, int out_size, void* d_ws, size_t ws_size, hipStream_t stream) {
    static int grid = 0;
    if (grid == 0) {
        if (n_in != 13 || out_size != MROWS * DMODEL || ws_size < WS_END) { fprintf(stderr, "kernel_launch: unexpected problem shape (n_in %d, out %d, ws %zu); nothing launched\n", n_in, out_size, ws_size); grid = -1; return; }
        int dev = 0, cus = 0, per_cu = 0;
        if (hipGetDevice(&dev) != hipSuccess || hipDeviceGetAttribute(&cus, hipDeviceAttributeMultiprocessorCount, dev) != hipSuccess) { grid = -1; return; }
        if (hipFuncSetAttribute((const void*)trunk_fwd, hipFuncAttributeMaxDynamicSharedMemorySize, LDS_BYTES) != hipSuccess) { fprintf(stderr, "kernel_launch: hipFuncSetAttribute failed\n"); grid = -1; return; }
        if (hipOccupancyMaxActiveBlocksPerMultiprocessor(&per_cu, (const void*)trunk_fwd, NWAVES * 64, LDS_BYTES) != hipSuccess || per_cu < 1) { fprintf(stderr, "kernel_launch: occupancy query says %d workgroups per CU\n", per_cu); per_cu = 1; }
        (void)hipGetLastError();
        grid = cus;
    }
    if (grid < 0) return;
    if (hipMemsetAsync((char*)d_ws + WS_CTL, 0, CTL_USED_BYTES, stream) != hipSuccess) { fprintf(stderr, "kernel_launch: hipMemsetAsync failed\n"); return; }
    Args a{};
    for (int i = 0; i < 13; ++i) a.in[i] = (const float*)d_in[i];
    a.out = (float*)d_out; a.ws = (unsigned char*)d_ws;
#if MK_PER_PHASE
    for (int p = 0; p < NPHASES; ++p) { a.ph_lo = p; a.ph_hi = p + 1; a.li = p; hipLaunchKernelGGL(trunk_fwd, dim3(grid), dim3(NWAVES * 64), LDS_BYTES, stream, a); }
#else
    a.ph_lo = 0; a.ph_hi = NPHASES; a.li = 0;
    hipLaunchKernelGGL(trunk_fwd, dim3(grid), dim3(NWAVES * 64), LDS_BYTES, stream, a);
#endif
    const hipError_t le = hipPeekAtLastError();
    if (le != hipSuccess) fprintf(stderr, "kernel_launch: launch failed: %s\n", hipGetErrorName(le));
}
```
